# Optimizing an MI355X kernel written in HIP

```python
import math
import jax, jax.numpy as jnp
from jax import lax
import numpy as np

D_MODEL = 1024
BATCH = 4
SEQ = 8192
DEPTH = 1

CTX_LEN = 256
GRID_W = 64
N_MOD = 6
EPS = 1e-6
RET_HEADS = 4
RET_DK = 128
RET_DV = 256
RET_QK = RET_HEADS * RET_DK
RET_V = RET_HEADS * RET_DV
RET_CHUNK = 128
ROPE_BASE = 10000.0
D_RNN = 1024
LRU_BLOCKS = 8
LRU_BS = D_RNN // LRU_BLOCKS
CONV_W = 4
CONV_LEFT = 2
LRU_C = 8.0
PEER_HEADS = 8
PEER_DKEY = 128
PEER_DHALF = PEER_DKEY // 2
PEER_NKEYS = 128
PEER_TOPK = 16
PEER_NEXP = PEER_NKEYS * PEER_NKEYS
PEER_BLOCK = 128
IN_SIZES = (RET_QK, RET_QK, RET_V, RET_V, D_RNN, D_RNN, D_MODEL, D_MODEL)
IN_COLS = sum(IN_SIZES)

kernel_name = 'hybrid_retention_rglru_peer_block'


def rms_norm(x, g):
    x32 = x.astype(jnp.float32)
    y = x32 * lax.rsqrt(jnp.mean(x32 * x32, axis=-1, keepdims=True) + EPS)
    return (y * g.astype(jnp.float32)).astype(x.dtype)


def modulate(h, shift, scale):
    return h * (1.0 + scale) + shift


def split_proj(p):
    idx = [int(s) for s in np.cumsum(IN_SIZES)[:-1]]
    return jnp.split(p, idx, axis=-1)


def head_norm(o):
    mu = jnp.mean(o, axis=-1, keepdims=True)
    var = jnp.mean(jnp.square(o - mu), axis=-1, keepdims=True)
    return (o - mu) * lax.rsqrt(var + EPS)


def axial_rope(t, rows):
    quarter = RET_DK // 4
    row = jnp.repeat(jnp.arange(rows), GRID_W)
    col = jnp.tile(jnp.arange(GRID_W), rows)
    inv = ROPE_BASE ** (-jnp.arange(quarter, dtype=jnp.float32) / quarter)

    def rot(u, pos):
        ang = pos.astype(jnp.float32)[:, None] * inv[None, :]
        cos = jnp.cos(ang)[None, :, None, :]
        sin = jnp.sin(ang)[None, :, None, :]
        u1, u2 = u[..., :quarter], u[..., quarter:]
        return jnp.concatenate([u1 * cos - u2 * sin, u2 * cos + u1 * sin], axis=-1)

    half = RET_DK // 2
    return jnp.concatenate([rot(t[..., :half], row), rot(t[..., half:], col)], axis=-1)


def retention_dir(q, k, v, log_gamma, s0, inclusive):
    b_, L, H, _ = q.shape
    dv = v.shape[-1]
    n = L // RET_CHUNK

    def chunks(t):
        return t.reshape(b_, n, RET_CHUNK, H, t.shape[-1]).transpose(1, 0, 3, 2, 4)

    idx = jnp.arange(RET_CHUNK, dtype=jnp.float32)
    diff = idx[:, None] - idx[None, :]
    keep = (diff >= 0) if inclusive else (diff > 0)
    dmat = jnp.where(keep[None], jnp.exp(log_gamma[:, None, None] * jnp.maximum(diff, 0.0)[None]), 0.0)
    xi = jnp.exp(log_gamma[:, None] * (idx + 1.0)[None])[..., None]
    zeta = jnp.exp(log_gamma[:, None] * (RET_CHUNK - 1.0 - idx)[None])[..., None]
    chunk_decay = jnp.exp(log_gamma * RET_CHUNK)[:, None, None]

    def step(S, blk):
        qb, kb, vb = blk
        scores = jnp.einsum('bhid,bhjd->bhij', qb, kb) * dmat
        o = jnp.einsum('bhij,bhjv->bhiv', scores, vb) + jnp.einsum('bhid,bhdv->bhiv', qb * xi, S)
        S = chunk_decay * S + jnp.einsum('bhjd,bhjv->bhdv', kb * zeta, vb)
        return S, o

    S, o = lax.scan(step, s0, (chunks(q), chunks(k), chunks(v)))
    o = o.transpose(1, 0, 3, 2, 4).reshape(b_, L, H, dv)
    return o, S


def retention_mixer(pc, px, ret_decay_l, rows):
    f32 = jnp.float32
    b_ = px[0].shape[0]

    def heads(t, d):
        return t.astype(f32).reshape(t.shape[0], t.shape[1], RET_HEADS, d)

    kscale = RET_DK ** -0.5
    qc, kc, vc = heads(pc[0], RET_DK), heads(pc[1], RET_DK) * kscale, heads(pc[2], RET_DV)
    qx = axial_rope(heads(px[0], RET_DK), rows)
    kx = axial_rope(heads(px[1], RET_DK), rows) * kscale
    vx = heads(px[2], RET_DV)
    log_gamma = jax.nn.log_sigmoid(ret_decay_l.astype(f32))
    zeros = jnp.zeros((b_, RET_HEADS, RET_DK, RET_DV), f32)

    def bidir(q, k, v, s0f, s0b):
        of, sf = retention_dir(q, k, v, log_gamma[0], s0f, True)
        ob, sb = retention_dir(q[:, ::-1], k[:, ::-1], v[:, ::-1], log_gamma[1], s0b, False)
        return of + ob[:, ::-1], sf, sb

    oc, sf, sb = bidir(qc, kc, vc, zeros, zeros)
    ox, _, _ = bidir(qx, kx, vx, sf, sb)
    return head_norm(oc), head_norm(ox)


def short_conv(u, w, b):
    L = u.shape[1]
    up = jnp.pad(u, ((0, 0), (CONV_LEFT, CONV_W - 1 - CONV_LEFT), (0, 0)))
    out = b.astype(jnp.float32)
    for tap in range(CONV_W):
        out = out + up[:, tap:tap + L] * w[tap].astype(jnp.float32)
    return out


def lru_coeffs(u, wa, ba, wx, bx, lam):
    f32 = jnp.float32
    b_, L, _ = u.shape
    ub = u.reshape(b_, L, LRU_BLOCKS, LRU_BS)
    r = jax.nn.sigmoid(jnp.einsum('blnc,ncd->blnd', ub, wa.astype(f32)).reshape(b_, L, D_RNN) + ba.astype(f32))
    i = jax.nn.sigmoid(jnp.einsum('blnc,ncd->blnd', ub, wx.astype(f32)).reshape(b_, L, D_RNN) + bx.astype(f32))
    log_a = -LRU_C * r * jax.nn.softplus(-lam.astype(f32))
    a = jnp.exp(log_a)
    bterm = jnp.sqrt(-jnp.expm1(2.0 * log_a)) * (i * u)
    return a, bterm


def _lin_combine(e1, e2):
    a1, b1 = e1
    a2, b2 = e2
    return a1 * a2, a2 * b1 + b2


def lru_scan(a, b, h0, reverse):
    A, Bc = lax.associative_scan(_lin_combine, (a, b), axis=1, reverse=reverse)
    h = A * h0[:, None, :] + Bc
    final = h[:, 0] if reverse else h[:, -1]
    return h, final


def lru_mixer(uc_in, ux_in, cw, cb, wa, ba, wx, bx, lam):
    uc = short_conv(uc_in.astype(jnp.float32), cw, cb)
    ux = short_conv(ux_in.astype(jnp.float32), cw, cb)
    ys_c, ys_x = [], []
    for d in range(2):
        rev = d == 1
        ac, bc = lru_coeffs(uc, wa[d], ba[d], wx[d], bx[d], lam[d])
        hc, fin = lru_scan(ac, bc, jnp.zeros_like(uc[:, 0]), rev)
        ax, bxx = lru_coeffs(ux, wa[d], ba[d], wx[d], bx[d], lam[d])
        hx, _ = lru_scan(ax, bxx, fin, rev)
        ys_c.append(hc)
        ys_x.append(hx)
    return ys_c[0] + ys_c[1], ys_x[0] + ys_x[1]


def merge_branches(ret_o, lru_y, p, w_ret_out, w_lru_out, w_out):
    dt = p[3].dtype
    b_, L = ret_o.shape[0], ret_o.shape[1]
    ret = (ret_o.reshape(b_, L, RET_V).astype(dt) * jax.nn.silu(p[3])) @ w_ret_out
    lru = (lru_y.astype(dt) * jax.nn.gelu(p[5])) @ w_lru_out
    y = jax.nn.sigmoid(p[6]) * ret + jax.nn.sigmoid(p[7]) * lru
    return y @ w_out


def peer_ffn(h, wq, keys, u_tab, v_tab):
    b_, L, D = h.shape
    tok = h.reshape(-1, PEER_BLOCK, D)
    K = PEER_TOPK

    def block(xb):
        q = (xb @ wq).reshape(PEER_BLOCK, PEER_HEADS, 2, PEER_DHALF)
        s = jnp.einsum('thpd,hpkd->thpk', q, keys).astype(jnp.float32)
        s1, i1 = lax.top_k(s[:, :, 0], K)
        s2, i2 = lax.top_k(s[:, :, 1], K)
        cand = (s1[..., :, None] + s2[..., None, :]).reshape(PEER_BLOCK, PEER_HEADS, K * K)
        top, ci = lax.top_k(cand, K)
        e = jnp.take_along_axis(i1, ci // K, axis=-1) * PEER_NKEYS + jnp.take_along_axis(i2, ci % K, axis=-1)
        g = jax.nn.softmax(top, axis=-1).astype(xb.dtype)
        act = jax.nn.gelu(jnp.einsum('thkd,td->thk', u_tab[e], xb))
        return jnp.einsum('thk,thkd->td', g * act, v_tab[e])

    return lax.map(block, tok).reshape(b_, L, D)


def setup_inputs(seed: int = 0) -> dict:
    key = jax.random.key(seed)
    ks = jax.random.split(key, 32)
    f = jnp.float32
    D = D_MODEL

    def nrm(k, shape, s):
        return jax.random.normal(k, shape, f) * s

    gamma = 1.0 - jnp.exp2(-5.0 - jnp.arange(RET_HEADS, dtype=f))
    gamma_logit = jnp.log(gamma) - jnp.log1p(-gamma)
    ret_decay = jnp.broadcast_to(gamma_logit, (DEPTH, 2, RET_HEADS)) + nrm(ks[9], (DEPTH, 2, RET_HEADS), 0.01)
    a8 = jax.random.uniform(ks[17], (DEPTH, 2, D_RNN), f, 0.9, 0.999)
    s_lam = a8 ** (1.0 / LRU_C)
    lru_lambda = jnp.log(s_lam) - jnp.log1p(-s_lam)
    return {
        'x': nrm(ks[0], (BATCH, SEQ, D), 1.0),
        'c': nrm(ks[1], (BATCH, D), 1.0),
        'ctx': nrm(ks[2], (BATCH, CTX_LEN, D), 1.0),
        'c_ctx': nrm(ks[3], (D,), 1.0),
        'mod_w': nrm(ks[4], (DEPTH, D, N_MOD * D), 0.5 * D ** -0.5),
        'mod_b': nrm(ks[5], (DEPTH, N_MOD * D), 0.02),
        'norm1_g': 1.0 + nrm(ks[6], (DEPTH, D), 0.02),
        'norm2_g': 1.0 + nrm(ks[7], (DEPTH, D), 0.02),
        'w_in': nrm(ks[8], (DEPTH, D, IN_COLS), D ** -0.5),
        'ret_decay': ret_decay,
        'conv_w': nrm(ks[10], (DEPTH, CONV_W, D_RNN), CONV_W ** -0.5),
        'conv_b': nrm(ks[11], (DEPTH, D_RNN), 0.02),
        'lru_wa': nrm(ks[12], (DEPTH, 2, LRU_BLOCKS, LRU_BS, LRU_BS), LRU_BS ** -0.5),
        'lru_ba': nrm(ks[13], (DEPTH, 2, D_RNN), 0.1),
        'lru_wx': nrm(ks[14], (DEPTH, 2, LRU_BLOCKS, LRU_BS, LRU_BS), LRU_BS ** -0.5),
        'lru_bx': nrm(ks[15], (DEPTH, 2, D_RNN), 0.1),
        'lru_lambda': lru_lambda,
        'w_ret_out': nrm(ks[18], (DEPTH, RET_V, D), RET_V ** -0.5),
        'w_lru_out': nrm(ks[19], (DEPTH, D_RNN, D), D_RNN ** -0.5),
        'w_out': nrm(ks[20], (DEPTH, D, D), D ** -0.5),
        'peer_wq': nrm(ks[21], (DEPTH, D, PEER_HEADS * PEER_DKEY), D ** -0.5),
        'peer_keys': nrm(ks[22], (DEPTH, PEER_HEADS, 2, PEER_NKEYS, PEER_DHALF), PEER_DHALF ** -0.5),
        'peer_u': nrm(ks[23], (DEPTH, PEER_NEXP, D), D ** -0.5),
        'peer_v': nrm(ks[24], (DEPTH, PEER_NEXP, D), PEER_HEADS ** -0.5),
        'final_g': 1.0 + nrm(ks[25], (D,), 0.02),
    }


def reference(x, c, ctx, c_ctx, mod_w, mod_b, norm1_g, norm2_g, w_in, ret_decay, conv_w, conv_b,
              lru_wa, lru_ba, lru_wx, lru_bx, lru_lambda, w_ret_out, w_lru_out, w_out,
              peer_wq, peer_keys, peer_u, peer_v, final_g):
    n_tok = x.shape[1]
    rows = n_tok // GRID_W
    sc = jax.nn.silu(c)
    scc = jax.nn.silu(c_ctx)
    for l in range(DEPTH):
        last = l == DEPTH - 1
        mod_x = (sc @ mod_w[l] + mod_b[l])[:, None, :]
        mod_c = (scc @ mod_w[l] + mod_b[l])[None, None, :]
        sh1x, sc1x, g1x, sh2x, sc2x, g2x = jnp.split(mod_x, N_MOD, axis=-1)
        sh1c, sc1c, g1c, sh2c, sc2c, g2c = jnp.split(mod_c, N_MOD, axis=-1)

        hx = modulate(rms_norm(x, norm1_g[l]), sh1x, sc1x)
        hc = modulate(rms_norm(ctx, norm1_g[l]), sh1c, sc1c)
        px = split_proj(hx @ w_in[l])
        pc = split_proj(hc @ w_in[l])
        ret_c, ret_x = retention_mixer(pc, px, ret_decay[l], rows)
        lru_c, lru_x = lru_mixer(pc[4], px[4], conv_w[l], conv_b[l], lru_wa[l], lru_ba[l],
                                 lru_wx[l], lru_bx[l], lru_lambda[l])
        x = x + g1x * merge_branches(ret_x, lru_x, px, w_ret_out[l], w_lru_out[l], w_out[l])
        if not last:
            ctx = ctx + g1c * merge_branches(ret_c, lru_c, pc, w_ret_out[l], w_lru_out[l], w_out[l])
            hc2 = modulate(rms_norm(ctx, norm2_g[l]), sh2c, sc2c)
            ctx = ctx + g2c * peer_ffn(hc2, peer_wq[l], peer_keys[l], peer_u[l], peer_v[l])

        hx2 = modulate(rms_norm(x, norm2_g[l]), sh2x, sc2x)
        x = x + g2x * peer_ffn(hx2, peer_wq[l], peer_keys[l], peer_u[l], peer_v[l])
    return rms_norm(x, final_g)
```

```cpp
#include <hip/hip_runtime.h>
#include <hip/hip_bf16.h>
#include <hip/hip_cooperative_groups.h>
#include <cstdio>
namespace cg = cooperative_groups;

typedef unsigned short u16;
using bf16x8 = __attribute__((ext_vector_type(8))) short;
using f32x4 = __attribute__((ext_vector_type(4))) float;
#define DI __device__ __forceinline__

#ifndef MULTI
#define MULTI 0
#endif

constexpr int NB = 4, LS = 8192, LCX = 256, DM = 1024;
constexpr int NTOK = NB * LS;
constexpr int NCTX = NB * LCX;
constexpr int NROW = NTOK + NCTX;
constexpr int NCHUNK = NROW / 128;
constexpr int INC = 7168;
constexpr float EPSV = 1e-6f;

constexpr size_t al256(size_t x) { return (x + 255) & ~size_t(255); }
constexpr size_t OFF_WTIN = 0;
constexpr size_t OFF_WTRO = OFF_WTIN + al256((size_t)INC * 1024 * 2);
constexpr size_t OFF_WTLO = OFF_WTRO + al256((size_t)1024 * 1024 * 2);
constexpr size_t OFF_WTO = OFF_WTLO + al256((size_t)1024 * 1024 * 2);
constexpr size_t OFF_WTQ = OFF_WTO + al256((size_t)1024 * 1024 * 2);
constexpr size_t OFF_WAT = OFF_WTQ + al256((size_t)1024 * 1024 * 2);
constexpr size_t OFF_KEYS = OFF_WAT + al256((size_t)2 * 2 * 8 * 128 * 128 * 2);
constexpr size_t OFF_MOD = OFF_KEYS + al256((size_t)8 * 2 * 128 * 64 * 2);
constexpr size_t OFF_LA = OFF_MOD + al256((size_t)5 * 6144 * 4);
constexpr size_t OFF_LB = OFF_LA + al256((size_t)2 * NCHUNK * 1024 * 4);
constexpr size_t OFF_LH = OFF_LB + al256((size_t)2 * NCHUNK * 1024 * 4);
constexpr size_t OFF_UT = OFF_LH + al256((size_t)2 * NCHUNK * 1024 * 4);
constexpr size_t OFF_VTAB = OFF_UT + al256((size_t)16384 * 1024);
constexpr size_t OFF_USC = OFF_VTAB + al256((size_t)16384 * 1024);
constexpr size_t OFF_VSC = OFF_USC + al256((size_t)16384 * 4);
constexpr size_t OFF_HX = OFF_VSC + al256((size_t)16384 * 4);
constexpr size_t OFF_Q = OFF_HX + al256((size_t)NROW * 1024 * 2);
constexpr size_t OFF_K = OFF_Q + al256((size_t)NROW * 512 * 2);
constexpr size_t OFF_VT = OFF_K + al256((size_t)NROW * 512 * 2);
constexpr size_t OFF_P4 = OFF_VT + al256((size_t)NROW * 1024 * 2);
constexpr size_t OFF_O = OFF_P4 + al256((size_t)NROW * 1024 * 2);
constexpr size_t OFF_STATS = OFF_O + al256((size_t)NTOK * 1024 * 2);
constexpr size_t OFF_KVC = OFF_STATS + al256((size_t)NTOK * 16 * 4);
constexpr size_t OFF_KT = OFF_KVC + al256((size_t)32 * 2 * 32768 * 2);
constexpr size_t OFF_Y = OFF_KT;
constexpr size_t WS_END = OFF_Y + al256((size_t)NTOK * 1024 * 2);

constexpr size_t OFF_BAR = WS_END;
constexpr size_t WS_END2 = OFF_BAR + 16384;
constexpr int LDS_MAIN = 4 * 128 * 72 * 2;
constexpr int LDS_BYTES = LDS_MAIN + 4096;

struct Params {
  const float *x, *c, *ctx, *c_ctx, *mod_w, *mod_b, *norm1_g, *norm2_g, *w_in, *ret_decay, *conv_w, *conv_b, *lru_wa,
      *lru_ba, *lru_wx, *lru_bx, *lru_lambda, *w_ret_out, *w_lru_out, *w_out, *peer_wq, *peer_keys, *peer_u, *peer_v,
      *final_g;
  float* out;
  unsigned char* ws;
  long ph_lo, ph_hi;
};

DI u16 f2bf(float f) {
  unsigned u = __float_as_uint(f);
  u += 0x7fffu + ((u >> 16) & 1u);
  return (u16)(u >> 16);
}
DI float bf2f(u16 h) { return __uint_as_float(((unsigned)h) << 16); }
DI unsigned pack2(float a, float b) { return (unsigned)f2bf(a) | ((unsigned)f2bf(b) << 16); }
DI float lo2f(unsigned w) { return __uint_as_float(w << 16); }
DI float hi2f(unsigned w) { return __uint_as_float(w & 0xffff0000u); }
DI float wave_sum(float v) {
#pragma unroll
  for (int o = 32; o > 0; o >>= 1) v += __shfl_xor(v, o);
  return v;
}
DI float sigmoidf_(float x) { return __builtin_amdgcn_rcpf(1.f + __expf(-x)); }
DI float siluf_(float x) { return x * __builtin_amdgcn_rcpf(1.f + __expf(-x)); }
DI float geluf_(float x) {
  float z2 = 1.5957691216057308f * (x + 0.044715f * x * x * x);
  return x * __builtin_amdgcn_rcpf(1.f + __expf(-z2));
}
DI float softplusf_(float x) { return x > 20.f ? x : log1pf(__expf(x)); }

struct Ident {
  static constexpr bool id = true;
  DI float operator()(float v, int, int) const { return v; }
};
struct ColScale {
  static constexpr bool id = false;
  const float* tab;
  DI float operator()(float v, int, int k) const { return v * tab[k]; }
};
struct RowScale {
  static constexpr bool id = false;
  const float* tab;
  DI float operator()(float v, int r, int) const { return v * tab[r]; }
};

template <class AX>
DI uint4 xform8(uint4 v, int row, int k, const AX& ax) {
  if constexpr (AX::id) {
    return v;
  } else {
    uint4 o;
    o.x = pack2(ax(lo2f(v.x), row, k + 0), ax(hi2f(v.x), row, k + 1));
    o.y = pack2(ax(lo2f(v.y), row, k + 2), ax(hi2f(v.y), row, k + 3));
    o.z = pack2(ax(lo2f(v.z), row, k + 4), ax(hi2f(v.z), row, k + 5));
    o.w = pack2(ax(lo2f(v.w), row, k + 6), ax(hi2f(v.w), row, k + 7));
    return o;
  }
}

template <bool A_LDS, int NI, class AX>
DI void mma_loop(f32x4 (&acc)[4][NI], const u16* __restrict__ A, long lda, const u16* __restrict__ Bt, long ldb, int K,
                 u16* smem, const AX& ax) {
  const int tid = threadIdx.x, lane = tid & 63, wid = tid >> 6, wm = wid >> 1, wn = wid & 1, fr = lane & 15,
            fq = lane >> 4;
  u16* sA = smem;
  u16* sB = smem + 2 * 128 * 72;
  const int nk = K >> 6;
  uint4 ra[4], rb[NI];
  __syncthreads();
#pragma unroll
  for (int i = 0; i < 4; ++i) {
    int c = tid + i * 256;
    int row = c >> 3, kc = (c & 7) * 8;
    if (!A_LDS) ra[i] = *(const uint4*)(A + (long)row * lda + kc);
    if (i < NI) rb[i] = *(const uint4*)(Bt + (long)row * ldb + kc);
  }
#pragma unroll
  for (int i = 0; i < 4; ++i) {
    int c = tid + i * 256;
    int row = c >> 3, kc = (c & 7) * 8;
    const int pk = (((c & 7) ^ ((row >> 1) & 7)) << 3);
    if (!A_LDS) *(uint4*)(sA + row * 64 + pk) = xform8(ra[i], row, kc, ax);
    if (i < NI) *(uint4*)(sB + row * 64 + pk) = rb[i];
  }
  __syncthreads();
  for (int kt = 0; kt < nk; ++kt) {
    const int cur = kt & 1;
    if (kt + 1 < nk) {
#pragma unroll
      for (int i = 0; i < 4; ++i) {
        int c = tid + i * 256;
        int row = c >> 3, kc = (c & 7) * 8;
        if (!A_LDS) ra[i] = *(const uint4*)(A + (long)row * lda + (kt + 1) * 64 + kc);
        if (i < NI) rb[i] = *(const uint4*)(Bt + (long)row * ldb + (kt + 1) * 64 + kc);
      }
    }
#pragma unroll
    for (int ks = 0; ks < 2; ++ks) {
      bf16x8 af[4];
#pragma unroll
      for (int mi = 0; mi < 4; ++mi) {
        if (A_LDS)
          af[mi] = *(const bf16x8*)(smem + (wm * 64 + mi * 16 + fr) * 144 + kt * 64 + ks * 32 + fq * 8);
        else
          af[mi] = *(const bf16x8*)(sA + cur * (128 * 64) + (wm * 64 + mi * 16 + fr) * 64 + (((ks * 4 + fq) ^ (fr >> 1)) << 3));
      }
#pragma unroll
      for (int ni = 0; ni < NI; ++ni) {
        bf16x8 bq = *(const bf16x8*)(sB + cur * (128 * 64) + (wn * (16 * NI) + ni * 16 + fr) * 64 + (((ks * 4 + fq) ^ (fr >> 1)) << 3));
#pragma unroll
        for (int mi = 0; mi < 4; ++mi)
          acc[mi][ni] = __builtin_amdgcn_mfma_f32_16x16x32_bf16(af[mi], bq, acc[mi][ni], 0, 0, 0);
      }
    }
    if (kt + 1 < nk) {
      const int nx = cur ^ 1;
#pragma unroll
      for (int i = 0; i < 4; ++i) {
        int c = tid + i * 256;
        int row = c >> 3, kc = (c & 7) * 8;
        const int pk = (((c & 7) ^ ((row >> 1) & 7)) << 3);
        if (!A_LDS) *(uint4*)(sA + nx * (128 * 64) + row * 64 + pk) = xform8(ra[i], row, (kt + 1) * 64 + kc, ax);
        if (i < NI) *(uint4*)(sB + nx * (128 * 64) + row * 64 + pk) = rb[i];
      }
    }
    __syncthreads();
  }
}

DI void mma_loop2(f32x4 (&acc)[4][4], const u16* __restrict__ A, long lda, const u16* __restrict__ Bt, long ldb, int K, u16* smem) {
  const int tid = threadIdx.x, lane = tid & 63, wid = tid >> 6, wm = wid >> 1, wn = wid & 1, fr = lane & 15,
            fq = lane >> 4;
  u16* sA = smem;
  u16* sB = smem + 2 * 128 * 72;
  const int nk = K >> 6;
  uint4 a00, b00, a01, b01, a02, b02, a03, b03, a10, b10, a11, b11, a12, b12, a13, b13;
  const int lrow = tid >> 3, kc = (tid & 7) * 8;
  const u16* ap = A + (long)lrow * lda + kc;
  const u16* bp = Bt + (long)lrow * ldb + kc;
  const int soff = lrow * 64 + ((((tid & 7) ^ ((lrow >> 1) & 7))) << 3);
  __syncthreads();
  {
    a00 = *(const uint4*)(ap + (long)(0) * lda + (0) * 64);
    b00 = *(const uint4*)(bp + (long)(0) * ldb + (0) * 64);
    a01 = *(const uint4*)(ap + (long)(32) * lda + (0) * 64);
    b01 = *(const uint4*)(bp + (long)(32) * ldb + (0) * 64);
    a02 = *(const uint4*)(ap + (long)(64) * lda + (0) * 64);
    b02 = *(const uint4*)(bp + (long)(64) * ldb + (0) * 64);
    a03 = *(const uint4*)(ap + (long)(96) * lda + (0) * 64);
    b03 = *(const uint4*)(bp + (long)(96) * ldb + (0) * 64);
    a10 = *(const uint4*)(ap + (long)(0) * lda + (1) * 64);
    b10 = *(const uint4*)(bp + (long)(0) * ldb + (1) * 64);
    a11 = *(const uint4*)(ap + (long)(32) * lda + (1) * 64);
    b11 = *(const uint4*)(bp + (long)(32) * ldb + (1) * 64);
    a12 = *(const uint4*)(ap + (long)(64) * lda + (1) * 64);
    b12 = *(const uint4*)(bp + (long)(64) * ldb + (1) * 64);
    a13 = *(const uint4*)(ap + (long)(96) * lda + (1) * 64);
    b13 = *(const uint4*)(bp + (long)(96) * ldb + (1) * 64);
    *(uint4*)(sA + 0 * (128 * 64) + soff + 0) = a00;
    *(uint4*)(sB + 0 * (128 * 64) + soff + 0) = b00;
    *(uint4*)(sA + 0 * (128 * 64) + soff + 2048) = a01;
    *(uint4*)(sB + 0 * (128 * 64) + soff + 2048) = b01;
    *(uint4*)(sA + 0 * (128 * 64) + soff + 4096) = a02;
    *(uint4*)(sB + 0 * (128 * 64) + soff + 4096) = b02;
    *(uint4*)(sA + 0 * (128 * 64) + soff + 6144) = a03;
    *(uint4*)(sB + 0 * (128 * 64) + soff + 6144) = b03;
  }
  __syncthreads();
  for (int kt = 0; kt < nk; kt += 2) {
    if (kt + 2 < nk) {
    a00 = *(const uint4*)(ap + (long)(0) * lda + (kt + 2) * 64);
    b00 = *(const uint4*)(bp + (long)(0) * ldb + (kt + 2) * 64);
    a01 = *(const uint4*)(ap + (long)(32) * lda + (kt + 2) * 64);
    b01 = *(const uint4*)(bp + (long)(32) * ldb + (kt + 2) * 64);
    a02 = *(const uint4*)(ap + (long)(64) * lda + (kt + 2) * 64);
    b02 = *(const uint4*)(bp + (long)(64) * ldb + (kt + 2) * 64);
    a03 = *(const uint4*)(ap + (long)(96) * lda + (kt + 2) * 64);
    b03 = *(const uint4*)(bp + (long)(96) * ldb + (kt + 2) * 64);
    }
    __builtin_amdgcn_s_setprio(1);
#pragma unroll
    for (int ks = 0; ks < 2; ++ks) {
      bf16x8 af[4];
#pragma unroll
      for (int mi = 0; mi < 4; ++mi)
        af[mi] = *(const bf16x8*)(sA + 0 * (128 * 64) + (wm * 64 + mi * 16 + fr) * 64 + (((ks * 4 + fq) ^ (fr >> 1)) << 3));
#pragma unroll
      for (int ni = 0; ni < 4; ++ni) {
        bf16x8 bq = *(const bf16x8*)(sB + 0 * (128 * 64) + (wn * 64 + ni * 16 + fr) * 64 + (((ks * 4 + fq) ^ (fr >> 1)) << 3));
#pragma unroll
        for (int mi = 0; mi < 4; ++mi)
          acc[mi][ni] = __builtin_amdgcn_mfma_f32_16x16x32_bf16(af[mi], bq, acc[mi][ni], 0, 0, 0);
      }
    }
    __builtin_amdgcn_s_setprio(0);
    *(uint4*)(sA + 1 * (128 * 64) + soff + 0) = a10;
    *(uint4*)(sB + 1 * (128 * 64) + soff + 0) = b10;
    *(uint4*)(sA + 1 * (128 * 64) + soff + 2048) = a11;
    *(uint4*)(sB + 1 * (128 * 64) + soff + 2048) = b11;
    *(uint4*)(sA + 1 * (128 * 64) + soff + 4096) = a12;
    *(uint4*)(sB + 1 * (128 * 64) + soff + 4096) = b12;
    *(uint4*)(sA + 1 * (128 * 64) + soff + 6144) = a13;
    *(uint4*)(sB + 1 * (128 * 64) + soff + 6144) = b13;
    __syncthreads();
    if (kt + 3 < nk) {
    a10 = *(const uint4*)(ap + (long)(0) * lda + (kt + 3) * 64);
    b10 = *(const uint4*)(bp + (long)(0) * ldb + (kt + 3) * 64);
    a11 = *(const uint4*)(ap + (long)(32) * lda + (kt + 3) * 64);
    b11 = *(const uint4*)(bp + (long)(32) * ldb + (kt + 3) * 64);
    a12 = *(const uint4*)(ap + (long)(64) * lda + (kt + 3) * 64);
    b12 = *(const uint4*)(bp + (long)(64) * ldb + (kt + 3) * 64);
    a13 = *(const uint4*)(ap + (long)(96) * lda + (kt + 3) * 64);
    b13 = *(const uint4*)(bp + (long)(96) * ldb + (kt + 3) * 64);
    }
    __builtin_amdgcn_s_setprio(1);
#pragma unroll
    for (int ks = 0; ks < 2; ++ks) {
      bf16x8 af[4];
#pragma unroll
      for (int mi = 0; mi < 4; ++mi)
        af[mi] = *(const bf16x8*)(sA + 1 * (128 * 64) + (wm * 64 + mi * 16 + fr) * 64 + (((ks * 4 + fq) ^ (fr >> 1)) << 3));
#pragma unroll
      for (int ni = 0; ni < 4; ++ni) {
        bf16x8 bq = *(const bf16x8*)(sB + 1 * (128 * 64) + (wn * 64 + ni * 16 + fr) * 64 + (((ks * 4 + fq) ^ (fr >> 1)) << 3));
#pragma unroll
        for (int mi = 0; mi < 4; ++mi)
          acc[mi][ni] = __builtin_amdgcn_mfma_f32_16x16x32_bf16(af[mi], bq, acc[mi][ni], 0, 0, 0);
      }
    }
    __builtin_amdgcn_s_setprio(0);
    if (kt + 2 < nk) {
    *(uint4*)(sA + 0 * (128 * 64) + soff + 0) = a00;
    *(uint4*)(sB + 0 * (128 * 64) + soff + 0) = b00;
    *(uint4*)(sA + 0 * (128 * 64) + soff + 2048) = a01;
    *(uint4*)(sB + 0 * (128 * 64) + soff + 2048) = b01;
    *(uint4*)(sA + 0 * (128 * 64) + soff + 4096) = a02;
    *(uint4*)(sB + 0 * (128 * 64) + soff + 4096) = b02;
    *(uint4*)(sA + 0 * (128 * 64) + soff + 6144) = a03;
    *(uint4*)(sB + 0 * (128 * 64) + soff + 6144) = b03;
    }
    __syncthreads();
  }
}

DI void mma_big(f32x4 (&acc)[4][8], const u16* __restrict__ A, const u16* __restrict__ Bt, u16* smem) {
  const int tid = threadIdx.x, lane = tid & 63, wid = tid >> 6, fr = lane & 15, fq = lane >> 4;
  u16* sA = smem;
  u16* sB = smem + 16384;
  uint4 a00, a01, a02, a03, a10, a11, a12, a13, b00, b01, b10, b11;
  const u16* ap = A + (long)(tid >> 2) * 1024 + (tid & 3) * 8;
  const u16* bp = Bt + (long)(tid >> 2) * 1024 + (tid & 3) * 8;
  const int soff = (tid >> 2) * 32 + ((((tid & 3) ^ ((0 - (tid >> 4)) & 3))) << 3);
  const int rpk = ((fq ^ ((0 - (fr >> 2)) & 3)) << 3);
  __syncthreads();
  {
    a00 = *(const uint4*)(ap + (long)(0) * 1024 + (0) * 32);
    a01 = *(const uint4*)(ap + (long)(64) * 1024 + (0) * 32);
    a02 = *(const uint4*)(ap + (long)(128) * 1024 + (0) * 32);
    a03 = *(const uint4*)(ap + (long)(192) * 1024 + (0) * 32);
    b00 = *(const uint4*)(bp + (long)(0) * 1024 + (0) * 32);
    b01 = *(const uint4*)(bp + (long)(64) * 1024 + (0) * 32);
    a10 = *(const uint4*)(ap + (long)(0) * 1024 + (1) * 32);
    a11 = *(const uint4*)(ap + (long)(64) * 1024 + (1) * 32);
    a12 = *(const uint4*)(ap + (long)(128) * 1024 + (1) * 32);
    a13 = *(const uint4*)(ap + (long)(192) * 1024 + (1) * 32);
    b10 = *(const uint4*)(bp + (long)(0) * 1024 + (1) * 32);
    b11 = *(const uint4*)(bp + (long)(64) * 1024 + (1) * 32);
    *(uint4*)(sA + 0 * 8192 + soff + 0) = a00;
    *(uint4*)(sA + 0 * 8192 + soff + 2048) = a01;
    *(uint4*)(sA + 0 * 8192 + soff + 4096) = a02;
    *(uint4*)(sA + 0 * 8192 + soff + 6144) = a03;
    *(uint4*)(sB + 0 * 4096 + soff + 0) = b00;
    *(uint4*)(sB + 0 * 4096 + soff + 2048) = b01;
  }
  __syncthreads();
  for (int kt = 0; kt < 32; kt += 2) {
    *(uint4*)(sA + 1 * 8192 + soff + 0) = a10;
    *(uint4*)(sA + 1 * 8192 + soff + 2048) = a11;
    *(uint4*)(sA + 1 * 8192 + soff + 4096) = a12;
    *(uint4*)(sA + 1 * 8192 + soff + 6144) = a13;
    *(uint4*)(sB + 1 * 4096 + soff + 0) = b10;
    *(uint4*)(sB + 1 * 4096 + soff + 2048) = b11;
    if (kt + 2 < 32) {
    a00 = *(const uint4*)(ap + (long)(0) * 1024 + (kt + 2) * 32);
    a01 = *(const uint4*)(ap + (long)(64) * 1024 + (kt + 2) * 32);
    a02 = *(const uint4*)(ap + (long)(128) * 1024 + (kt + 2) * 32);
    a03 = *(const uint4*)(ap + (long)(192) * 1024 + (kt + 2) * 32);
    b00 = *(const uint4*)(bp + (long)(0) * 1024 + (kt + 2) * 32);
    b01 = *(const uint4*)(bp + (long)(64) * 1024 + (kt + 2) * 32);
    a10 = *(const uint4*)(ap + (long)(0) * 1024 + (kt + 3) * 32);
    a11 = *(const uint4*)(ap + (long)(64) * 1024 + (kt + 3) * 32);
    a12 = *(const uint4*)(ap + (long)(128) * 1024 + (kt + 3) * 32);
    a13 = *(const uint4*)(ap + (long)(192) * 1024 + (kt + 3) * 32);
    b10 = *(const uint4*)(bp + (long)(0) * 1024 + (kt + 3) * 32);
    b11 = *(const uint4*)(bp + (long)(64) * 1024 + (kt + 3) * 32);
    }
    {
      bf16x8 af[4];
      __builtin_amdgcn_s_setprio(1);
#pragma unroll
      for (int mi = 0; mi < 4; ++mi) af[mi] = *(const bf16x8*)(sA + 0 * 8192 + (wid * 64 + mi * 16 + fr) * 32 + rpk);
#pragma unroll
      for (int ni = 0; ni < 8; ++ni) {
        bf16x8 bq = *(const bf16x8*)(sB + 0 * 4096 + (ni * 16 + fr) * 32 + rpk);
#pragma unroll
        for (int mi = 0; mi < 4; ++mi)
          acc[mi][ni] = __builtin_amdgcn_mfma_f32_16x16x32_bf16(af[mi], bq, acc[mi][ni], 0, 0, 0);
      }
      __builtin_amdgcn_s_setprio(0);
    }
    __syncthreads();
    {
      bf16x8 af[4];
      __builtin_amdgcn_s_setprio(1);
#pragma unroll
      for (int mi = 0; mi < 4; ++mi) af[mi] = *(const bf16x8*)(sA + 1 * 8192 + (wid * 64 + mi * 16 + fr) * 32 + rpk);
#pragma unroll
      for (int ni = 0; ni < 8; ++ni) {
        bf16x8 bq = *(const bf16x8*)(sB + 1 * 4096 + (ni * 16 + fr) * 32 + rpk);
#pragma unroll
        for (int mi = 0; mi < 4; ++mi)
          acc[mi][ni] = __builtin_amdgcn_mfma_f32_16x16x32_bf16(af[mi], bq, acc[mi][ni], 0, 0, 0);
      }
      __builtin_amdgcn_s_setprio(0);
    }
    if (kt + 2 < 32) {
    *(uint4*)(sA + 0 * 8192 + soff + 0) = a00;
    *(uint4*)(sA + 0 * 8192 + soff + 2048) = a01;
    *(uint4*)(sA + 0 * 8192 + soff + 4096) = a02;
    *(uint4*)(sA + 0 * 8192 + soff + 6144) = a03;
    *(uint4*)(sB + 0 * 4096 + soff + 0) = b00;
    *(uint4*)(sB + 0 * 4096 + soff + 2048) = b01;
    }
    __syncthreads();
  }
}
DI void mma_big3(f32x4 (&acc)[4][8], const u16* __restrict__ A, const u16* __restrict__ Bt, u16* smem) {
  const int tid = threadIdx.x, lane = tid & 63, wid = tid >> 6, fr = lane & 15, fq = lane >> 4;
  const int rpk = ((fq ^ ((0 - (fr >> 2)) & 3)) << 3);
  const int lrow = lane >> 2, lc = ((lane & 3) ^ ((0 - (lane >> 4)) & 3));
  const u16* ap = A + (long)(wid * 64 + lrow) * 1024 + lc * 8;
  const u16* bp = Bt + (long)(wid * 32 + lrow) * 1024 + lc * 8;
  char* lbase = (char*)smem;
  auto issue = [&](int kt, int buf) {
    char* la = lbase + buf * 24576 + wid * 4096;
    char* lb = lbase + buf * 24576 + 16384 + wid * 2048;
#pragma unroll
    for (int i = 0; i < 4; ++i)
      __builtin_amdgcn_global_load_lds((const unsigned*)(ap + (long)(16 * i) * 1024 + kt * 32), (unsigned __attribute__((address_space(3)))*)(la + i * 1024), 16, 0, 0);
#pragma unroll
    for (int i = 0; i < 2; ++i)
      __builtin_amdgcn_global_load_lds((const unsigned*)(bp + (long)(16 * i) * 1024 + kt * 32), (unsigned __attribute__((address_space(3)))*)(lb + i * 1024), 16, 0, 0);
  };
  __syncthreads();
  issue(0, 0);
  issue(1, 1);
  int cur = 0;
#pragma unroll 1
  for (int kt = 0; kt < 32; ++kt) {
    if (kt < 31) asm volatile("s_waitcnt vmcnt(6)" ::: "memory");
    else asm volatile("s_waitcnt vmcnt(0)" ::: "memory");
    asm volatile("s_waitcnt lgkmcnt(0)" ::: "memory");
    __builtin_amdgcn_s_barrier();
    if (kt + 2 < 32) {
      int nb = cur + 2;
      if (nb >= 3) nb -= 3;
      issue(kt + 2, nb);
    }
    const u16* sA = smem + cur * 12288;
    const u16* sB = sA + 8192;
    {
      bf16x8 af[4];
      __builtin_amdgcn_s_setprio(1);
#pragma unroll
      for (int mi = 0; mi < 4; ++mi) af[mi] = *(const bf16x8*)(sA + (wid * 64 + mi * 16 + fr) * 32 + rpk);
#pragma unroll
      for (int ni = 0; ni < 8; ++ni) {
        bf16x8 bq = *(const bf16x8*)(sB + (ni * 16 + fr) * 32 + rpk);
#pragma unroll
        for (int mi = 0; mi < 4; ++mi)
          acc[mi][ni] = __builtin_amdgcn_mfma_f32_16x16x32_bf16(af[mi], bq, acc[mi][ni], 0, 0, 0);
      }
      __builtin_amdgcn_s_setprio(0);
    }
    cur = cur + 1;
    if (cur == 3) cur = 0;
  }
  __syncthreads();
}

DI void zero_big(f32x4 (&acc)[4][8]) {
#pragma unroll
  for (int mi = 0; mi < 4; ++mi)
#pragma unroll
    for (int ni = 0; ni < 8; ++ni) acc[mi][ni] = f32x4{0.f, 0.f, 0.f, 0.f};
}
DI void big_to_lds(const f32x4 (&acc)[4][8], float* T, int h) {
  const int tid = threadIdx.x, lane = tid & 63, wid = tid >> 6, fr = lane & 15, fq = lane >> 4;
  if ((wid >> 1) != h) return;
#pragma unroll
  for (int mi = 0; mi < 4; ++mi)
#pragma unroll
    for (int ni = 0; ni < 8; ++ni)
#pragma unroll
      for (int j = 0; j < 4; ++j) T[((wid & 1) * 64 + mi * 16 + fq * 4 + j) * 132 + ni * 16 + fr] = acc[mi][ni][j];
}
DI void big_to_lds_T(const f32x4 (&acc)[4][8], float* T, int h) {
  const int tid = threadIdx.x, lane = tid & 63, wid = tid >> 6, fr = lane & 15, fq = lane >> 4;
  if ((wid >> 1) != h) return;
#pragma unroll
  for (int mi = 0; mi < 4; ++mi)
#pragma unroll
    for (int ni = 0; ni < 8; ++ni) *(f32x4*)(T + (ni * 16 + fr) * 132 + (wid & 1) * 64 + mi * 16 + fq * 4) = acc[mi][ni];
}
DI int tile_at_pad(int it, int MT, int NT, int& mt, int& nt) {
  const int G = gridDim.x >> 3, xcd = blockIdx.x & 7, lb = blockIdx.x >> 3;
  const int NT8 = NT >> 3, nst = ((MT + 7) >> 3) * NT8;
  const int f = it * G + lb;
  const int st = xcd + 8 * (f >> 6);
  if (st >= nst) return 0;
  const int w = f & 63;
  mt = (st / NT8) * 8 + (w >> 3);
  nt = (st % NT8) * 8 + (w & 7);
  return mt < MT ? 1 : 2;
}

DI void mma_glds128(f32x4 (&acc)[4][4], const u16* __restrict__ A, long lda, const u16* __restrict__ Bt, long ldb, int K, u16* smem) {
  const int tid = threadIdx.x, lane = tid & 63, wid = tid >> 6, wm = wid >> 1, wn = wid & 1, fr = lane & 15, fq = lane >> 4;
  u16* sA = smem;
  u16* sB = smem + 2 * 128 * 72;
  const int nk = K >> 6;
  typedef unsigned __attribute__((address_space(3))) lds_u32;
  auto issue = [&](int kt, int buf) {
#pragma unroll
    for (int i = 0; i < 4; ++i) {
      const int row = wid * 32 + i * 8 + (lane >> 3);
      const int lc = (lane & 7) ^ ((row >> 1) & 7);
      __builtin_amdgcn_global_load_lds((const unsigned*)(A + (long)row * lda + kt * 64 + lc * 8),
                                       (lds_u32*)(sA + buf * (128 * 64) + (wid * 32 + i * 8) * 64), 16, 0, 0);
      __builtin_amdgcn_global_load_lds((const unsigned*)(Bt + (long)row * ldb + kt * 64 + lc * 8),
                                       (lds_u32*)(sB + buf * (128 * 64) + (wid * 32 + i * 8) * 64), 16, 0, 0);
    }
  };
  __syncthreads();
  issue(0, 0);
  asm volatile("s_waitcnt vmcnt(0)" ::: "memory");
  __syncthreads();
  for (int kt = 0; kt < nk; ++kt) {
    const int cur = kt & 1;
    if (kt + 1 < nk) issue(kt + 1, cur ^ 1);
    __builtin_amdgcn_s_setprio(1);
#pragma unroll
    for (int ks = 0; ks < 2; ++ks) {
      bf16x8 af[4];
#pragma unroll
      for (int mi = 0; mi < 4; ++mi)
        af[mi] = *(const bf16x8*)(sA + cur * (128 * 64) + (wm * 64 + mi * 16 + fr) * 64 + (((ks * 4 + fq) ^ (fr >> 1)) << 3));
#pragma unroll
      for (int ni = 0; ni < 4; ++ni) {
        bf16x8 bq = *(const bf16x8*)(sB + cur * (128 * 64) + (wn * 64 + ni * 16 + fr) * 64 + (((ks * 4 + fq) ^ (fr >> 1)) << 3));
#pragma unroll
        for (int mi = 0; mi < 4; ++mi)
          acc[mi][ni] = __builtin_amdgcn_mfma_f32_16x16x32_bf16(af[mi], bq, acc[mi][ni], 0, 0, 0);
      }
    }
    __builtin_amdgcn_s_setprio(0);
    asm volatile("s_waitcnt vmcnt(0)" ::: "memory");
    __syncthreads();
  }
}

template <int NI>
DI void zero_acc(f32x4 (&acc)[4][NI]) {
#pragma unroll
  for (int mi = 0; mi < 4; ++mi)
#pragma unroll
    for (int ni = 0; ni < NI; ++ni) acc[mi][ni] = f32x4{0.f, 0.f, 0.f, 0.f};
}

DI void acc_to_lds(const f32x4 (&acc)[4][4], float* T) {
  const int tid = threadIdx.x, lane = tid & 63, wid = tid >> 6, wm = wid >> 1, wn = wid & 1, fr = lane & 15, fq = lane >> 4;
#pragma unroll
  for (int mi = 0; mi < 4; ++mi)
#pragma unroll
    for (int ni = 0; ni < 4; ++ni)
#pragma unroll
      for (int j = 0; j < 4; ++j) T[(wm * 64 + mi * 16 + fq * 4 + j) * 132 + wn * 64 + ni * 16 + fr] = acc[mi][ni][j];
}
DI void acc_to_lds_T(const f32x4 (&acc)[4][4], float* T) {
  const int tid = threadIdx.x, lane = tid & 63, wid = tid >> 6, wm = wid >> 1, wn = wid & 1, fr = lane & 15, fq = lane >> 4;
#pragma unroll
  for (int mi = 0; mi < 4; ++mi)
#pragma unroll
    for (int ni = 0; ni < 4; ++ni) *(f32x4*)(T + (wn * 64 + ni * 16 + fr) * 132 + wm * 64 + mi * 16 + fq * 4) = acc[mi][ni];
}
DI uint4 pack8(float4 a, float4 b) {
  uint4 o;
  o.x = pack2(a.x, a.y); o.y = pack2(a.z, a.w); o.z = pack2(b.x, b.y); o.w = pack2(b.z, b.w);
  return o;
}
DI void tile_store_bf16(const float* T, u16* dst, long ld) {
  const int tid = threadIdx.x;
#pragma unroll 1
  for (int i = 0; i < 8; ++i) {
    int idx = tid + i * 256;
    int r = idx >> 4, c0 = (idx & 15) * 8;
    float4 a = *(const float4*)(T + r * 132 + c0), b = *(const float4*)(T + r * 132 + c0 + 4);
    *(uint4*)(dst + (long)r * ld + c0) = pack8(a, b);
  }
}

template <int MODE>
DI void build_resident(u16* smem, const u16* __restrict__ A, long lda, const float* tab) {
  const int tid = threadIdx.x;
#pragma unroll 1
  for (int i = 0; i < 8; ++i) {
    int idx = tid + i * 256;
    int r = idx >> 4, c0 = (idx & 15) * 8;
    uint4 v = *(const uint4*)(A + (long)r * lda + c0);
    float s[8];
#pragma unroll
    for (int e = 0; e < 8; ++e) s[e] = MODE == 1 ? tab[r] : tab[c0 + e];
    uint4 o;
    o.x = pack2(lo2f(v.x) * s[0], hi2f(v.x) * s[1]);
    o.y = pack2(lo2f(v.y) * s[2], hi2f(v.y) * s[3]);
    o.z = pack2(lo2f(v.z) * s[4], hi2f(v.z) * s[5]);
    o.w = pack2(lo2f(v.w) * s[6], hi2f(v.w) * s[7]);
    *(uint4*)(smem + r * 144 + c0) = o;
  }
}

DI bool tile_at(int it, int MT, int NT, int& mt, int& nt) {
  const int G = gridDim.x >> 3, xcd = blockIdx.x & 7, lb = blockIdx.x >> 3;
  const int NT8 = NT >> 3, nst = (MT >> 3) * NT8;
  const int f = it * G + lb;
  const int st = xcd + 8 * (f >> 6);
  if (st >= nst) return false;
  const int w = f & 63;
  mt = (st / NT8) * 8 + (w >> 3);
  nt = (st % NT8) * 8 + (w & 7);
  return true;
}

DI void tr_items(const float* __restrict__ src, u16* __restrict__ dst, int K, int N, long nmat, long gtid,
                 long gstride) {
  const long per = (long)N * (K / 8);
  const long total = nmat * per;
  for (long i = gtid; i < total; i += gstride) {
    long mat = i / per;
    long r = i - mat * per;
    int k8 = (int)(r / N);
    int n = (int)(r - (long)k8 * N);
    const float* s = src + mat * (long)K * N + (long)k8 * 8 * N + n;
    uint4 o;
    o.x = pack2(s[0], s[(long)N]);
    o.y = pack2(s[2L * N], s[3L * N]);
    o.z = pack2(s[4L * N], s[5L * N]);
    o.w = pack2(s[6L * N], s[7L * N]);
    *(uint4*)(dst + mat * (long)K * N + (long)n * K + k8 * 8) = o;
  }
}
DI void cvt_items(const float* __restrict__ src, u16* __restrict__ dst, long n8, long gtid, long gstride) {
  for (long i = gtid; i < n8; i += gstride) {
    float4 a = *(const float4*)(src + i * 8);
    float4 b = *(const float4*)(src + i * 8 + 4);
    uint4 o;
    o.x = pack2(a.x, a.y);
    o.y = pack2(a.z, a.w);
    o.z = pack2(b.x, b.y);
    o.w = pack2(b.z, b.w);
    *(uint4*)(dst + i * 8) = o;
  }
}

DI void phase_prep(const Params& p, u16* smem) {
  const long gtid = (long)blockIdx.x * blockDim.x + threadIdx.x;
  const long gstride = (long)gridDim.x * blockDim.x;
  unsigned char* ws = p.ws;
  {
    float* mod = (float*)(ws + OFF_MOD);
    float* red = (float*)smem;
    const int tid = threadIdx.x;
    for (int it = blockIdx.x; it < 192; it += gridDim.x) {
      const int col = it * 32 + (tid & 31), ks = tid >> 5;
      float a0 = 0.f, a1 = 0.f, a2 = 0.f, a3 = 0.f, a4 = 0.f;
      for (int k = ks * 128; k < ks * 128 + 128; ++k) {
        float w = p.mod_w[(long)k * 6144 + col];
        a0 += siluf_(p.c[k]) * w;
        a1 += siluf_(p.c[1024 + k]) * w;
        a2 += siluf_(p.c[2048 + k]) * w;
        a3 += siluf_(p.c[3072 + k]) * w;
        a4 += siluf_(p.c_ctx[k]) * w;
      }
      __syncthreads();
      red[(ks * 5 + 0) * 32 + (tid & 31)] = a0;
      red[(ks * 5 + 1) * 32 + (tid & 31)] = a1;
      red[(ks * 5 + 2) * 32 + (tid & 31)] = a2;
      red[(ks * 5 + 3) * 32 + (tid & 31)] = a3;
      red[(ks * 5 + 4) * 32 + (tid & 31)] = a4;
      __syncthreads();
      if (tid < 160) {
        int r = tid >> 5, cc = tid & 31;
        float sum = p.mod_b[it * 32 + cc];
        for (int q = 0; q < 8; ++q) sum += red[(q * 5 + r) * 32 + cc];
        mod[r * 6144 + it * 32 + cc] = sum;
      }
    }
  }
  tr_items(p.w_in, (u16*)(ws + OFF_WTIN), 1024, INC, 1, gtid, gstride);
  tr_items(p.w_ret_out, (u16*)(ws + OFF_WTRO), 1024, 1024, 1, gtid, gstride);
  tr_items(p.w_lru_out, (u16*)(ws + OFF_WTLO), 1024, 1024, 1, gtid, gstride);
  tr_items(p.w_out, (u16*)(ws + OFF_WTO), 1024, 1024, 1, gtid, gstride);
  tr_items(p.peer_wq, (u16*)(ws + OFF_WTQ), 1024, 1024, 1, gtid, gstride);
  for (int d = 0; d < 2; ++d) {
    tr_items(p.lru_wa + (long)d * 8 * 16384, (u16*)(ws + OFF_WAT) + (long)(d * 2 + 0) * 8 * 16384, 128, 128, 8, gtid, gstride);
    tr_items(p.lru_wx + (long)d * 8 * 16384, (u16*)(ws + OFF_WAT) + (long)(d * 2 + 1) * 8 * 16384, 128, 128, 8, gtid, gstride);
  }
  cvt_items(p.peer_keys, (u16*)(ws + OFF_KEYS), 8L * 2 * 128 * 64 / 8, gtid, gstride);
  {
    const int lane = threadIdx.x & 63;
    const long gw = gtid >> 6, nw = gstride >> 6;
    for (long rr = gw; rr < 2L * 16384; rr += nw) {
      const int tb = (int)(rr >> 14);
      const long row = rr & 16383;
      const float* src = (tb ? p.peer_v : p.peer_u) + row * 1024 + lane * 16;
      float4 v0 = *(const float4*)(src), v1 = *(const float4*)(src + 4), v2 = *(const float4*)(src + 8), v3 = *(const float4*)(src + 12);
      float m = fmaxf(fmaxf(fmaxf(fabsf(v0.x), fabsf(v0.y)), fmaxf(fabsf(v0.z), fabsf(v0.w))),
                      fmaxf(fmaxf(fabsf(v1.x), fabsf(v1.y)), fmaxf(fabsf(v1.z), fabsf(v1.w))));
      m = fmaxf(m, fmaxf(fmaxf(fmaxf(fabsf(v2.x), fabsf(v2.y)), fmaxf(fabsf(v2.z), fabsf(v2.w))),
                         fmaxf(fmaxf(fabsf(v3.x), fabsf(v3.y)), fmaxf(fabsf(v3.z), fabsf(v3.w)))));
#pragma unroll
      for (int o = 32; o > 0; o >>= 1) m = fmaxf(m, __shfl_xor(m, o));
      m = fmaxf(m, 1e-30f);
      const float inv = 127.f / m;
      const int qoff = tb ? 128 : 0;
#define Q8(x) ((unsigned)((int)rintf((x) * inv) + qoff) & 0xffu)
      uint4 o;
      o.x = Q8(v0.x) | (Q8(v0.y) << 8) | (Q8(v0.z) << 16) | (Q8(v0.w) << 24);
      o.y = Q8(v1.x) | (Q8(v1.y) << 8) | (Q8(v1.z) << 16) | (Q8(v1.w) << 24);
      o.z = Q8(v2.x) | (Q8(v2.y) << 8) | (Q8(v2.z) << 16) | (Q8(v2.w) << 24);
      o.w = Q8(v3.x) | (Q8(v3.y) << 8) | (Q8(v3.z) << 16) | (Q8(v3.w) << 24);
#undef Q8
      *(uint4*)(ws + (tb ? OFF_VTAB : OFF_UT) + row * 1024 + lane * 16) = o;
      if (lane == 0) ((float*)(ws + (tb ? OFF_VSC : OFF_USC)))[row] = m * (1.f / 127.f);
    }
  }
}

DI void norm_row(const float* __restrict__ src, const float* __restrict__ g, const float* __restrict__ shift,
                 const float* __restrict__ scale, u16* __restrict__ dst, int lane) {
  float4 v[4];
  float ss = 0.f;
#pragma unroll
  for (int i = 0; i < 4; ++i) {
    v[i] = *(const float4*)(src + (i * 64 + lane) * 4);
    ss += v[i].x * v[i].x + v[i].y * v[i].y + v[i].z * v[i].z + v[i].w * v[i].w;
  }
  ss = wave_sum(ss);
  float rstd = rsqrtf(ss * (1.f / 1024.f) + EPSV);
#pragma unroll
  for (int i = 0; i < 4; ++i) {
    int c = (i * 64 + lane) * 4;
    float4 gg = *(const float4*)(g + c);
    float4 sh = *(const float4*)(shift + c);
    float4 sc = *(const float4*)(scale + c);
    float y0 = v[i].x * rstd * gg.x * (1.f + sc.x) + sh.x;
    float y1 = v[i].y * rstd * gg.y * (1.f + sc.y) + sh.y;
    float y2 = v[i].z * rstd * gg.z * (1.f + sc.z) + sh.z;
    float y3 = v[i].w * rstd * gg.w * (1.f + sc.w) + sh.w;
    uint2 o;
    o.x = pack2(y0, y1);
    o.y = pack2(y2, y3);
    *(uint2*)(dst + c) = o;
  }
}

DI void phase_norm1(const Params& p) {
  const int lane = threadIdx.x & 63;
  const long gw = ((long)blockIdx.x * blockDim.x + threadIdx.x) >> 6;
  const long nw = ((long)gridDim.x * blockDim.x) >> 6;
  const float* mod = (const float*)(p.ws + OFF_MOD);
  u16* hx = (u16*)(p.ws + OFF_HX);
#pragma unroll 2
  for (long r = gw; r < NROW; r += nw) {
    const float* src;
    int mr;
    if (r < NTOK) { src = p.x + r * 1024; mr = (int)(r / LS); }
    else { src = p.ctx + (r - NTOK) * 1024; mr = 4; }
    norm_row(src, p.norm1_g, mod + mr * 6144, mod + mr * 6144 + 1024, hx + r * 1024, lane);
  }
}
DI void phase_norm2(const Params& p) {
  const int lane = threadIdx.x & 63;
  const long gw = ((long)blockIdx.x * blockDim.x + threadIdx.x) >> 6;
  const long nw = ((long)gridDim.x * blockDim.x) >> 6;
  const float* mod = (const float*)(p.ws + OFF_MOD);
  u16* hx2 = (u16*)(p.ws + OFF_O);
#pragma unroll 2
  for (long r = gw; r < NTOK; r += nw) {
    int mr = (int)(r / LS);
    norm_row(p.out + r * 1024, p.norm2_g, mod + mr * 6144 + 3072, mod + mr * 6144 + 4096, hx2 + r * 1024, lane);
  }
}

DI void phase_gemm_a(const Params& p, u16* smem) {
  const int tid = threadIdx.x, lane = tid & 63, wid = tid >> 6, wm = wid >> 1, wn = wid & 1, fr = lane & 15, fq = lane >> 4;
  const u16* hx = (const u16*)(p.ws + OFF_HX);
  const u16* wt = (const u16*)(p.ws + OFF_WTIN);
  u16* Q = (u16*)(p.ws + OFF_Q);
  u16* Kb = (u16*)(p.ws + OFF_K);
  u16* KT = (u16*)(p.ws + OFF_KT);
  u16* VT = (u16*)(p.ws + OFF_VT);
  u16* P4 = (u16*)(p.ws + OFF_P4);
  int mt, nt;
  for (int it = 0; tile_at(it, NCHUNK, 24, mt, nt); ++it) {
    const int wrow0 = nt < 16 ? nt * 128 : 3072 + (nt - 16) * 128;
    const bool latent = mt < 256;
    if (!latent && nt < 4) continue;
    f32x4 acc[4][4];
    zero_acc(acc);
    mma_glds128(acc, hx + (long)mt * 128 * 1024, 1024, wt + (long)wrow0 * 1024, 1024, 1024, smem);
    const int b = latent ? mt / 64 : (mt - 256) / 2;
    const int tseq0 = latent ? (mt % 64) * 128 : ((mt - 256) % 2) * 128;
    const long row0 = (long)mt * 128;
    const int Lseq = latent ? LS : LCX;
    float* T = (float*)smem;
    if (nt < 8) {
      if (latent) {
#pragma unroll
        for (int mi = 0; mi < 4; ++mi)
#pragma unroll
          for (int j = 0; j < 4; ++j) {
            int tok = tseq0 + wm * 64 + mi * 16 + fq * 4 + j;
            float pos = (float)(wn == 0 ? (tok >> 6) : (tok & 63));
#pragma unroll
            for (int n2 = 0; n2 < 2; ++n2) {
              float f = (float)(n2 * 16 + fr);
              float inv = exp2f(-f * (13.287712379549449f / 32.f));
              float ang = pos * inv;
              float cs = __cosf(ang), sn = __sinf(ang);
              float u1 = acc[mi][n2][j], u2 = acc[mi][n2 + 2][j];
              acc[mi][n2][j] = u1 * cs - u2 * sn;
              acc[mi][n2 + 2][j] = u2 * cs + u1 * sn;
            }
          }
      }
      if (nt < 4) {
        acc_to_lds(acc, T);
        __syncthreads();
        tile_store_bf16(T, Q + row0 * 512 + nt * 128, 512);
      } else {
        const int h = nt - 4;
#pragma unroll
        for (int mi = 0; mi < 4; ++mi)
#pragma unroll
          for (int ni = 0; ni < 4; ++ni) acc[mi][ni] *= 0.08838834764831845f;
        acc_to_lds(acc, T);
        __syncthreads();
        tile_store_bf16(T, Kb + row0 * 512 + h * 128, 512);
        __syncthreads();
        acc_to_lds_T(acc, T);
        __syncthreads();
        u16* ktb = latent ? KT : KT + (size_t)4 * 512 * LS;
        tile_store_bf16(T, ktb + ((long)(b * 512 + h * 128)) * Lseq + tseq0, Lseq);
      }
    } else if (nt < 16) {
      acc_to_lds_T(acc, T);
      __syncthreads();
      u16* vtb = latent ? VT : VT + (size_t)4 * 1024 * LS;
      tile_store_bf16(T, vtb + ((long)(b * 1024 + (nt - 8) * 128)) * Lseq + tseq0, Lseq);
    } else {
      acc_to_lds(acc, T);
      __syncthreads();
      tile_store_bf16(T, P4 + row0 * 1024 + (nt - 16) * 128, 1024);
    }
  }
}

DI float log_gamma_of(const Params& p, int dir, int h) {
  float x = p.ret_decay[dir * 4 + h];
  return -softplusf_(-x);
}

DI void kv_item(const Params& p, int item, u16* smem, float* tabs) {
  const int tid = threadIdx.x;
  const int dvh = item & 1, cc = (item >> 1) % 66, bh = (item >> 1) / 66, h = bh & 3, b = bh >> 2;
  const float lgf = log_gamma_of(p, 0, h), lgb = log_gamma_of(p, 1, h);
  __syncthreads();
  if (tid < 128) {
    tabs[tid] = __expf(lgf * (float)(127 - tid));
    tabs[128 + tid] = __expf(lgb * (float)tid);
  }
  __syncthreads();
  const u16* KT = (const u16*)(p.ws + OFF_KT);
  const u16* VT = (const u16*)(p.ws + OFF_VT);
  const u16 *asrc, *bsrc;
  long ld;
  if (cc < 2) {
    asrc = VT + (size_t)4 * 1024 * LS + ((long)(b * 1024 + h * 256 + dvh * 128)) * LCX + cc * 128;
    bsrc = KT + (size_t)4 * 512 * LS + ((long)(b * 512 + h * 128)) * LCX + cc * 128;
    ld = LCX;
  } else {
    asrc = VT + ((long)(b * 1024 + h * 256 + dvh * 128)) * LS + (cc - 2) * 128;
    bsrc = KT + ((long)(b * 512 + h * 128)) * LS + (cc - 2) * 128;
    ld = LS;
  }
#pragma unroll 1
  for (int dir = 0; dir < 2; ++dir) {
    __syncthreads();
    build_resident<2>(smem, asrc, ld, tabs + dir * 128);
    f32x4 acc[4][4];
    zero_acc(acc);
    mma_loop<true>(acc, nullptr, 0, bsrc, ld, 128, smem, Ident{});
    const int bhd = (b * 4 + h) * 2 + dir;
    u16* dst = cc < 2 ? (u16*)(p.ws + OFF_KVC) + ((long)(bhd * 2 + cc)) * 32768 + dvh * 128 * 128
                      : (u16*)p.out + ((long)bhd * 64 + (cc - 2)) * 32768 + dvh * 128 * 128;
    acc_to_lds(acc, (float*)smem);
    __syncthreads();
    tile_store_bf16((const float*)smem, dst, 128);
  }
}

DI void state_scan(const Params& p) {
  const long gtid = (long)blockIdx.x * blockDim.x + threadIdx.x;
  const long gstride = (long)gridDim.x * blockDim.x;
  for (long idx = gtid; idx < 32L * 4096; idx += gstride) {
    const int e8 = (int)(idx & 4095), bhd = (int)(idx >> 12);
    const int dir = bhd & 1, h = (bhd >> 1) & 3;
    const float cd = __expf(log_gamma_of(p, dir, h) * 128.f);
    float acc[8];
#pragma unroll
    for (int e = 0; e < 8; ++e) acc[e] = 0.f;
    const u16* kvc = (const u16*)(p.ws + OFF_KVC) + (long)bhd * 2 * 32768 + e8 * 8;
#pragma unroll
    for (int s = 0; s < 2; ++s) {
      int cc = dir == 0 ? s : 1 - s;
      uint4 kv = *(const uint4*)(kvc + (long)cc * 32768);
      acc[0] = cd * acc[0] + lo2f(kv.x); acc[1] = cd * acc[1] + hi2f(kv.x);
      acc[2] = cd * acc[2] + lo2f(kv.y); acc[3] = cd * acc[3] + hi2f(kv.y);
      acc[4] = cd * acc[4] + lo2f(kv.z); acc[5] = cd * acc[5] + hi2f(kv.z);
      acc[6] = cd * acc[6] + lo2f(kv.w); acc[7] = cd * acc[7] + hi2f(kv.w);
    }
    u16* base = (u16*)p.out + (long)bhd * 64 * 32768 + e8 * 8;
    const long cstep = dir == 0 ? 32768 : -32768;
    u16* cur = base + (long)(dir == 0 ? 0 : 63) * 32768;
    uint4 k0 = *(const uint4*)(cur), k1 = *(const uint4*)(cur + cstep), k2 = *(const uint4*)(cur + 2 * cstep), k3 = *(const uint4*)(cur + 3 * cstep);
#define SCAN_STEP(KV, s)                                                                       \
    {                                                                                          \
      uint4 kv = KV;                                                                           \
      if ((s) + 4 < 64) KV = *(const uint4*)(cur + 4 * cstep);                                 \
      uint4 o;                                                                                 \
      o.x = pack2(acc[0], acc[1]); o.y = pack2(acc[2], acc[3]); o.z = pack2(acc[4], acc[5]); o.w = pack2(acc[6], acc[7]); \
      *(uint4*)(cur) = o;                                                                      \
      acc[0] = cd * acc[0] + lo2f(kv.x); acc[1] = cd * acc[1] + hi2f(kv.x);                    \
      acc[2] = cd * acc[2] + lo2f(kv.y); acc[3] = cd * acc[3] + hi2f(kv.y);                    \
      acc[4] = cd * acc[4] + lo2f(kv.z); acc[5] = cd * acc[5] + hi2f(kv.z);                    \
      acc[6] = cd * acc[6] + lo2f(kv.w); acc[7] = cd * acc[7] + hi2f(kv.w);                    \
      cur += cstep;                                                                            \
    }
#pragma unroll 1
    for (int s = 0; s < 64; s += 4) {
      SCAN_STEP(k0, s)
      SCAN_STEP(k1, s + 1)
      SCAN_STEP(k2, s + 2)
      SCAN_STEP(k3, s + 3)
    }
#undef SCAN_STEP
  }
}

DI float one_minus_exp(float x) {
  float ser = -x * (1.f + x * (0.5f + x * (0.16666667f + x * (0.041666668f + x * 0.008333334f))));
  return x > -0.25f ? ser : 1.f - __expf(x);
}

DI void lru_tile(const Params& p, int cid, int blk, int nh, int mode, u16* smem) {
  const int tid = threadIdx.x, lane = tid & 63, wid = tid >> 6, wm = wid >> 1, wn = wid & 1, fr = lane & 15, fq = lane >> 4;
  const u16* P4 = (const u16*)(p.ws + OFF_P4);
  const u16* WAT = (const u16*)(p.ws + OFF_WAT);
  float* LA = (float*)(p.ws + OFF_LA);
  float* LB = (float*)(p.ws + OFF_LB);
  const float* LH = (const float*)(p.ws + OFF_LH);
  u16* Y = (u16*)(p.ws + OFF_Y);
  const long r0 = (long)cid * 128;
  long seq_lo, seq_hi;
  if (cid < 256) { seq_lo = (long)(cid / 64) * LS; seq_hi = seq_lo + LS; }
  else { seq_lo = NTOK + (long)((cid - 256) / 2) * LCX; seq_hi = seq_lo + LCX; }
  __syncthreads();
  {
    const int cv = (tid & 15) * 8;
    const int chc = blk * 128 + cv;
    float cw[4][8], cb8[8];
    {
      float4 b0 = *(const float4*)(p.conv_b + chc), b1 = *(const float4*)(p.conv_b + chc + 4);
      cb8[0] = b0.x; cb8[1] = b0.y; cb8[2] = b0.z; cb8[3] = b0.w; cb8[4] = b1.x; cb8[5] = b1.y; cb8[6] = b1.z; cb8[7] = b1.w;
#pragma unroll
      for (int tap = 0; tap < 4; ++tap) {
        float4 w0 = *(const float4*)(p.conv_w + tap * 1024 + chc), w1 = *(const float4*)(p.conv_w + tap * 1024 + chc + 4);
        cw[tap][0] = w0.x; cw[tap][1] = w0.y; cw[tap][2] = w0.z; cw[tap][3] = w0.w;
        cw[tap][4] = w1.x; cw[tap][5] = w1.y; cw[tap][6] = w1.z; cw[tap][7] = w1.w;
      }
    }
#pragma unroll 4
    for (int i = 0; i < 8; ++i) {
      const int row = (tid >> 4) + i * 16;
      uint4 v[4];
#pragma unroll
      for (int tap = 0; tap < 4; ++tap) {
        long rr = r0 + row + tap - 2;
        v[tap] = (rr >= seq_lo && rr < seq_hi) ? *(const uint4*)(P4 + rr * 1024 + chc) : make_uint4(0u, 0u, 0u, 0u);
      }
      float u[8];
#pragma unroll
      for (int e = 0; e < 8; ++e) u[e] = cb8[e];
#pragma unroll
      for (int tap = 0; tap < 4; ++tap) {
        u[0] += lo2f(v[tap].x) * cw[tap][0]; u[1] += hi2f(v[tap].x) * cw[tap][1];
        u[2] += lo2f(v[tap].y) * cw[tap][2]; u[3] += hi2f(v[tap].y) * cw[tap][3];
        u[4] += lo2f(v[tap].z) * cw[tap][4]; u[5] += hi2f(v[tap].z) * cw[tap][5];
        u[6] += lo2f(v[tap].w) * cw[tap][6]; u[7] += hi2f(v[tap].w) * cw[tap][7];
      }
      uint4 o;
      o.x = pack2(u[0], u[1]); o.y = pack2(u[2], u[3]); o.z = pack2(u[4], u[5]); o.w = pack2(u[6], u[7]);
      *(uint4*)(smem + row * 144 + cv) = o;
    }
  }
  u16* sW = smem + 128 * 144;
  float* abuf = (float*)(smem + 128 * 144);
  float* bbuf = abuf + 64 * 65;
  float* sg = bbuf + 64 * 65;
  const int ch = tid & 63, sgi = tid >> 6;
  const long chg = (long)blk * 128 + nh * 64 + ch;
#pragma unroll 1
  for (int dir = 0; dir < 2; ++dir) {
    f32x4 acc[2][4][2];
    __syncthreads();
#pragma unroll 1
    for (int i0 = 0; i0 < 8; i0 += 4) {
      uint4 v[4];
#pragma unroll
      for (int i = 0; i < 4; ++i) {
        int c = tid + (i0 + i) * 256;
        int g = c >> 10, cc = c & 1023, row = cc >> 4, kc = (cc & 15) * 8;
        v[i] = *(const uint4*)(WAT + (long)((dir * 2 + g) * 8 + blk) * 16384 + (nh * 64 + row) * 128 + kc);
      }
#pragma unroll
      for (int i = 0; i < 4; ++i) {
        int c = tid + (i0 + i) * 256;
        int g = c >> 10, cc = c & 1023, row = cc >> 4, kc = (cc & 15) * 8;
        *(uint4*)(sW + g * (64 * 144) + row * 144 + kc) = v[i];
      }
    }
    __syncthreads();
#pragma unroll
    for (int g = 0; g < 2; ++g) {
      zero_acc(acc[g]);
#pragma unroll
      for (int ks = 0; ks < 4; ++ks) {
        bf16x8 af[4];
#pragma unroll
        for (int mi = 0; mi < 4; ++mi) af[mi] = *(const bf16x8*)(smem + (wm * 64 + mi * 16 + fr) * 144 + ks * 32 + fq * 8);
#pragma unroll
        for (int ni = 0; ni < 2; ++ni) {
          bf16x8 bq = *(const bf16x8*)(sW + g * (64 * 144) + (wn * 32 + ni * 16 + fr) * 144 + ks * 32 + fq * 8);
#pragma unroll
          for (int mi = 0; mi < 4; ++mi)
            acc[g][mi][ni] = __builtin_amdgcn_mfma_f32_16x16x32_bf16(af[mi], bq, acc[g][mi][ni], 0, 0, 0);
        }
      }
    }
#pragma unroll
    for (int ni = 0; ni < 2; ++ni) {
      int cl = wn * 32 + ni * 16 + fr;
      int chn = blk * 128 + nh * 64 + cl;
      float ba = p.lru_ba[dir * 1024 + chn], bx = p.lru_bx[dir * 1024 + chn];
      float spl = softplusf_(-p.lru_lambda[dir * 1024 + chn]);
#pragma unroll
      for (int mi = 0; mi < 4; ++mi)
#pragma unroll
        for (int j = 0; j < 4; ++j) {
          int r = wm * 64 + mi * 16 + fq * 4 + j;
          float rg = sigmoidf_(acc[0][mi][ni][j] + ba);
          float ig = sigmoidf_(acc[1][mi][ni][j] + bx);
          float la = -8.f * rg * spl;
          float a = __expf(la);
          float uu = bf2f(smem[r * 144 + nh * 64 + cl]);
          float x2 = 2.f * la;
          float ser = -x2 * (1.f + x2 * (0.5f + x2 * (0.16666667f + x2 * (0.041666668f + x2 * 0.008333334f))));
          float bt = __builtin_amdgcn_sqrtf(x2 > -0.25f ? ser : 1.f - a * a) * (ig * uu);
          acc[0][mi][ni][j] = a;
          acc[1][mi][ni][j] = bt;
        }
    }
    float cP = 1.f, cQ = 0.f;
    if (mode == 1) cQ = LH[((long)dir * NCHUNK + cid) * 1024 + chg];
#pragma unroll
    for (int half = 0; half < 2; ++half) {
      const int hw = dir == 0 ? half : 1 - half;
      __syncthreads();
      if (wm == hw) {
#pragma unroll
        for (int mi = 0; mi < 4; ++mi)
#pragma unroll
          for (int ni = 0; ni < 2; ++ni)
#pragma unroll
            for (int j = 0; j < 4; ++j) {
              int lr = mi * 16 + fq * 4 + j, cl = wn * 32 + ni * 16 + fr;
              abuf[lr * 65 + cl] = acc[0][mi][ni][j];
              bbuf[lr * 65 + cl] = acc[1][mi][ni][j];
            }
      }
      __syncthreads();
      {
        float P = 1.f, Q = 0.f;
#pragma unroll
        for (int s = 0; s < 16; ++s) {
          int pos = sgi * 16 + s;
          int lr = dir == 0 ? pos : 63 - pos;
          float a = abuf[lr * 65 + ch], bb = bbuf[lr * 65 + ch];
          P *= a;
          Q = a * Q + bb;
        }
        sg[(sgi * 64 + ch) * 2] = P;
        sg[(sgi * 64 + ch) * 2 + 1] = Q;
      }
      __syncthreads();
      if (mode == 0) {
#pragma unroll
        for (int k = 0; k < 4; ++k) {
          float pk = sg[(k * 64 + ch) * 2], qk = sg[(k * 64 + ch) * 2 + 1];
          cQ = pk * cQ + qk;
          cP *= pk;
        }
      } else {
        float h = cQ;
#pragma unroll
        for (int k = 0; k < 4; ++k) {
          float pk = sg[(k * 64 + ch) * 2], qk = sg[(k * 64 + ch) * 2 + 1];
          if (k < sgi) h = pk * h + qk;
          cQ = pk * cQ + qk;
        }
#pragma unroll
        for (int s = 0; s < 16; ++s) {
          int pos = sgi * 16 + s;
          int lr = dir == 0 ? pos : 63 - pos;
          float a = abuf[lr * 65 + ch], bb = bbuf[lr * 65 + ch];
          h = a * h + bb;
          bbuf[lr * 65 + ch] = h;
        }
        __syncthreads();
#pragma unroll 1
        for (int i = 0; i < 2; ++i) {
          int idx = tid + i * 256;
          int row = idx >> 3, c8 = (idx & 7) * 8;
          const float* hp = bbuf + row * 65 + c8;
          float4 h0 = make_float4(hp[0], hp[1], hp[2], hp[3]), h1 = make_float4(hp[4], hp[5], hp[6], hp[7]);
          u16* yp = Y + (r0 + hw * 64 + row) * 1024 + blk * 128 + nh * 64 + c8;
          if (dir == 1) {
            uint4 y = *(const uint4*)yp;
            h0.x += lo2f(y.x); h0.y += hi2f(y.x); h0.z += lo2f(y.y); h0.w += hi2f(y.y);
            h1.x += lo2f(y.z); h1.y += hi2f(y.z); h1.z += lo2f(y.w); h1.w += hi2f(y.w);
          }
          *(uint4*)yp = pack8(h0, h1);
        }
      }
    }
    if (mode == 0 && sgi == 0) {
      LA[((long)dir * NCHUNK + cid) * 1024 + chg] = cP;
      LB[((long)dir * NCHUNK + cid) * 1024 + chg] = cQ;
    }
  }
}

DI void phase3(const Params& p, u16* smem, float* tabs) {
#ifndef REP_SUB
#define REP_SUB 0
#endif
  for (int rep = 0; rep <= (REP_SUB & 1); ++rep)
    for (int t = blockIdx.x; t < 2112; t += gridDim.x) kv_item(p, t, smem, tabs);
  for (int rep = 0; rep <= ((REP_SUB >> 1) & 1); ++rep)
    for (int u = blockIdx.x; u < NCHUNK * 16; u += gridDim.x) lru_tile(p, u >> 4, (u >> 1) & 7, u & 1, 0, smem);
}

DI void lru_cross(const Params& p) {
  const long gtid = (long)blockIdx.x * blockDim.x + threadIdx.x;
  if (gtid >= 8192) return;
  const int ch = (int)(gtid & 1023), b = (int)((gtid >> 10) & 3), dir = (int)(gtid >> 12);
  const float* LA = (const float*)(p.ws + OFF_LA) + (long)dir * NCHUNK * 1024;
  const float* LB = (const float*)(p.ws + OFF_LB) + (long)dir * NCHUNK * 1024;
  float* LH = (float*)(p.ws + OFF_LH) + (long)dir * NCHUNK * 1024;
  float h = 0.f;
  for (int s = 0; s < 2; ++s) {
    int cid = 256 + b * 2 + (dir == 0 ? s : 1 - s);
    h = LA[(long)cid * 1024 + ch] * h + LB[(long)cid * 1024 + ch];
  }
  for (int s = 0; s < 64; ++s) {
    int cid = b * 64 + (dir == 0 ? s : 63 - s);
    LH[(long)cid * 1024 + ch] = h;
    h = LA[(long)cid * 1024 + ch] * h + LB[(long)cid * 1024 + ch];
  }
}

DI void ret_out_item(const Params& p, int item, u16* smem, float* tabs) {
  const int tid = threadIdx.x, lane = tid & 63, wid = tid >> 6, wm = wid >> 1, wn = wid & 1, fr = lane & 15, fq = lane >> 4;
  const int half = item & 1, c = (item >> 1) & 63, h = (item >> 7) & 3, b = item >> 9;
  const float lgf = log_gamma_of(p, 0, h), lgb = log_gamma_of(p, 1, h);
  __syncthreads();
  for (int i = tid; i < 129; i += 256) {
    tabs[i] = __expf(lgf * (float)i);
    tabs[129 + i] = __expf(lgb * (float)i);
  }
  if (tid < 128) {
    tabs[258 + tid] = __expf(lgf * (float)(tid + 1));
    tabs[386 + tid] = __expf(lgb * (float)(128 - tid));
  }
  __syncthreads();
  const u16* Q = (const u16*)(p.ws + OFF_Q);
  const u16* Kb = (const u16*)(p.ws + OFF_K);
  const u16* VT = (const u16*)(p.ws + OFF_VT);
  const u16* ST = (const u16*)p.out;
  u16* O = (u16*)(p.ws + OFF_O);
  float* STATS = (float*)(p.ws + OFF_STATS);
  const long row0 = ((long)b * 64 + c) * 128;
  f32x4 ao[4][4];
  zero_acc(ao);
  mma_loop<false>(ao, Q + row0 * 512 + h * 128, 512, Kb + row0 * 512 + h * 128, 512, 128, smem, Ident{});
  const float ddbase = (float)(wm * 64 - wn * 64 + fq * 4 - fr);
#pragma unroll
  for (int mi = 0; mi < 4; ++mi)
#pragma unroll
    for (int ni = 0; ni < 4; ++ni)
#pragma unroll
      for (int j = 0; j < 4; ++j) {
        int i = wm * 64 + mi * 16 + fq * 4 + j, jj = wn * 64 + ni * 16 + fr;
        float dd = ddbase + (float)((mi - ni) * 16 + j);
        float d = __expf(dd >= 0.f ? lgf * dd : -lgb * dd);
        smem[i * 144 + jj] = f2bf(ao[mi][ni][j] * d);
      }
  zero_acc(ao);
#pragma unroll 1
  for (int seg = 0; seg < 3; ++seg) {
    const u16* Bt;
    long ldb;
    if (seg == 0) {
      Bt = VT + ((long)(b * 1024 + h * 256 + half * 128)) * LS + c * 128;
      ldb = LS;
    } else {
      const int dir = seg - 1;
      build_resident<1>(smem, Q + row0 * 512 + h * 128, 512, tabs + 258 + dir * 128);
      Bt = ST + ((((long)(b * 4 + h) * 2 + dir) * 64 + c) * 256 + half * 128) * 128;
      ldb = 128;
    }
    mma_loop<true>(ao, nullptr, 0, Bt, ldb, 128, smem, Ident{});
  }
  float* T = (float*)smem;
  acc_to_lds(ao, T);
  __syncthreads();
#pragma unroll 1
  for (int i = 0; i < 8; ++i) {
    int idx = tid + i * 256;
    int r = idx >> 4, c0 = (idx & 15) * 8;
    float4 a = *(const float4*)(T + r * 132 + c0), bq = *(const float4*)(T + r * 132 + c0 + 4);
    uint4 o = pack8(a, bq);
    *(uint4*)(O + (row0 + r) * 1024 + h * 256 + half * 128 + c0) = o;
    float v0 = lo2f(o.x), v1 = hi2f(o.x), v2 = lo2f(o.y), v3 = hi2f(o.y), v4 = lo2f(o.z), v5 = hi2f(o.z), v6 = lo2f(o.w), v7 = hi2f(o.w);
    float s1 = v0 + v1 + v2 + v3 + v4 + v5 + v6 + v7;
    float s2 = v0 * v0 + v1 * v1 + v2 * v2 + v3 * v3 + v4 * v4 + v5 * v5 + v6 * v6 + v7 * v7;
#pragma unroll
    for (int o2 = 1; o2 < 16; o2 <<= 1) {
      s1 += __shfl_xor(s1, o2);
      s2 += __shfl_xor(s2, o2);
    }
    if ((idx & 15) == 0) {
      float* st = STATS + ((row0 + r) * 4 + h) * 4 + half * 2;
      st[0] = s1;
      st[1] = s2;
    }
  }
}

DI void phase4(const Params& p) {
  lru_cross(p);
  state_scan(p);
}

DI void phase5(const Params& p, u16* smem, float* tabs) {
  for (int rep = 0; rep <= ((REP_SUB >> 2) & 1); ++rep)
    for (int t = blockIdx.x; t < 2048; t += gridDim.x) ret_out_item(p, t, smem, tabs);
  for (int rep = 0; rep <= ((REP_SUB >> 3) & 1); ++rep)
    for (int u = blockIdx.x; u < 256 * 16; u += gridDim.x) lru_tile(p, u >> 4, (u >> 1) & 7, u & 1, 1, smem);
}

DI void phase_gemm_b(const Params& p, u16* smem) {
  const int tid = threadIdx.x, lane = tid & 63, wid = tid >> 6, wm = wid >> 1, wn = wid & 1, fr = lane & 15, fq = lane >> 4;
  const u16* hx = (const u16*)(p.ws + OFF_HX);
  const u16* wt = (const u16*)(p.ws + OFF_WTIN);
  u16* O = (u16*)(p.ws + OFF_O);
  u16* Y = (u16*)(p.ws + OFF_Y);
  u16* S6 = (u16*)(p.ws + OFF_VT);
  u16* S7 = (u16*)(p.ws + OFF_P4);
  int mt2, nt;
  for (int it = 0; tile_at(it, 128, 32, mt2, nt); ++it) {
    const int seg = nt >> 3;
    const int wrow0 = (seg == 0 ? 2048 : 4096 + (seg - 1) * 1024) + (nt & 7) * 128;
    f32x4 acc[4][8];
    zero_big(acc);
    mma_big3(acc, hx + (long)mt2 * 256 * 1024, wt + (long)wrow0 * 1024, smem);
    u16* dst = seg == 0 ? O : (seg == 1 ? Y : (seg == 2 ? S6 : S7));
    const float* STATS = (const float*)(p.ws + OFF_STATS);
    float* T = (float*)smem;
#pragma unroll 1
   for (int h = 0; h < 2; ++h) {
    const long row0 = (long)(mt2 * 2 + h) * 128;
    __syncthreads();
    big_to_lds(acc, T, h);
    __syncthreads();
#pragma unroll 1
    for (int i = 0; i < 8; ++i) {
      int idx = tid + i * 256;
      int r = idx >> 4, c0 = (idx & 15) * 8;
      float v[8];
      {
        float4 a = *(const float4*)(T + r * 132 + c0), bq = *(const float4*)(T + r * 132 + c0 + 4);
        v[0] = a.x; v[1] = a.y; v[2] = a.z; v[3] = a.w; v[4] = bq.x; v[5] = bq.y; v[6] = bq.z; v[7] = bq.w;
      }
      long ad = (row0 + r) * 1024 + (nt & 7) * 128 + c0;
      float o[8];
      if (seg >= 2) {
#pragma unroll
        for (int e = 0; e < 8; ++e) o[e] = sigmoidf_(v[e]);
      } else {
        uint4 d = *(const uint4*)(dst + ad);
        float dv[8] = {lo2f(d.x), hi2f(d.x), lo2f(d.y), hi2f(d.y), lo2f(d.z), hi2f(d.z), lo2f(d.w), hi2f(d.w)};
        if (seg == 0) {
          float4 st = *(const float4*)(STATS + ((row0 + r) * 4 + ((nt & 7) >> 1)) * 4);
          float mu = (st.x + st.z) * (1.f / 256.f);
          float var = fmaxf((st.y + st.w) * (1.f / 256.f) - mu * mu, 0.f);
          float rstd = rsqrtf(var + EPSV);
#pragma unroll
          for (int e = 0; e < 8; ++e) o[e] = (dv[e] - mu) * rstd * siluf_(v[e]);
        } else {
#pragma unroll
          for (int e = 0; e < 8; ++e) o[e] = dv[e] * geluf_(v[e]);
        }
      }
      uint4 ov;
      ov.x = pack2(o[0], o[1]); ov.y = pack2(o[2], o[3]); ov.z = pack2(o[4], o[5]); ov.w = pack2(o[6], o[7]);
      *(uint4*)(dst + ad) = ov;
    }
   }
  }
}

DI void phase_gemm_c(const Params& p, u16* smem) {
  const int tid = threadIdx.x, lane = tid & 63, wid = tid >> 6, wm = wid >> 1, wn = wid & 1, fr = lane & 15, fq = lane >> 4;
  const u16* A3 = (const u16*)(p.ws + OFF_O);
  const u16* A5 = (const u16*)(p.ws + OFF_Y);
  const u16* S6 = (const u16*)(p.ws + OFF_VT);
  const u16* S7 = (const u16*)(p.ws + OFF_P4);
  const u16* wro = (const u16*)(p.ws + OFF_WTRO);
  const u16* wlo = (const u16*)(p.ws + OFF_WTLO);
  u16* YM = (u16*)(p.ws + OFF_HX);
  int mt2, nt;
  for (int it = 0; tile_at(it, 128, 8, mt2, nt); ++it) {
    f32x4 a1[4][8];
    float* T = (float*)smem;
    zero_big(a1);
    mma_big3(a1, A3 + (long)mt2 * 256 * 1024, wro + (long)nt * 128 * 1024, smem);
#pragma unroll 1
    for (int h = 0; h < 2; ++h) {
      const long row0 = (long)(mt2 * 2 + h) * 128;
      __syncthreads();
      big_to_lds(a1, T, h);
      __syncthreads();
#pragma unroll 1
      for (int i = 0; i < 8; ++i) {
        int idx = tid + i * 256;
        int r = idx >> 4, c0 = (idx & 15) * 8;
        float4 a = *(const float4*)(T + r * 132 + c0), bq = *(const float4*)(T + r * 132 + c0 + 4);
        long ad = (row0 + r) * 1024 + nt * 128 + c0;
        uint4 g = *(const uint4*)(S6 + ad);
        a.x *= lo2f(g.x); a.y *= hi2f(g.x); a.z *= lo2f(g.y); a.w *= hi2f(g.y);
        bq.x *= lo2f(g.z); bq.y *= hi2f(g.z); bq.z *= lo2f(g.w); bq.w *= hi2f(g.w);
        *(uint4*)(YM + ad) = pack8(a, bq);
      }
    }
    zero_big(a1);
    mma_big3(a1, A5 + (long)mt2 * 256 * 1024, wlo + (long)nt * 128 * 1024, smem);
#pragma unroll 1
    for (int h = 0; h < 2; ++h) {
      const long row0 = (long)(mt2 * 2 + h) * 128;
      __syncthreads();
      big_to_lds(a1, T, h);
      __syncthreads();
#pragma unroll 1
      for (int i = 0; i < 8; ++i) {
        int idx = tid + i * 256;
        int r = idx >> 4, c0 = (idx & 15) * 8;
        float4 a = *(const float4*)(T + r * 132 + c0), bq = *(const float4*)(T + r * 132 + c0 + 4);
        long ad = (row0 + r) * 1024 + nt * 128 + c0;
        uint4 g = *(const uint4*)(S7 + ad);
        uint4 y = *(const uint4*)(YM + ad);
        a.x = lo2f(y.x) + a.x * lo2f(g.x); a.y = hi2f(y.x) + a.y * hi2f(g.x); a.z = lo2f(y.y) + a.z * lo2f(g.y); a.w = hi2f(y.y) + a.w * hi2f(g.y);
        bq.x = lo2f(y.z) + bq.x * lo2f(g.z); bq.y = hi2f(y.z) + bq.y * hi2f(g.z); bq.z = lo2f(y.w) + bq.z * lo2f(g.w); bq.w = hi2f(y.w) + bq.w * hi2f(g.w);
        *(uint4*)(YM + ad) = pack8(a, bq);
      }
    }
  }
}

DI void phase_gemm_d(const Params& p, u16* smem) {
  const int tid = threadIdx.x, lane = tid & 63, wid = tid >> 6, wm = wid >> 1, wn = wid & 1, fr = lane & 15, fq = lane >> 4;
  const u16* YM = (const u16*)(p.ws + OFF_HX);
  const u16* wo = (const u16*)(p.ws + OFF_WTO);
  const float* mod = (const float*)(p.ws + OFF_MOD);
  int mt2, nt;
  for (int it = 0; tile_at(it, 128, 8, mt2, nt); ++it) {
    const int b = mt2 / 32;
    f32x4 acc[4][8];
    zero_big(acc);
    mma_big3(acc, YM + (long)mt2 * 256 * 1024, wo + (long)nt * 128 * 1024, smem);
    float* T = (float*)smem;
#pragma unroll 1
   for (int h = 0; h < 2; ++h) {
    const long row0 = (long)(mt2 * 2 + h) * 128;
    __syncthreads();
    big_to_lds(acc, T, h);
    __syncthreads();
#pragma unroll 1
    for (int i = 0; i < 8; ++i) {
      int idx = tid + i * 256;
      int r = idx >> 4, c0 = (idx & 15) * 8;
      float4 a = *(const float4*)(T + r * 132 + c0), bq = *(const float4*)(T + r * 132 + c0 + 4);
      long ad = (row0 + r) * 1024 + nt * 128 + c0;
      float4 ga = *(const float4*)(mod + b * 6144 + 2048 + nt * 128 + c0), gb = *(const float4*)(mod + b * 6144 + 2048 + nt * 128 + c0 + 4);
      float4 xa = *(const float4*)(p.x + ad), xb = *(const float4*)(p.x + ad + 4);
      a.x = xa.x + ga.x * a.x; a.y = xa.y + ga.y * a.y; a.z = xa.z + ga.z * a.z; a.w = xa.w + ga.w * a.w;
      bq.x = xb.x + gb.x * bq.x; bq.y = xb.y + gb.y * bq.y; bq.z = xb.z + gb.z * bq.z; bq.w = xb.w + gb.w * bq.w;
      *(float4*)(p.out + ad) = a;
      *(float4*)(p.out + ad + 4) = bq;
    }
   }
  }
}

DI void phase_gemm_e(const Params& p, u16* smem) {
  const int tid = threadIdx.x, lane = tid & 63, wid = tid >> 6, wm = wid >> 1, wn = wid & 1, fr = lane & 15, fq = lane >> 4;
  const u16* HX2 = (const u16*)(p.ws + OFF_O);
  const u16* wq = (const u16*)(p.ws + OFF_WTQ);
  u16* QP = (u16*)(p.ws + OFF_Q);
  int mt2, nt;
  for (int it = 0; tile_at(it, 128, 8, mt2, nt); ++it) {
    f32x4 acc[4][8];
    zero_big(acc);
    mma_big3(acc, HX2 + (long)mt2 * 256 * 1024, wq + (long)nt * 128 * 1024, smem);
#pragma unroll 1
    for (int h = 0; h < 2; ++h) {
      const long row0 = (long)(mt2 * 2 + h) * 128;
      __syncthreads();
      big_to_lds(acc, (float*)smem, h);
      __syncthreads();
      tile_store_bf16((const float*)smem, QP + row0 * 1024 + nt * 128, 1024);
    }
  }
}

DI void ins16(float (&L)[16], float v) {
#pragma unroll
  for (int j = 15; j >= 1; --j) L[j] = __builtin_amdgcn_fmed3f(L[j - 1], L[j], v);
  L[0] = fmaxf(L[0], v);
}

DI void phase_peer_topk(const Params& p, u16* smem) {
  const int tid = threadIdx.x, lane = tid & 63, wid = tid >> 6, wm = wid >> 1, wn = wid & 1, fr = lane & 15, fq = lane >> 4;
  const u16* QP = (const u16*)(p.ws + OFF_Q);
  const u16* KEYS = (const u16*)(p.ws + OFF_KEYS);
  int* PIDX = (int*)(p.ws + OFF_KT);
  float* PG = (float*)(p.ws + OFF_KT + (size_t)NTOK * 128 * 4);
  float* sc = (float*)smem;
  const float NINF = -__builtin_inff();
  int mt, h;
  for (int it = 0; tile_at(it, 256, 8, mt, h); ++it) {
    const long row0 = (long)mt * 128;
    float L1[16], L2[16];
#pragma unroll
    for (int j = 0; j < 16; ++j) { L1[j] = NINF; L2[j] = NINF; }
#pragma unroll
    for (int ph = 0; ph < 2; ++ph) {
      f32x4 acc[4][4];
      zero_acc(acc);
      mma_loop<false>(acc, QP + row0 * 1024 + h * 128 + ph * 64, 1024, KEYS + (long)((h * 2 + ph) * 128) * 64, 64, 64, smem, Ident{});
#pragma unroll
      for (int mi = 0; mi < 4; ++mi)
#pragma unroll
        for (int ni = 0; ni < 4; ++ni)
#pragma unroll
          for (int j = 0; j < 4; ++j) {
            int r = wm * 64 + mi * 16 + fq * 4 + j, cl = wn * 64 + ni * 16 + fr;
            sc[r * 129 + cl] = acc[mi][ni][j];
          }
      __syncthreads();
      {
        const int row = tid & 127, kh = tid >> 7;
        float Lt[16];
#pragma unroll
        for (int j = 0; j < 16; ++j) Lt[j] = NINF;
        for (int kk = 0; kk < 64; ++kk) {
          const int k = kh * 64 + kk;
          float v = sc[row * 129 + k];
          v = __uint_as_float((__float_as_uint(v) & ~0x7Fu) | (unsigned)k);
          ins16(Lt, v);
        }
        if (kh == 1) {
#pragma unroll
          for (int j = 0; j < 16; ++j) sc[row * 129 + 64 + j] = Lt[j];
        }
        __syncthreads();
        if (kh == 0) {
#pragma unroll
          for (int j = 0; j < 16; ++j) ins16(Lt, sc[row * 129 + 64 + j]);
#pragma unroll
          for (int j = 0; j < 16; ++j) {
            if (ph == 0) L1[j] = Lt[j];
            else L2[j] = Lt[j];
          }
        }
      }
    }
    if (tid < 128) {
      int* myrow = (int*)(sc + tid * 129);
      float C[16];
#pragma unroll
      for (int j = 0; j < 16; ++j) {
        C[j] = NINF;
        myrow[j] = (int)(__float_as_uint(L1[j]) & 0x7Fu);
        myrow[16 + j] = (int)(__float_as_uint(L2[j]) & 0x7Fu);
      }
#pragma unroll
      for (int a = 0; a < 16; ++a)
#pragma unroll
        for (int b = 0; b < 16; ++b)
          if ((a + 1) * (b + 1) <= 16) {
            float s = __uint_as_float(__float_as_uint(L1[a]) & ~0x7Fu) + __uint_as_float(__float_as_uint(L2[b]) & ~0x7Fu);
            s = __uint_as_float((__float_as_uint(s) & ~0xFFu) | (unsigned)(a * 16 + b));
            ins16(C, s);
          }
      float m = __uint_as_float(__float_as_uint(C[0]) & ~0xFFu);
      float w[16];
      float sum = 0.f;
#pragma unroll
      for (int k = 0; k < 16; ++k) {
        w[k] = __expf(__uint_as_float(__float_as_uint(C[k]) & ~0xFFu) - m);
        sum += w[k];
      }
      float rs = 1.f / sum;
      long base = (row0 + tid) * 128 + h * 16;
#pragma unroll
      for (int k = 0; k < 16; ++k) {
        unsigned ab = __float_as_uint(C[k]) & 0xFFu;
        int e = myrow[ab >> 4] * 128 + myrow[16 + (ab & 15)];
        PIDX[base + k] = e;
        PG[base + k] = w[k] * rs;
      }
    }
  }
}

DI float dotq16(uint4 q, const float* x) {
  float s = 0.f;
  s += (float)(q.x & 0xffu) * x[0] + (float)((q.x >> 8) & 0xffu) * x[1] + (float)((q.x >> 16) & 0xffu) * x[2] + (float)(q.x >> 24) * x[3];
  s += (float)(q.y & 0xffu) * x[4] + (float)((q.y >> 8) & 0xffu) * x[5] + (float)((q.y >> 16) & 0xffu) * x[6] + (float)(q.y >> 24) * x[7];
  s += (float)(q.z & 0xffu) * x[8] + (float)((q.z >> 8) & 0xffu) * x[9] + (float)((q.z >> 16) & 0xffu) * x[10] + (float)(q.z >> 24) * x[11];
  s += (float)(q.w & 0xffu) * x[12] + (float)((q.w >> 8) & 0xffu) * x[13] + (float)((q.w >> 16) & 0xffu) * x[14] + (float)(q.w >> 24) * x[15];
  return s;
}
DI void axpyq16(float* o, float c, uint4 q) {
  o[0] += c * (float)(q.x & 0xffu); o[1] += c * (float)((q.x >> 8) & 0xffu); o[2] += c * (float)((q.x >> 16) & 0xffu); o[3] += c * (float)(q.x >> 24);
  o[4] += c * (float)(q.y & 0xffu); o[5] += c * (float)((q.y >> 8) & 0xffu); o[6] += c * (float)((q.y >> 16) & 0xffu); o[7] += c * (float)(q.y >> 24);
  o[8] += c * (float)(q.z & 0xffu); o[9] += c * (float)((q.z >> 8) & 0xffu); o[10] += c * (float)((q.z >> 16) & 0xffu); o[11] += c * (float)(q.z >> 24);
  o[12] += c * (float)(q.w & 0xffu); o[13] += c * (float)((q.w >> 8) & 0xffu); o[14] += c * (float)((q.w >> 16) & 0xffu); o[15] += c * (float)(q.w >> 24);
}

template <int MODE>
DI void phase_peer_gather(const Params& p, float* outp) {
  const int lane = threadIdx.x & 63;
  const long gw = ((long)blockIdx.x * blockDim.x + threadIdx.x) >> 6;
  const long nw = ((long)gridDim.x * blockDim.x) >> 6;
  const u16* HX2 = (const u16*)(p.ws + OFF_O);
  const unsigned char* UT = p.ws + OFF_UT;
  const unsigned char* VTAB = p.ws + OFF_VTAB;
  const float* USC = (const float*)(p.ws + OFF_USC);
  const float* VSC = (const float*)(p.ws + OFF_VSC);
  const int* PIDX = (const int*)(p.ws + OFF_KT);
  const float* PG = (const float*)(p.ws + OFF_KT + (size_t)NTOK * 128 * 4);
  const float* mod = (const float*)(p.ws + OFF_MOD);
  for (long t = gw; t < NTOK; t += nw) {
    float x[16];
    float xl = 0.f;
    {
      uint4 v0 = *(const uint4*)(HX2 + t * 1024 + lane * 16);
      uint4 v1 = *(const uint4*)(HX2 + t * 1024 + lane * 16 + 8);
      x[0] = lo2f(v0.x); x[1] = hi2f(v0.x); x[2] = lo2f(v0.y); x[3] = hi2f(v0.y);
      x[4] = lo2f(v0.z); x[5] = hi2f(v0.z); x[6] = lo2f(v0.w); x[7] = hi2f(v0.w);
      x[8] = lo2f(v1.x); x[9] = hi2f(v1.x); x[10] = lo2f(v1.y); x[11] = hi2f(v1.y);
      x[12] = lo2f(v1.z); x[13] = hi2f(v1.z); x[14] = lo2f(v1.w); x[15] = hi2f(v1.w);
#pragma unroll
      for (int i = 0; i < 16; ++i) xl += x[i];
    }
    float xm = 0.f;
#pragma unroll
    for (int i = 0; i < 16; ++i) xm = fmaxf(xm, fabsf(x[i]));
#pragma unroll
    for (int o = 32; o > 0; o >>= 1) xm = fmaxf(xm, __shfl_xor(xm, o));
    xm = fmaxf(xm, 1e-30f);
    const float xinv = 127.f / xm, xsc = xm * (1.f / 127.f);
    int xq[4];
#pragma unroll
    for (int w = 0; w < 4; ++w) {
      unsigned b0 = (unsigned)((int)rintf(x[w * 4 + 0] * xinv)) & 0xffu, b1 = (unsigned)((int)rintf(x[w * 4 + 1] * xinv)) & 0xffu;
      unsigned b2 = (unsigned)((int)rintf(x[w * 4 + 2] * xinv)) & 0xffu, b3 = (unsigned)((int)rintf(x[w * 4 + 3] * xinv)) & 0xffu;
      xq[w] = (int)(b0 | (b1 << 8) | (b2 << 16) | (b3 << 24));
    }
    const int e0 = PIDX[t * 128 + lane], e1 = PIDX[t * 128 + 64 + lane];
    const float g0 = PG[t * 128 + lane], g1 = PG[t * 128 + 64 + lane];
    float d0 = 0.f, d1 = 0.f;
#pragma unroll 1
    for (int pi = 0; pi < (MODE == 2 ? 0 : 128); pi += 8) {
      uint4 ua[8];
#pragma unroll
      for (int q = 0; q < 8; ++q) {
        int e = __shfl(pi < 64 ? e0 : e1, (pi + q) & 63);
        ua[q] = *(const uint4*)(UT + (long)e * 1024 + lane * 16);
      }
      int a8[8];
#pragma unroll
      for (int q = 0; q < 8; ++q) {
        int acc = __builtin_amdgcn_sdot4((int)ua[q].x, xq[0], 0, false);
        acc = __builtin_amdgcn_sdot4((int)ua[q].y, xq[1], acc, false);
        acc = __builtin_amdgcn_sdot4((int)ua[q].z, xq[2], acc, false);
        a8[q] = __builtin_amdgcn_sdot4((int)ua[q].w, xq[3], acc, false);
      }
      {
        const bool h5 = (lane & 32) != 0, h4 = (lane & 16) != 0, h3 = (lane & 8) != 0;
        int b4[4], b2[2], b1;
#pragma unroll
        for (int i = 0; i < 4; ++i) {
          int keep = h5 ? a8[4 + i] : a8[i], send = h5 ? a8[i] : a8[4 + i];
          b4[i] = keep + __shfl_xor(send, 32);
        }
#pragma unroll
        for (int i = 0; i < 2; ++i) {
          int keep = h4 ? b4[2 + i] : b4[i], send = h4 ? b4[i] : b4[2 + i];
          b2[i] = keep + __shfl_xor(send, 16);
        }
        {
          int keep = h3 ? b2[1] : b2[0], send = h3 ? b2[0] : b2[1];
          b1 = keep + __shfl_xor(send, 8);
        }
        b1 += __shfl_xor(b1, 4);
        b1 += __shfl_xor(b1, 2);
        b1 += __shfl_xor(b1, 1);
        int got = __shfl(b1, (lane & 7) * 8);
        if ((lane >> 3) == ((pi & 63) >> 3)) {
          if (pi < 64) d0 = (float)got * xsc;
          else d1 = (float)got * xsc;
        }
      }
    }
    float* COEF = (float*)(p.ws + OFF_HX);
    float c0, c1;
    if (MODE != 2) {
      c0 = g0 * geluf_(d0 * USC[e0]) * VSC[e0];
      c1 = g1 * geluf_(d1 * USC[e1]) * VSC[e1];
      if (MODE == 1) {
        COEF[t * 128 + lane] = c0;
        COEF[t * 128 + 64 + lane] = c1;
        continue;
      }
    } else {
      c0 = COEF[t * 128 + lane];
      c1 = COEF[t * 128 + 64 + lane];
    }
    const float csum = wave_sum(c0 + c1);
    float o[16];
#pragma unroll
    for (int i = 0; i < 16; ++i) o[i] = 0.f;
#pragma unroll 1
    for (int pi = 0; pi < 128; pi += 8) {
      uint4 va[8];
      float cf[8];
#pragma unroll
      for (int q = 0; q < 8; ++q) {
        int e = __shfl(pi < 64 ? e0 : e1, (pi + q) & 63);
        cf[q] = __shfl(pi < 64 ? c0 : c1, (pi + q) & 63);
        va[q] = *(const uint4*)(VTAB + (long)e * 1024 + lane * 16);
      }
#pragma unroll
      for (int q = 0; q < 8; ++q) axpyq16(o, cf[q], va[q]);
    }
    const int b = (int)(t / LS);
    const float* g2 = mod + b * 6144 + 5120;
    const float* xr = p.out + t * 1024;
    float* xw = outp + t * 1024;
    float ss = 0.f;
#pragma unroll
    for (int q4 = 0; q4 < 4; ++q4) {
      int c = lane * 16 + q4 * 4;
      float4 xv = *(const float4*)(xr + c);
      float4 gv = *(const float4*)(g2 + c);
      float* oo = o + q4 * 4;
      oo[0] = xv.x + gv.x * (oo[0] - 128.f * csum);
      oo[1] = xv.y + gv.y * (oo[1] - 128.f * csum);
      oo[2] = xv.z + gv.z * (oo[2] - 128.f * csum);
      oo[3] = xv.w + gv.w * (oo[3] - 128.f * csum);
      ss += oo[0] * oo[0] + oo[1] * oo[1] + oo[2] * oo[2] + oo[3] * oo[3];
    }
    ss = wave_sum(ss);
    float rstd = rsqrtf(ss * (1.f / 1024.f) + EPSV);
#pragma unroll
    for (int q4 = 0; q4 < 4; ++q4) {
      int c = lane * 16 + q4 * 4;
      float4 fg = *(const float4*)(p.final_g + c);
      float* oo = o + q4 * 4;
      float4 r;
      r.x = oo[0] * rstd * fg.x;
      r.y = oo[1] * rstd * fg.y;
      r.z = oo[2] * rstd * fg.z;
      r.w = oo[3] * rstd * fg.w;
      *(float4*)(xw + c) = r;
    }
  }
}

#define XB_TMO      128
#define XB_XCNT(j)  (256  + 64 * (j))
#define XB_XSUB(j)  (1280 + 64 * (j))
#define XB_XGEN(j)  (2304 + 64 * (j))
#define XB_TOP      3328
#define XB_TOPGEN   3392
#define XCD_BAR_WORDS 3456
#define XB_SPIN_CAP (1u << 18)
#define LAS __attribute__((address_space(3)))
DI unsigned xb_ld(unsigned* p) { return __hip_atomic_load(p, __ATOMIC_RELAXED, __HIP_MEMORY_SCOPE_AGENT); }
DI unsigned xb_add(unsigned* p, unsigned v) { return __hip_atomic_fetch_add(p, v, __ATOMIC_RELAXED, __HIP_MEMORY_SCOPE_AGENT); }
DI unsigned xb_xcc_id() { return (unsigned)__builtin_amdgcn_s_getreg((3 << 11) | 20) & 0xFu; }
#define XB_SPIN(cond, bar) do { unsigned _sp = 0; while (cond) { __builtin_amdgcn_s_sleep(1); \
    if ((++_sp & 255u) == 0u) { if (xb_ld(&(bar)[XB_TMO])) break; if (_sp > XB_SPIN_CAP) { atomicAdd(&(bar)[XB_TMO], 1u); break; } } } } while (0)
struct XcdBarrier {
  unsigned* bar;
  unsigned x;
  volatile LAS unsigned* st;
};
DI XcdBarrier xcd_barrier_post(unsigned* bar, volatile LAS unsigned* st) {
  XcdBarrier b;
  b.bar = bar;
  b.x = xb_xcc_id();
  b.st = st;
  if (threadIdx.x == 0) (void)xb_add(&bar[XB_XCNT(b.x)], 1u);
  return b;
}
DI void xcd_barrier_complete(unsigned* bar, unsigned x, unsigned& nloc, unsigned& nx) {
  const unsigned G = gridDim.x * gridDim.y * gridDim.z;
  unsigned sum, cnt, mine, sp = 0u;
  for (;;) {
    sum = 0u; cnt = 0u; mine = 0u;
#pragma unroll
    for (unsigned j = 0; j < 16; ++j) {
      const unsigned c = xb_ld(&bar[XB_XCNT(j)]);
      sum += c;
      cnt += (c > 0u) ? 1u : 0u;
      mine = (j == x) ? c : mine;
    }
    if (sum == G) break;
    __builtin_amdgcn_s_sleep(1);
    if ((++sp & 255u) == 0u) {
      if (xb_ld(&bar[XB_TMO])) break;
      if (sp > XB_SPIN_CAP) { atomicAdd(&bar[XB_TMO], 1u); break; }
    }
  }
  nloc = mine > 0u ? mine : 1u;
  nx = cnt > 0u ? cnt : 1u;
}
DI void xcd_barrier(const XcdBarrier& b) {
  asm volatile("s_waitcnt vmcnt(0)" ::: "memory");
  __syncthreads();
  if (threadIdx.x == 0) {
    unsigned* bar = b.bar;
    __builtin_amdgcn_s_waitcnt(0);
    unsigned nloc = b.st[0], nx = b.st[1];
    if (nloc == 0u) { xcd_barrier_complete(bar, b.x, nloc, nx); b.st[0] = nloc; b.st[1] = nx; }
    const unsigned old = xb_add(&bar[XB_XSUB(b.x)], 1u);
    const unsigned gen = old / nloc;
    if (old + 1u == (gen + 1u) * nloc) {
      __builtin_amdgcn_fence(__ATOMIC_RELEASE, "agent");
      asm volatile("s_waitcnt vmcnt(0)" ::: "memory");
      const unsigned og = xb_add(&bar[XB_TOP], 1u);
      const unsigned tg = og / nx;
      if (og + 1u == (tg + 1u) * nx) xb_add(&bar[XB_TOPGEN], 1u);
      else XB_SPIN(xb_ld(&bar[XB_TOPGEN]) == tg, bar);
      __builtin_amdgcn_fence(__ATOMIC_ACQUIRE, "agent");
      xb_add(&bar[XB_XGEN(b.x)], 1u);
      asm volatile("s_waitcnt vmcnt(0)" ::: "memory");
    } else {
      XB_SPIN(xb_ld(&bar[XB_XGEN(b.x)]) == gen, bar);
      __builtin_amdgcn_fence(__ATOMIC_ACQUIRE, "agent");
      asm volatile("s_waitcnt vmcnt(0)" ::: "memory");
    }
  }
  __syncthreads();
}

constexpr int NPHASE = 14;

__global__ void __launch_bounds__(256, 2) mega(Params p) {
  extern __shared__ __attribute__((aligned(16))) unsigned char lds_raw[];
  u16* smem = (u16*)lds_raw;
  float* tabs = (float*)(lds_raw + LDS_MAIN);
#ifndef ONLY
#define ONLY -1
#endif
  const int lo = (int)p.ph_lo, hi = (int)p.ph_hi;
  volatile LAS unsigned* xst = (volatile LAS unsigned*)(lds_raw + LDS_MAIN + 3072);
  if (threadIdx.x == 0) { xst[0] = 0u; xst[1] = 0u; }
  __syncthreads();
  XcdBarrier xb = xcd_barrier_post((unsigned*)(p.ws + OFF_BAR), xst);
#ifndef REP_MASK
#define REP_MASK 0
#endif
#define PHS(n, call)                                        \
  if ((ONLY < 0 || ONLY == n) && lo <= n && n < hi) {       \
    if ((REP_MASK >> n) & 1) {                              \
      call;                                                 \
      cg::this_grid().sync();                               \
    }                                                       \
    call;                                                   \
    if (n + 1 < hi) {                                       \
      if (lo < 0) cg::this_grid().sync();                   \
      else xcd_barrier(xb);                                 \
    }                                                       \
  }
  PHS(0, phase_prep(p, smem))
#ifndef REP_SYNC
#define REP_SYNC 0
#endif
  for (int i = 0; i < REP_SYNC; ++i) xcd_barrier(xb);
  PHS(1, phase_norm1(p))
  PHS(2, phase_gemm_a(p, smem))
  PHS(3, phase3(p, smem, tabs))
  PHS(4, phase4(p))
  PHS(5, phase5(p, smem, tabs))
  PHS(6, phase_gemm_b(p, smem))
  PHS(7, phase_gemm_c(p, smem))
  PHS(8, phase_gemm_d(p, smem))
  PHS(9, phase_norm2(p))
  PHS(10, phase_gemm_e(p, smem))
  PHS(11, phase_peer_topk(p, smem))
#ifndef REP_GATHER
#define REP_GATHER 0
#endif
  PHS(12, phase_peer_gather<1>(p, p.out))
  PHS(13, phase_peer_gather<2>(p, p.out))
}

extern "C" void kernel_launch(void* const* d_in, const int* in_sizes, int n_in, void* d_out, int out_size, void* d_ws,
                              size_t ws_size, hipStream_t stream) {
  static int grid_blocks = 0;
  if (!grid_blocks) {
    int dev = 0, cus = 0, per_cu = 0;
    hipGetDevice(&dev);
    hipDeviceGetAttribute(&cus, hipDeviceAttributeMultiprocessorCount, dev);
    hipFuncSetAttribute((const void*)mega, hipFuncAttributeMaxDynamicSharedMemorySize, LDS_BYTES);
    hipOccupancyMaxActiveBlocksPerMultiprocessor(&per_cu, (const void*)mega, 256, LDS_BYTES);
    if (per_cu < 1) per_cu = 1;
    if (per_cu > 2) per_cu = 2;
    grid_blocks = cus * per_cu;
    fprintf(stderr, "mega: cus=%d per_cu=%d grid=%d ws_need=%zu ws_size=%zu\n", cus, per_cu, grid_blocks, (size_t)WS_END, ws_size);
  }
  if (ws_size < WS_END2 || n_in != 25) {
    fprintf(stderr, "mega: workspace too small (%zu < %zu) or n_in=%d\n", ws_size, (size_t)WS_END, n_in);
    return;
  }
  hipMemsetAsync((unsigned char*)d_ws + OFF_BAR, 0, 16384, stream);
  Params p{};
  const float** pp = (const float**)&p;
  for (int i = 0; i < 25; ++i) pp[i] = (const float*)d_in[i];
  p.out = (float*)d_out;
  p.ws = (unsigned char*)d_ws;
#if MULTI
  for (int ph = 0; ph < NPHASE; ++ph) {
    p.ph_lo = ph;
    p.ph_hi = ph + 1;
    hipLaunchKernelGGL(mega, dim3(grid_blocks), dim3(256), LDS_BYTES, stream, p);
  }
#else
  p.ph_lo = 0;
  p.ph_hi = NPHASE;
  void* args[] = {&p};
  hipError_t e = hipLaunchCooperativeKernel((const void*)mega, dim3(grid_blocks), dim3(256), args, LDS_BYTES, stream);
  if (e != hipSuccess) fprintf(stderr, "cooperative launch failed: %s (grid %d)\n", hipGetErrorString(e), grid_blocks);
#endif
}
```

```cpp
#include <hip/hip_runtime.h>
#include <hip/hip_bf16.h>
#include <hip/hip_cooperative_groups.h>
#include <cstdio>
namespace cg = cooperative_groups;

typedef unsigned short u16;
using bf16x8 = __attribute__((ext_vector_type(8))) short;
using f32x4 = __attribute__((ext_vector_type(4))) float;
#define DI __device__ __forceinline__

#ifndef MULTI
#define MULTI 0
#endif

constexpr int NB = 4, LS = 8192, LCX = 256, DM = 1024;
constexpr int NTOK = NB * LS;
constexpr int NCTX = NB * LCX;
constexpr int NROW = NTOK + NCTX;
constexpr int NCHUNK = NROW / 128;
constexpr int INC = 7168;
constexpr float EPSV = 1e-6f;

constexpr size_t al256(size_t x) { return (x + 255) & ~size_t(255); }
constexpr size_t OFF_WTIN = 0;
constexpr size_t OFF_WTRO = OFF_WTIN + al256((size_t)INC * 1024 * 2);
constexpr size_t OFF_WTLO = OFF_WTRO + al256((size_t)1024 * 1024 * 2);
constexpr size_t OFF_WTO = OFF_WTLO + al256((size_t)1024 * 1024 * 2);
constexpr size_t OFF_WTQ = OFF_WTO + al256((size_t)1024 * 1024 * 2);
constexpr size_t OFF_WAT = OFF_WTQ + al256((size_t)1024 * 1024 * 2);
constexpr size_t OFF_KEYS = OFF_WAT + al256((size_t)2 * 2 * 8 * 128 * 128 * 2);
constexpr size_t OFF_MOD = OFF_KEYS + al256((size_t)8 * 2 * 128 * 64 * 2);
constexpr size_t OFF_LA = OFF_MOD + al256((size_t)5 * 6144 * 4);
constexpr size_t OFF_LB = OFF_LA + al256((size_t)2 * NCHUNK * 1024 * 4);
constexpr size_t OFF_LH = OFF_LB + al256((size_t)2 * NCHUNK * 1024 * 4);
constexpr size_t OFF_UT = OFF_LH + al256((size_t)2 * NCHUNK * 1024 * 4);
constexpr size_t OFF_VTAB = OFF_UT + al256((size_t)16384 * 1024);
constexpr size_t OFF_USC = OFF_VTAB + al256((size_t)16384 * 1024);
constexpr size_t OFF_VSC = OFF_USC + al256((size_t)16384 * 4);
constexpr size_t OFF_HX = OFF_VSC + al256((size_t)16384 * 4);
constexpr size_t OFF_Q = OFF_HX + al256((size_t)NROW * 1024 * 2);
constexpr size_t OFF_K = OFF_Q + al256((size_t)NROW * 512 * 2);
constexpr size_t OFF_VT = OFF_K + al256((size_t)NROW * 512 * 2);
constexpr size_t OFF_P4 = OFF_VT + al256((size_t)NROW * 1024 * 2);
constexpr size_t OFF_O = OFF_P4 + al256((size_t)NROW * 1024 * 2);
constexpr size_t OFF_STATS = OFF_O + al256((size_t)NTOK * 1024 * 2);
constexpr size_t OFF_KVC = OFF_STATS + al256((size_t)NTOK * 16 * 4);
constexpr size_t OFF_KT = OFF_KVC + al256((size_t)32 * 2 * 32768 * 2);
constexpr size_t OFF_Y = OFF_KT;
constexpr size_t WS_END = OFF_Y + al256((size_t)NTOK * 1024 * 2);

constexpr size_t OFF_BAR = WS_END;
constexpr size_t WS_END2 = OFF_BAR + 16384;
constexpr int LDS_MAIN = 4 * 128 * 72 * 2;
constexpr int LDS_BYTES = LDS_MAIN + 4096;

struct Params {
  const float *x, *c, *ctx, *c_ctx, *mod_w, *mod_b, *norm1_g, *norm2_g, *w_in, *ret_decay, *conv_w, *conv_b, *lru_wa,
      *lru_ba, *lru_wx, *lru_bx, *lru_lambda, *w_ret_out, *w_lru_out, *w_out, *peer_wq, *peer_keys, *peer_u, *peer_v,
      *final_g;
  float* out;
  unsigned char* ws;
  long ph_lo, ph_hi;
};

DI u16 f2bf(float f) {
  unsigned u = __float_as_uint(f);
  u += 0x7fffu + ((u >> 16) & 1u);
  return (u16)(u >> 16);
}
DI float bf2f(u16 h) { return __uint_as_float(((unsigned)h) << 16); }
DI unsigned pack2(float a, float b) { return (unsigned)f2bf(a) | ((unsigned)f2bf(b) << 16); }
DI float lo2f(unsigned w) { return __uint_as_float(w << 16); }
DI float hi2f(unsigned w) { return __uint_as_float(w & 0xffff0000u); }
DI float wave_sum(float v) {
#pragma unroll
  for (int o = 32; o > 0; o >>= 1) v += __shfl_xor(v, o);
  return v;
}
DI float sigmoidf_(float x) { return __builtin_amdgcn_rcpf(1.f + __expf(-x)); }
DI float siluf_(float x) { return x * __builtin_amdgcn_rcpf(1.f + __expf(-x)); }
DI float geluf_(float x) {
  float z2 = 1.5957691216057308f * (x + 0.044715f * x * x * x);
  return x * __builtin_amdgcn_rcpf(1.f + __expf(-z2));
}
DI float softplusf_(float x) { return x > 20.f ? x : log1pf(__expf(x)); }

struct Ident {
  static constexpr bool id = true;
  DI float operator()(float v, int, int) const { return v; }
};
struct ColScale {
  static constexpr bool id = false;
  const float* tab;
  DI float operator()(float v, int, int k) const { return v * tab[k]; }
};
struct RowScale {
  static constexpr bool id = false;
  const float* tab;
  DI float operator()(float v, int r, int) const { return v * tab[r]; }
};

template <class AX>
DI uint4 xform8(uint4 v, int row, int k, const AX& ax) {
  if constexpr (AX::id) {
    return v;
  } else {
    uint4 o;
    o.x = pack2(ax(lo2f(v.x), row, k + 0), ax(hi2f(v.x), row, k + 1));
    o.y = pack2(ax(lo2f(v.y), row, k + 2), ax(hi2f(v.y), row, k + 3));
    o.z = pack2(ax(lo2f(v.z), row, k + 4), ax(hi2f(v.z), row, k + 5));
    o.w = pack2(ax(lo2f(v.w), row, k + 6), ax(hi2f(v.w), row, k + 7));
    return o;
  }
}

template <bool A_LDS, int NI, class AX>
DI void mma_loop(f32x4 (&acc)[4][NI], const u16* __restrict__ A, long lda, const u16* __restrict__ Bt, long ldb, int K,
                 u16* smem, const AX& ax) {
  const int tid = threadIdx.x, lane = tid & 63, wid = tid >> 6, wm = wid >> 1, wn = wid & 1, fr = lane & 15,
            fq = lane >> 4;
  u16* sA = smem;
  u16* sB = smem + 2 * 128 * 72;
  const int nk = K >> 6;
  uint4 ra[4], rb[NI];
  __syncthreads();
#pragma unroll
  for (int i = 0; i < 4; ++i) {
    int c = tid + i * 256;
    int row = c >> 3, kc = (c & 7) * 8;
    if (!A_LDS) ra[i] = *(const uint4*)(A + (long)row * lda + kc);
    if (i < NI) rb[i] = *(const uint4*)(Bt + (long)row * ldb + kc);
  }
#pragma unroll
  for (int i = 0; i < 4; ++i) {
    int c = tid + i * 256;
    int row = c >> 3, kc = (c & 7) * 8;
    const int pk = (((c & 7) ^ ((row >> 1) & 7)) << 3);
    if (!A_LDS) *(uint4*)(sA + row * 64 + pk) = xform8(ra[i], row, kc, ax);
    if (i < NI) *(uint4*)(sB + row * 64 + pk) = rb[i];
  }
  __syncthreads();
  for (int kt = 0; kt < nk; ++kt) {
    const int cur = kt & 1;
    if (kt + 1 < nk) {
#pragma unroll
      for (int i = 0; i < 4; ++i) {
        int c = tid + i * 256;
        int row = c >> 3, kc = (c & 7) * 8;
        if (!A_LDS) ra[i] = *(const uint4*)(A + (long)row * lda + (kt + 1) * 64 + kc);
        if (i < NI) rb[i] = *(const uint4*)(Bt + (long)row * ldb + (kt + 1) * 64 + kc);
      }
    }
#pragma unroll
    for (int ks = 0; ks < 2; ++ks) {
      bf16x8 af[4];
#pragma unroll
      for (int mi = 0; mi < 4; ++mi) {
        if (A_LDS)
          af[mi] = *(const bf16x8*)(smem + (wm * 64 + mi * 16 + fr) * 144 + kt * 64 + ks * 32 + fq * 8);
        else
          af[mi] = *(const bf16x8*)(sA + cur * (128 * 64) + (wm * 64 + mi * 16 + fr) * 64 + (((ks * 4 + fq) ^ (fr >> 1)) << 3));
      }
#pragma unroll
      for (int ni = 0; ni < NI; ++ni) {
        bf16x8 bq = *(const bf16x8*)(sB + cur * (128 * 64) + (wn * (16 * NI) + ni * 16 + fr) * 64 + (((ks * 4 + fq) ^ (fr >> 1)) << 3));
#pragma unroll
        for (int mi = 0; mi < 4; ++mi)
          acc[mi][ni] = __builtin_amdgcn_mfma_f32_16x16x32_bf16(af[mi], bq, acc[mi][ni], 0, 0, 0);
      }
    }
    if (kt + 1 < nk) {
      const int nx = cur ^ 1;
#pragma unroll
      for (int i = 0; i < 4; ++i) {
        int c = tid + i * 256;
        int row = c >> 3, kc = (c & 7) * 8;
        const int pk = (((c & 7) ^ ((row >> 1) & 7)) << 3);
        if (!A_LDS) *(uint4*)(sA + nx * (128 * 64) + row * 64 + pk) = xform8(ra[i], row, (kt + 1) * 64 + kc, ax);
        if (i < NI) *(uint4*)(sB + nx * (128 * 64) + row * 64 + pk) = rb[i];
      }
    }
    __syncthreads();
  }
}

DI void mma_loop2(f32x4 (&acc)[4][4], const u16* __restrict__ A, long lda, const u16* __restrict__ Bt, long ldb, int K, u16* smem) {
  const int tid = threadIdx.x, lane = tid & 63, wid = tid >> 6, wm = wid >> 1, wn = wid & 1, fr = lane & 15,
            fq = lane >> 4;
  u16* sA = smem;
  u16* sB = smem + 2 * 128 * 72;
  const int nk = K >> 6;
  uint4 a00, b00, a01, b01, a02, b02, a03, b03, a10, b10, a11, b11, a12, b12, a13, b13;
  const int lrow = tid >> 3, kc = (tid & 7) * 8;
  const u16* ap = A + (long)lrow * lda + kc;
  const u16* bp = Bt + (long)lrow * ldb + kc;
  const int soff = lrow * 64 + ((((tid & 7) ^ ((lrow >> 1) & 7))) << 3);
  __syncthreads();
  {
    a00 = *(const uint4*)(ap + (long)(0) * lda + (0) * 64);
    b00 = *(const uint4*)(bp + (long)(0) * ldb + (0) * 64);
    a01 = *(const uint4*)(ap + (long)(32) * lda + (0) * 64);
    b01 = *(const uint4*)(bp + (long)(32) * ldb + (0) * 64);
    a02 = *(const uint4*)(ap + (long)(64) * lda + (0) * 64);
    b02 = *(const uint4*)(bp + (long)(64) * ldb + (0) * 64);
    a03 = *(const uint4*)(ap + (long)(96) * lda + (0) * 64);
    b03 = *(const uint4*)(bp + (long)(96) * ldb + (0) * 64);
    a10 = *(const uint4*)(ap + (long)(0) * lda + (1) * 64);
    b10 = *(const uint4*)(bp + (long)(0) * ldb + (1) * 64);
    a11 = *(const uint4*)(ap + (long)(32) * lda + (1) * 64);
    b11 = *(const uint4*)(bp + (long)(32) * ldb + (1) * 64);
    a12 = *(const uint4*)(ap + (long)(64) * lda + (1) * 64);
    b12 = *(const uint4*)(bp + (long)(64) * ldb + (1) * 64);
    a13 = *(const uint4*)(ap + (long)(96) * lda + (1) * 64);
    b13 = *(const uint4*)(bp + (long)(96) * ldb + (1) * 64);
    *(uint4*)(sA + 0 * (128 * 64) + soff + 0) = a00;
    *(uint4*)(sB + 0 * (128 * 64) + soff + 0) = b00;
    *(uint4*)(sA + 0 * (128 * 64) + soff + 2048) = a01;
    *(uint4*)(sB + 0 * (128 * 64) + soff + 2048) = b01;
    *(uint4*)(sA + 0 * (128 * 64) + soff + 4096) = a02;
    *(uint4*)(sB + 0 * (128 * 64) + soff + 4096) = b02;
    *(uint4*)(sA + 0 * (128 * 64) + soff + 6144) = a03;
    *(uint4*)(sB + 0 * (128 * 64) + soff + 6144) = b03;
  }
  __syncthreads();
  for (int kt = 0; kt < nk; kt += 2) {
    if (kt + 2 < nk) {
    a00 = *(const uint4*)(ap + (long)(0) * lda + (kt + 2) * 64);
    b00 = *(const uint4*)(bp + (long)(0) * ldb + (kt + 2) * 64);
    a01 = *(const uint4*)(ap + (long)(32) * lda + (kt + 2) * 64);
    b01 = *(const uint4*)(bp + (long)(32) * ldb + (kt + 2) * 64);
    a02 = *(const uint4*)(ap + (long)(64) * lda + (kt + 2) * 64);
    b02 = *(const uint4*)(bp + (long)(64) * ldb + (kt + 2) * 64);
    a03 = *(const uint4*)(ap + (long)(96) * lda + (kt + 2) * 64);
    b03 = *(const uint4*)(bp + (long)(96) * ldb + (kt + 2) * 64);
    }
    __builtin_amdgcn_s_setprio(1);
#pragma unroll
    for (int ks = 0; ks < 2; ++ks) {
      bf16x8 af[4];
#pragma unroll
      for (int mi = 0; mi < 4; ++mi)
        af[mi] = *(const bf16x8*)(sA + 0 * (128 * 64) + (wm * 64 + mi * 16 + fr) * 64 + (((ks * 4 + fq) ^ (fr >> 1)) << 3));
#pragma unroll
      for (int ni = 0; ni < 4; ++ni) {
        bf16x8 bq = *(const bf16x8*)(sB + 0 * (128 * 64) + (wn * 64 + ni * 16 + fr) * 64 + (((ks * 4 + fq) ^ (fr >> 1)) << 3));
#pragma unroll
        for (int mi = 0; mi < 4; ++mi)
          acc[mi][ni] = __builtin_amdgcn_mfma_f32_16x16x32_bf16(af[mi], bq, acc[mi][ni], 0, 0, 0);
      }
    }
    __builtin_amdgcn_s_setprio(0);
    *(uint4*)(sA + 1 * (128 * 64) + soff + 0) = a10;
    *(uint4*)(sB + 1 * (128 * 64) + soff + 0) = b10;
    *(uint4*)(sA + 1 * (128 * 64) + soff + 2048) = a11;
    *(uint4*)(sB + 1 * (128 * 64) + soff + 2048) = b11;
    *(uint4*)(sA + 1 * (128 * 64) + soff + 4096) = a12;
    *(uint4*)(sB + 1 * (128 * 64) + soff + 4096) = b12;
    *(uint4*)(sA + 1 * (128 * 64) + soff + 6144) = a13;
    *(uint4*)(sB + 1 * (128 * 64) + soff + 6144) = b13;
    __syncthreads();
    if (kt + 3 < nk) {
    a10 = *(const uint4*)(ap + (long)(0) * lda + (kt + 3) * 64);
    b10 = *(const uint4*)(bp + (long)(0) * ldb + (kt + 3) * 64);
    a11 = *(const uint4*)(ap + (long)(32) * lda + (kt + 3) * 64);
    b11 = *(const uint4*)(bp + (long)(32) * ldb + (kt + 3) * 64);
    a12 = *(const uint4*)(ap + (long)(64) * lda + (kt + 3) * 64);
    b12 = *(const uint4*)(bp + (long)(64) * ldb + (kt + 3) * 64);
    a13 = *(const uint4*)(ap + (long)(96) * lda + (kt + 3) * 64);
    b13 = *(const uint4*)(bp + (long)(96) * ldb + (kt + 3) * 64);
    }
    __builtin_amdgcn_s_setprio(1);
#pragma unroll
    for (int ks = 0; ks < 2; ++ks) {
      bf16x8 af[4];
#pragma unroll
      for (int mi = 0; mi < 4; ++mi)
        af[mi] = *(const bf16x8*)(sA + 1 * (128 * 64) + (wm * 64 + mi * 16 + fr) * 64 + (((ks * 4 + fq) ^ (fr >> 1)) << 3));
#pragma unroll
      for (int ni = 0; ni < 4; ++ni) {
        bf16x8 bq = *(const bf16x8*)(sB + 1 * (128 * 64) + (wn * 64 + ni * 16 + fr) * 64 + (((ks * 4 + fq) ^ (fr >> 1)) << 3));
#pragma unroll
        for (int mi = 0; mi < 4; ++mi)
          acc[mi][ni] = __builtin_amdgcn_mfma_f32_16x16x32_bf16(af[mi], bq, acc[mi][ni], 0, 0, 0);
      }
    }
    __builtin_amdgcn_s_setprio(0);
    if (kt + 2 < nk) {
    *(uint4*)(sA + 0 * (128 * 64) + soff + 0) = a00;
    *(uint4*)(sB + 0 * (128 * 64) + soff + 0) = b00;
    *(uint4*)(sA + 0 * (128 * 64) + soff + 2048) = a01;
    *(uint4*)(sB + 0 * (128 * 64) + soff + 2048) = b01;
    *(uint4*)(sA + 0 * (128 * 64) + soff + 4096) = a02;
    *(uint4*)(sB + 0 * (128 * 64) + soff + 4096) = b02;
    *(uint4*)(sA + 0 * (128 * 64) + soff + 6144) = a03;
    *(uint4*)(sB + 0 * (128 * 64) + soff + 6144) = b03;
    }
    __syncthreads();
  }
}

DI void mma_big(f32x4 (&acc)[4][8], const u16* __restrict__ A, const u16* __restrict__ Bt, u16* smem) {
  const int tid = threadIdx.x, lane = tid & 63, wid = tid >> 6, fr = lane & 15, fq = lane >> 4;
  u16* sA = smem;
  u16* sB = smem + 16384;
  uint4 a00, a01, a02, a03, a10, a11, a12, a13, b00, b01, b10, b11;
  const u16* ap = A + (long)(tid >> 2) * 1024 + (tid & 3) * 8;
  const u16* bp = Bt + (long)(tid >> 2) * 1024 + (tid & 3) * 8;
  const int soff = (tid >> 2) * 32 + ((((tid & 3) ^ ((0 - (tid >> 4)) & 3))) << 3);
  const int rpk = ((fq ^ ((0 - (fr >> 2)) & 3)) << 3);
  __syncthreads();
  {
    a00 = *(const uint4*)(ap + (long)(0) * 1024 + (0) * 32);
    a01 = *(const uint4*)(ap + (long)(64) * 1024 + (0) * 32);
    a02 = *(const uint4*)(ap + (long)(128) * 1024 + (0) * 32);
    a03 = *(const uint4*)(ap + (long)(192) * 1024 + (0) * 32);
    b00 = *(const uint4*)(bp + (long)(0) * 1024 + (0) * 32);
    b01 = *(const uint4*)(bp + (long)(64) * 1024 + (0) * 32);
    a10 = *(const uint4*)(ap + (long)(0) * 1024 + (1) * 32);
    a11 = *(const uint4*)(ap + (long)(64) * 1024 + (1) * 32);
    a12 = *(const uint4*)(ap + (long)(128) * 1024 + (1) * 32);
    a13 = *(const uint4*)(ap + (long)(192) * 1024 + (1) * 32);
    b10 = *(const uint4*)(bp + (long)(0) * 1024 + (1) * 32);
    b11 = *(const uint4*)(bp + (long)(64) * 1024 + (1) * 32);
    *(uint4*)(sA + 0 * 8192 + soff + 0) = a00;
    *(uint4*)(sA + 0 * 8192 + soff + 2048) = a01;
    *(uint4*)(sA + 0 * 8192 + soff + 4096) = a02;
    *(uint4*)(sA + 0 * 8192 + soff + 6144) = a03;
    *(uint4*)(sB + 0 * 4096 + soff + 0) = b00;
    *(uint4*)(sB + 0 * 4096 + soff + 2048) = b01;
  }
  __syncthreads();
  for (int kt = 0; kt < 32; kt += 2) {
    *(uint4*)(sA + 1 * 8192 + soff + 0) = a10;
    *(uint4*)(sA + 1 * 8192 + soff + 2048) = a11;
    *(uint4*)(sA + 1 * 8192 + soff + 4096) = a12;
    *(uint4*)(sA + 1 * 8192 + soff + 6144) = a13;
    *(uint4*)(sB + 1 * 4096 + soff + 0) = b10;
    *(uint4*)(sB + 1 * 4096 + soff + 2048) = b11;
    if (kt + 2 < 32) {
    a00 = *(const uint4*)(ap + (long)(0) * 1024 + (kt + 2) * 32);
    a01 = *(const uint4*)(ap + (long)(64) * 1024 + (kt + 2) * 32);
    a02 = *(const uint4*)(ap + (long)(128) * 1024 + (kt + 2) * 32);
    a03 = *(const uint4*)(ap + (long)(192) * 1024 + (kt + 2) * 32);
    b00 = *(const uint4*)(bp + (long)(0) * 1024 + (kt + 2) * 32);
    b01 = *(const uint4*)(bp + (long)(64) * 1024 + (kt + 2) * 32);
    a10 = *(const uint4*)(ap + (long)(0) * 1024 + (kt + 3) * 32);
    a11 = *(const uint4*)(ap + (long)(64) * 1024 + (kt + 3) * 32);
    a12 = *(const uint4*)(ap + (long)(128) * 1024 + (kt + 3) * 32);
    a13 = *(const uint4*)(ap + (long)(192) * 1024 + (kt + 3) * 32);
    b10 = *(const uint4*)(bp + (long)(0) * 1024 + (kt + 3) * 32);
    b11 = *(const uint4*)(bp + (long)(64) * 1024 + (kt + 3) * 32);
    }
    {
      bf16x8 af[4];
      __builtin_amdgcn_s_setprio(1);
#pragma unroll
      for (int mi = 0; mi < 4; ++mi) af[mi] = *(const bf16x8*)(sA + 0 * 8192 + (wid * 64 + mi * 16 + fr) * 32 + rpk);
#pragma unroll
      for (int ni = 0; ni < 8; ++ni) {
        bf16x8 bq = *(const bf16x8*)(sB + 0 * 4096 + (ni * 16 + fr) * 32 + rpk);
#pragma unroll
        for (int mi = 0; mi < 4; ++mi)
          acc[mi][ni] = __builtin_amdgcn_mfma_f32_16x16x32_bf16(af[mi], bq, acc[mi][ni], 0, 0, 0);
      }
      __builtin_amdgcn_s_setprio(0);
    }
    __syncthreads();
    {
      bf16x8 af[4];
      __builtin_amdgcn_s_setprio(1);
#pragma unroll
      for (int mi = 0; mi < 4; ++mi) af[mi] = *(const bf16x8*)(sA + 1 * 8192 + (wid * 64 + mi * 16 + fr) * 32 + rpk);
#pragma unroll
      for (int ni = 0; ni < 8; ++ni) {
        bf16x8 bq = *(const bf16x8*)(sB + 1 * 4096 + (ni * 16 + fr) * 32 + rpk);
#pragma unroll
        for (int mi = 0; mi < 4; ++mi)
          acc[mi][ni] = __builtin_amdgcn_mfma_f32_16x16x32_bf16(af[mi], bq, acc[mi][ni], 0, 0, 0);
      }
      __builtin_amdgcn_s_setprio(0);
    }
    if (kt + 2 < 32) {
    *(uint4*)(sA + 0 * 8192 + soff + 0) = a00;
    *(uint4*)(sA + 0 * 8192 + soff + 2048) = a01;
    *(uint4*)(sA + 0 * 8192 + soff + 4096) = a02;
    *(uint4*)(sA + 0 * 8192 + soff + 6144) = a03;
    *(uint4*)(sB + 0 * 4096 + soff + 0) = b00;
    *(uint4*)(sB + 0 * 4096 + soff + 2048) = b01;
    }
    __syncthreads();
  }
}
DI void mma_big3(f32x4 (&acc)[4][8], const u16* __restrict__ A, const u16* __restrict__ Bt, u16* smem) {
  const int tid = threadIdx.x, lane = tid & 63, wid = tid >> 6, fr = lane & 15, fq = lane >> 4;
  const int rpk = ((fq ^ ((0 - (fr >> 2)) & 3)) << 3);
  const int lrow = lane >> 2, lc = ((lane & 3) ^ ((0 - (lane >> 4)) & 3));
  const u16* ap = A + (long)(wid * 64 + lrow) * 1024 + lc * 8;
  const u16* bp = Bt + (long)(wid * 32 + lrow) * 1024 + lc * 8;
  char* lbase = (char*)smem;
  auto issue = [&](int kt, int buf) {
    char* la = lbase + buf * 24576 + wid * 4096;
    char* lb = lbase + buf * 24576 + 16384 + wid * 2048;
#pragma unroll
    for (int i = 0; i < 4; ++i)
      __builtin_amdgcn_global_load_lds((const unsigned*)(ap + (long)(16 * i) * 1024 + kt * 32), (unsigned __attribute__((address_space(3)))*)(la + i * 1024), 16, 0, 0);
#pragma unroll
    for (int i = 0; i < 2; ++i)
      __builtin_amdgcn_global_load_lds((const unsigned*)(bp + (long)(16 * i) * 1024 + kt * 32), (unsigned __attribute__((address_space(3)))*)(lb + i * 1024), 16, 0, 0);
  };
  __syncthreads();
  issue(0, 0);
  issue(1, 1);
  int cur = 0;
#pragma unroll 1
  for (int kt = 0; kt < 32; ++kt) {
    if (kt < 31) asm volatile("s_waitcnt vmcnt(6)" ::: "memory");
    else asm volatile("s_waitcnt vmcnt(0)" ::: "memory");
    asm volatile("s_waitcnt lgkmcnt(0)" ::: "memory");
    __builtin_amdgcn_s_barrier();
    if (kt + 2 < 32) {
      int nb = cur + 2;
      if (nb >= 3) nb -= 3;
      issue(kt + 2, nb);
    }
    const u16* sA = smem + cur * 12288;
    const u16* sB = sA + 8192;
    {
      bf16x8 af[4];
      __builtin_amdgcn_s_setprio(1);
#pragma unroll
      for (int mi = 0; mi < 4; ++mi) af[mi] = *(const bf16x8*)(sA + (wid * 64 + mi * 16 + fr) * 32 + rpk);
      bf16x8 bq0 = *(const bf16x8*)(sB + (0 * 16 + fr) * 32 + rpk);
      bf16x8 bq1 = *(const bf16x8*)(sB + (1 * 16 + fr) * 32 + rpk);
#pragma unroll
      for (int ni = 0; ni < 8; ni += 2) {
        bf16x8 n0 = bq0, n1 = bq1;
        if (ni + 2 < 8) {
          n0 = *(const bf16x8*)(sB + ((ni + 2) * 16 + fr) * 32 + rpk);
          n1 = *(const bf16x8*)(sB + ((ni + 3) * 16 + fr) * 32 + rpk);
        }
        __builtin_amdgcn_sched_barrier(0);
#pragma unroll
        for (int mi = 0; mi < 4; ++mi)
          acc[mi][ni] = __builtin_amdgcn_mfma_f32_16x16x32_bf16(af[mi], bq0, acc[mi][ni], 0, 0, 0);
#pragma unroll
        for (int mi = 0; mi < 4; ++mi)
          acc[mi][ni + 1] = __builtin_amdgcn_mfma_f32_16x16x32_bf16(af[mi], bq1, acc[mi][ni + 1], 0, 0, 0);
        __builtin_amdgcn_sched_barrier(0);
        bq0 = n0;
        bq1 = n1;
      }
      __builtin_amdgcn_s_setprio(0);
    }
    cur = cur + 1;
    if (cur == 3) cur = 0;
  }
  __syncthreads();
}

DI void zero_big(f32x4 (&acc)[4][8]) {
#pragma unroll
  for (int mi = 0; mi < 4; ++mi)
#pragma unroll
    for (int ni = 0; ni < 8; ++ni) acc[mi][ni] = f32x4{0.f, 0.f, 0.f, 0.f};
}
DI void big_to_lds(const f32x4 (&acc)[4][8], float* T, int h) {
  const int tid = threadIdx.x, lane = tid & 63, wid = tid >> 6, fr = lane & 15, fq = lane >> 4;
  if ((wid >> 1) != h) return;
#pragma unroll
  for (int mi = 0; mi < 4; ++mi)
#pragma unroll
    for (int ni = 0; ni < 8; ++ni)
#pragma unroll
      for (int j = 0; j < 4; ++j) T[((wid & 1) * 64 + mi * 16 + fq * 4 + j) * 132 + ni * 16 + fr] = acc[mi][ni][j];
}
DI void big_to_lds_T(const f32x4 (&acc)[4][8], float* T, int h) {
  const int tid = threadIdx.x, lane = tid & 63, wid = tid >> 6, fr = lane & 15, fq = lane >> 4;
  if ((wid >> 1) != h) return;
#pragma unroll
  for (int mi = 0; mi < 4; ++mi)
#pragma unroll
    for (int ni = 0; ni < 8; ++ni) *(f32x4*)(T + (ni * 16 + fr) * 132 + (wid & 1) * 64 + mi * 16 + fq * 4) = acc[mi][ni];
}
DI int tile_at_pad(int it, int MT, int NT, int& mt, int& nt) {
  const int G = gridDim.x >> 3, xcd = blockIdx.x & 7, lb = blockIdx.x >> 3;
  const int NT8 = NT >> 3, nst = ((MT + 7) >> 3) * NT8;
  const int f = it * G + lb;
  const int st = xcd + 8 * (f >> 6);
  if (st >= nst) return 0;
  const int w = f & 63;
  mt = (st / NT8) * 8 + (w >> 3);
  nt = (st % NT8) * 8 + (w & 7);
  return mt < MT ? 1 : 2;
}

DI void mma_glds128(f32x4 (&acc)[4][4], const u16* __restrict__ A, long lda, const u16* __restrict__ Bt, long ldb, int K, u16* smem) {
  const int tid = threadIdx.x, lane = tid & 63, wid = tid >> 6, wm = wid >> 1, wn = wid & 1, fr = lane & 15, fq = lane >> 4;
  u16* sA = smem;
  u16* sB = smem + 2 * 128 * 72;
  const int nk = K >> 6;
  typedef unsigned __attribute__((address_space(3))) lds_u32;
  auto issue = [&](int kt, int buf) {
#pragma unroll
    for (int i = 0; i < 4; ++i) {
      const int row = wid * 32 + i * 8 + (lane >> 3);
      const int lc = (lane & 7) ^ ((row >> 1) & 7);
      __builtin_amdgcn_global_load_lds((const unsigned*)(A + (long)row * lda + kt * 64 + lc * 8),
                                       (lds_u32*)(sA + buf * (128 * 64) + (wid * 32 + i * 8) * 64), 16, 0, 0);
      __builtin_amdgcn_global_load_lds((const unsigned*)(Bt + (long)row * ldb + kt * 64 + lc * 8),
                                       (lds_u32*)(sB + buf * (128 * 64) + (wid * 32 + i * 8) * 64), 16, 0, 0);
    }
  };
  __syncthreads();
  issue(0, 0);
  asm volatile("s_waitcnt vmcnt(0)" ::: "memory");
  __syncthreads();
  for (int kt = 0; kt < nk; ++kt) {
    const int cur = kt & 1;
    if (kt + 1 < nk) issue(kt + 1, cur ^ 1);
    __builtin_amdgcn_s_setprio(1);
#pragma unroll
    for (int ks = 0; ks < 2; ++ks) {
      bf16x8 af[4];
#pragma unroll
      for (int mi = 0; mi < 4; ++mi)
        af[mi] = *(const bf16x8*)(sA + cur * (128 * 64) + (wm * 64 + mi * 16 + fr) * 64 + (((ks * 4 + fq) ^ (fr >> 1)) << 3));
#pragma unroll
      for (int ni = 0; ni < 4; ++ni) {
        bf16x8 bq = *(const bf16x8*)(sB + cur * (128 * 64) + (wn * 64 + ni * 16 + fr) * 64 + (((ks * 4 + fq) ^ (fr >> 1)) << 3));
#pragma unroll
        for (int mi = 0; mi < 4; ++mi)
          acc[mi][ni] = __builtin_amdgcn_mfma_f32_16x16x32_bf16(af[mi], bq, acc[mi][ni], 0, 0, 0);
      }
    }
    __builtin_amdgcn_s_setprio(0);
    asm volatile("s_waitcnt vmcnt(0)" ::: "memory");
    __syncthreads();
  }
}

template <int NI>
DI void zero_acc(f32x4 (&acc)[4][NI]) {
#pragma unroll
  for (int mi = 0; mi < 4; ++mi)
#pragma unroll
    for (int ni = 0; ni < NI; ++ni) acc[mi][ni] = f32x4{0.f, 0.f, 0.f, 0.f};
}

DI void acc_to_lds(const f32x4 (&acc)[4][4], float* T) {
  const int tid = threadIdx.x, lane = tid & 63, wid = tid >> 6, wm = wid >> 1, wn = wid & 1, fr = lane & 15, fq = lane >> 4;
#pragma unroll
  for (int mi = 0; mi < 4; ++mi)
#pragma unroll
    for (int ni = 0; ni < 4; ++ni)
#pragma unroll
      for (int j = 0; j < 4; ++j) T[(wm * 64 + mi * 16 + fq * 4 + j) * 132 + wn * 64 + ni * 16 + fr] = acc[mi][ni][j];
}
DI void acc_to_lds_T(const f32x4 (&acc)[4][4], float* T) {
  const int tid = threadIdx.x, lane = tid & 63, wid = tid >> 6, wm = wid >> 1, wn = wid & 1, fr = lane & 15, fq = lane >> 4;
#pragma unroll
  for (int mi = 0; mi < 4; ++mi)
#pragma unroll
    for (int ni = 0; ni < 4; ++ni) *(f32x4*)(T + (wn * 64 + ni * 16 + fr) * 132 + wm * 64 + mi * 16 + fq * 4) = acc[mi][ni];
}
DI uint4 pack8(float4 a, float4 b) {
  uint4 o;
  o.x = pack2(a.x, a.y); o.y = pack2(a.z, a.w); o.z = pack2(b.x, b.y); o.w = pack2(b.z, b.w);
  return o;
}
DI void tile_store_bf16(const float* T, u16* dst, long ld) {
  const int tid = threadIdx.x;
#pragma unroll 1
  for (int i = 0; i < 8; ++i) {
    int idx = tid + i * 256;
    int r = idx >> 4, c0 = (idx & 15) * 8;
    float4 a = *(const float4*)(T + r * 132 + c0), b = *(const float4*)(T + r * 132 + c0 + 4);
    *(uint4*)(dst + (long)r * ld + c0) = pack8(a, b);
  }
}

template <int MODE>
DI void build_resident(u16* smem, const u16* __restrict__ A, long lda, const float* tab) {
  const int tid = threadIdx.x;
#pragma unroll 1
  for (int i = 0; i < 8; ++i) {
    int idx = tid + i * 256;
    int r = idx >> 4, c0 = (idx & 15) * 8;
    uint4 v = *(const uint4*)(A + (long)r * lda + c0);
    float s[8];
#pragma unroll
    for (int e = 0; e < 8; ++e) s[e] = MODE == 1 ? tab[r] : tab[c0 + e];
    uint4 o;
    o.x = pack2(lo2f(v.x) * s[0], hi2f(v.x) * s[1]);
    o.y = pack2(lo2f(v.y) * s[2], hi2f(v.y) * s[3]);
    o.z = pack2(lo2f(v.z) * s[4], hi2f(v.z) * s[5]);
    o.w = pack2(lo2f(v.w) * s[6], hi2f(v.w) * s[7]);
    *(uint4*)(smem + r * 144 + c0) = o;
  }
}

DI bool tile_at(int it, int MT, int NT, int& mt, int& nt) {
  const int G = gridDim.x >> 3, xcd = blockIdx.x & 7, lb = blockIdx.x >> 3;
  const int NT8 = NT >> 3, nst = (MT >> 3) * NT8;
  const int f = it * G + lb;
  const int st = xcd + 8 * (f >> 6);
  if (st >= nst) return false;
  const int w = f & 63;
  mt = (st / NT8) * 8 + (w >> 3);
  nt = (st % NT8) * 8 + (w & 7);
  return true;
}

DI void tr_items(const float* __restrict__ src, u16* __restrict__ dst, int K, int N, long nmat, long gtid,
                 long gstride) {
  const long per = (long)N * (K / 8);
  const long total = nmat * per;
  for (long i = gtid; i < total; i += gstride) {
    long mat = i / per;
    long r = i - mat * per;
    int k8 = (int)(r / N);
    int n = (int)(r - (long)k8 * N);
    const float* s = src + mat * (long)K * N + (long)k8 * 8 * N + n;
    uint4 o;
    o.x = pack2(s[0], s[(long)N]);
    o.y = pack2(s[2L * N], s[3L * N]);
    o.z = pack2(s[4L * N], s[5L * N]);
    o.w = pack2(s[6L * N], s[7L * N]);
    *(uint4*)(dst + mat * (long)K * N + (long)n * K + k8 * 8) = o;
  }
}
DI void cvt_items(const float* __restrict__ src, u16* __restrict__ dst, long n8, long gtid, long gstride) {
  for (long i = gtid; i < n8; i += gstride) {
    float4 a = *(const float4*)(src + i * 8);
    float4 b = *(const float4*)(src + i * 8 + 4);
    uint4 o;
    o.x = pack2(a.x, a.y);
    o.y = pack2(a.z, a.w);
    o.z = pack2(b.x, b.y);
    o.w = pack2(b.z, b.w);
    *(uint4*)(dst + i * 8) = o;
  }
}

DI void phase_prep(const Params& p, u16* smem) {
  const long gtid = (long)blockIdx.x * blockDim.x + threadIdx.x;
  const long gstride = (long)gridDim.x * blockDim.x;
  unsigned char* ws = p.ws;
  {
    float* mod = (float*)(ws + OFF_MOD);
    float* red = (float*)smem;
    const int tid = threadIdx.x;
    for (int it = blockIdx.x; it < 192; it += gridDim.x) {
      const int col = it * 32 + (tid & 31), ks = tid >> 5;
      float a0 = 0.f, a1 = 0.f, a2 = 0.f, a3 = 0.f, a4 = 0.f;
      for (int k = ks * 128; k < ks * 128 + 128; ++k) {
        float w = p.mod_w[(long)k * 6144 + col];
        a0 += siluf_(p.c[k]) * w;
        a1 += siluf_(p.c[1024 + k]) * w;
        a2 += siluf_(p.c[2048 + k]) * w;
        a3 += siluf_(p.c[3072 + k]) * w;
        a4 += siluf_(p.c_ctx[k]) * w;
      }
      __syncthreads();
      red[(ks * 5 + 0) * 32 + (tid & 31)] = a0;
      red[(ks * 5 + 1) * 32 + (tid & 31)] = a1;
      red[(ks * 5 + 2) * 32 + (tid & 31)] = a2;
      red[(ks * 5 + 3) * 32 + (tid & 31)] = a3;
      red[(ks * 5 + 4) * 32 + (tid & 31)] = a4;
      __syncthreads();
      if (tid < 160) {
        int r = tid >> 5, cc = tid & 31;
        float sum = p.mod_b[it * 32 + cc];
        for (int q = 0; q < 8; ++q) sum += red[(q * 5 + r) * 32 + cc];
        mod[r * 6144 + it * 32 + cc] = sum;
      }
    }
  }
  tr_items(p.w_in, (u16*)(ws + OFF_WTIN), 1024, INC, 1, gtid, gstride);
  tr_items(p.w_ret_out, (u16*)(ws + OFF_WTRO), 1024, 1024, 1, gtid, gstride);
  tr_items(p.w_lru_out, (u16*)(ws + OFF_WTLO), 1024, 1024, 1, gtid, gstride);
  tr_items(p.w_out, (u16*)(ws + OFF_WTO), 1024, 1024, 1, gtid, gstride);
  tr_items(p.peer_wq, (u16*)(ws + OFF_WTQ), 1024, 1024, 1, gtid, gstride);
  for (int d = 0; d < 2; ++d) {
    tr_items(p.lru_wa + (long)d * 8 * 16384, (u16*)(ws + OFF_WAT) + (long)(d * 2 + 0) * 8 * 16384, 128, 128, 8, gtid, gstride);
    tr_items(p.lru_wx + (long)d * 8 * 16384, (u16*)(ws + OFF_WAT) + (long)(d * 2 + 1) * 8 * 16384, 128, 128, 8, gtid, gstride);
  }
  cvt_items(p.peer_keys, (u16*)(ws + OFF_KEYS), 8L * 2 * 128 * 64 / 8, gtid, gstride);
  {
    const int lane = threadIdx.x & 63;
    const long gw = gtid >> 6, nw = gstride >> 6;
    for (long rr = gw; rr < 2L * 16384; rr += nw) {
      const int tb = (int)(rr >> 14);
      const long row = rr & 16383;
      const float* src = (tb ? p.peer_v : p.peer_u) + row * 1024 + lane * 16;
      float4 v0 = *(const float4*)(src), v1 = *(const float4*)(src + 4), v2 = *(const float4*)(src + 8), v3 = *(const float4*)(src + 12);
      float m = fmaxf(fmaxf(fmaxf(fabsf(v0.x), fabsf(v0.y)), fmaxf(fabsf(v0.z), fabsf(v0.w))),
                      fmaxf(fmaxf(fabsf(v1.x), fabsf(v1.y)), fmaxf(fabsf(v1.z), fabsf(v1.w))));
      m = fmaxf(m, fmaxf(fmaxf(fmaxf(fabsf(v2.x), fabsf(v2.y)), fmaxf(fabsf(v2.z), fabsf(v2.w))),
                         fmaxf(fmaxf(fabsf(v3.x), fabsf(v3.y)), fmaxf(fabsf(v3.z), fabsf(v3.w)))));
#pragma unroll
      for (int o = 32; o > 0; o >>= 1) m = fmaxf(m, __shfl_xor(m, o));
      m = fmaxf(m, 1e-30f);
      const float inv = 127.f / m;
      const int qoff = tb ? 128 : 0;
#define Q8(x) ((unsigned)((int)rintf((x) * inv) + qoff) & 0xffu)
      uint4 o;
      o.x = Q8(v0.x) | (Q8(v0.y) << 8) | (Q8(v0.z) << 16) | (Q8(v0.w) << 24);
      o.y = Q8(v1.x) | (Q8(v1.y) << 8) | (Q8(v1.z) << 16) | (Q8(v1.w) << 24);
      o.z = Q8(v2.x) | (Q8(v2.y) << 8) | (Q8(v2.z) << 16) | (Q8(v2.w) << 24);
      o.w = Q8(v3.x) | (Q8(v3.y) << 8) | (Q8(v3.z) << 16) | (Q8(v3.w) << 24);
#undef Q8
      *(uint4*)(ws + (tb ? OFF_VTAB : OFF_UT) + row * 1024 + lane * 16) = o;
      if (lane == 0) ((float*)(ws + (tb ? OFF_VSC : OFF_USC)))[row] = m * (1.f / 127.f);
    }
  }
}

DI void norm_row(const float* __restrict__ src, const float* __restrict__ g, const float* __restrict__ shift,
                 const float* __restrict__ scale, u16* __restrict__ dst, int lane) {
  float4 v[4];
  float ss = 0.f;
#pragma unroll
  for (int i = 0; i < 4; ++i) {
    v[i] = *(const float4*)(src + (i * 64 + lane) * 4);
    ss += v[i].x * v[i].x + v[i].y * v[i].y + v[i].z * v[i].z + v[i].w * v[i].w;
  }
  ss = wave_sum(ss);
  float rstd = rsqrtf(ss * (1.f / 1024.f) + EPSV);
#pragma unroll
  for (int i = 0; i < 4; ++i) {
    int c = (i * 64 + lane) * 4;
    float4 gg = *(const float4*)(g + c);
    float4 sh = *(const float4*)(shift + c);
    float4 sc = *(const float4*)(scale + c);
    float y0 = v[i].x * rstd * gg.x * (1.f + sc.x) + sh.x;
    float y1 = v[i].y * rstd * gg.y * (1.f + sc.y) + sh.y;
    float y2 = v[i].z * rstd * gg.z * (1.f + sc.z) + sh.z;
    float y3 = v[i].w * rstd * gg.w * (1.f + sc.w) + sh.w;
    uint2 o;
    o.x = pack2(y0, y1);
    o.y = pack2(y2, y3);
    *(uint2*)(dst + c) = o;
  }
}

DI void phase_norm1(const Params& p) {
  const int lane = threadIdx.x & 63;
  const long gw = ((long)blockIdx.x * blockDim.x + threadIdx.x) >> 6;
  const long nw = ((long)gridDim.x * blockDim.x) >> 6;
  const float* mod = (const float*)(p.ws + OFF_MOD);
  u16* hx = (u16*)(p.ws + OFF_HX);
  for (long r = gw; r < NROW; r += nw) {
    const float* src;
    int mr;
    if (r < NTOK) { src = p.x + r * 1024; mr = (int)(r / LS); }
    else { src = p.ctx + (r - NTOK) * 1024; mr = 4; }
    norm_row(src, p.norm1_g, mod + mr * 6144, mod + mr * 6144 + 1024, hx + r * 1024, lane);
  }
}
DI void phase_norm2(const Params& p) {
  const int lane = threadIdx.x & 63;
  const long gw = ((long)blockIdx.x * blockDim.x + threadIdx.x) >> 6;
  const long nw = ((long)gridDim.x * blockDim.x) >> 6;
  const float* mod = (const float*)(p.ws + OFF_MOD);
  u16* hx2 = (u16*)(p.ws + OFF_O);
  for (long r = gw; r < NTOK; r += nw) {
    int mr = (int)(r / LS);
    norm_row(p.out + r * 1024, p.norm2_g, mod + mr * 6144 + 3072, mod + mr * 6144 + 4096, hx2 + r * 1024, lane);
  }
}

DI void phase_gemm_a(const Params& p, u16* smem) {
  const int tid = threadIdx.x, lane = tid & 63, wid = tid >> 6, wm = wid >> 1, wn = wid & 1, fr = lane & 15, fq = lane >> 4;
  const u16* hx = (const u16*)(p.ws + OFF_HX);
  const u16* wt = (const u16*)(p.ws + OFF_WTIN);
  u16* Q = (u16*)(p.ws + OFF_Q);
  u16* Kb = (u16*)(p.ws + OFF_K);
  u16* KT = (u16*)(p.ws + OFF_KT);
  u16* VT = (u16*)(p.ws + OFF_VT);
  u16* P4 = (u16*)(p.ws + OFF_P4);
  int mt, nt;
  for (int it = 0; tile_at(it, NCHUNK, 24, mt, nt); ++it) {
    const int wrow0 = nt < 16 ? nt * 128 : 3072 + (nt - 16) * 128;
    const bool latent = mt < 256;
    if (!latent && nt < 4) continue;
    f32x4 acc[4][4];
    zero_acc(acc);
    mma_glds128(acc, hx + (long)mt * 128 * 1024, 1024, wt + (long)wrow0 * 1024, 1024, 1024, smem);
    const int b = latent ? mt / 64 : (mt - 256) / 2;
    const int tseq0 = latent ? (mt % 64) * 128 : ((mt - 256) % 2) * 128;
    const long row0 = (long)mt * 128;
    const int Lseq = latent ? LS : LCX;
    float* T = (float*)smem;
    if (nt < 8) {
      if (latent) {
#pragma unroll
        for (int mi = 0; mi < 4; ++mi)
#pragma unroll
          for (int j = 0; j < 4; ++j) {
            int tok = tseq0 + wm * 64 + mi * 16 + fq * 4 + j;
            float pos = (float)(wn == 0 ? (tok >> 6) : (tok & 63));
#pragma unroll
            for (int n2 = 0; n2 < 2; ++n2) {
              float f = (float)(n2 * 16 + fr);
              float inv = exp2f(-f * (13.287712379549449f / 32.f));
              float ang = pos * inv;
              float cs = __cosf(ang), sn = __sinf(ang);
              float u1 = acc[mi][n2][j], u2 = acc[mi][n2 + 2][j];
              acc[mi][n2][j] = u1 * cs - u2 * sn;
              acc[mi][n2 + 2][j] = u2 * cs + u1 * sn;
            }
          }
      }
      if (nt < 4) {
        acc_to_lds(acc, T);
        __syncthreads();
        tile_store_bf16(T, Q + row0 * 512 + nt * 128, 512);
      } else {
        const int h = nt - 4;
#pragma unroll
        for (int mi = 0; mi < 4; ++mi)
#pragma unroll
          for (int ni = 0; ni < 4; ++ni) acc[mi][ni] *= 0.08838834764831845f;
        acc_to_lds(acc, T);
        __syncthreads();
        tile_store_bf16(T, Kb + row0 * 512 + h * 128, 512);
        __syncthreads();
        acc_to_lds_T(acc, T);
        __syncthreads();
        u16* ktb = latent ? KT : KT + (size_t)4 * 512 * LS;
        tile_store_bf16(T, ktb + ((long)(b * 512 + h * 128)) * Lseq + tseq0, Lseq);
      }
    } else if (nt < 16) {
      acc_to_lds_T(acc, T);
      __syncthreads();
      u16* vtb = latent ? VT : VT + (size_t)4 * 1024 * LS;
      tile_store_bf16(T, vtb + ((long)(b * 1024 + (nt - 8) * 128)) * Lseq + tseq0, Lseq);
    } else {
      acc_to_lds(acc, T);
      __syncthreads();
      tile_store_bf16(T, P4 + row0 * 1024 + (nt - 16) * 128, 1024);
    }
  }
}

DI float log_gamma_of(const Params& p, int dir, int h) {
  float x = p.ret_decay[dir * 4 + h];
  return -softplusf_(-x);
}

DI void kv_item(const Params& p, int item, u16* smem, float* tabs) {
  const int tid = threadIdx.x;
  const int dvh = item & 1, cc = (item >> 1) % 66, bh = (item >> 1) / 66, h = bh & 3, b = bh >> 2;
  const float lgf = log_gamma_of(p, 0, h), lgb = log_gamma_of(p, 1, h);
  __syncthreads();
  if (tid < 128) {
    tabs[tid] = __expf(lgf * (float)(127 - tid));
    tabs[128 + tid] = __expf(lgb * (float)tid);
  }
  __syncthreads();
  const u16* KT = (const u16*)(p.ws + OFF_KT);
  const u16* VT = (const u16*)(p.ws + OFF_VT);
  const u16 *asrc, *bsrc;
  long ld;
  if (cc < 2) {
    asrc = VT + (size_t)4 * 1024 * LS + ((long)(b * 1024 + h * 256 + dvh * 128)) * LCX + cc * 128;
    bsrc = KT + (size_t)4 * 512 * LS + ((long)(b * 512 + h * 128)) * LCX + cc * 128;
    ld = LCX;
  } else {
    asrc = VT + ((long)(b * 1024 + h * 256 + dvh * 128)) * LS + (cc - 2) * 128;
    bsrc = KT + ((long)(b * 512 + h * 128)) * LS + (cc - 2) * 128;
    ld = LS;
  }
#pragma unroll 1
  for (int dir = 0; dir < 2; ++dir) {
    __syncthreads();
    build_resident<2>(smem, asrc, ld, tabs + dir * 128);
    f32x4 acc[4][4];
    zero_acc(acc);
    mma_loop<true>(acc, nullptr, 0, bsrc, ld, 128, smem, Ident{});
    const int bhd = (b * 4 + h) * 2 + dir;
    u16* dst = cc < 2 ? (u16*)(p.ws + OFF_KVC) + ((long)(bhd * 2 + cc)) * 32768 + dvh * 128 * 128
                      : (u16*)p.out + ((long)bhd * 64 + (cc - 2)) * 32768 + dvh * 128 * 128;
    acc_to_lds(acc, (float*)smem);
    __syncthreads();
    tile_store_bf16((const float*)smem, dst, 128);
  }
}

DI void state_scan(const Params& p) {
  const long gtid = (long)blockIdx.x * blockDim.x + threadIdx.x;
  const long gstride = (long)gridDim.x * blockDim.x;
  for (long idx = gtid; idx < 32L * 4096; idx += gstride) {
    const int e8 = (int)(idx & 4095), bhd = (int)(idx >> 12);
    const int dir = bhd & 1, h = (bhd >> 1) & 3;
    const float cd = __expf(log_gamma_of(p, dir, h) * 128.f);
    float acc[8];
#pragma unroll
    for (int e = 0; e < 8; ++e) acc[e] = 0.f;
    const u16* kvc = (const u16*)(p.ws + OFF_KVC) + (long)bhd * 2 * 32768 + e8 * 8;
#pragma unroll
    for (int s = 0; s < 2; ++s) {
      int cc = dir == 0 ? s : 1 - s;
      uint4 kv = *(const uint4*)(kvc + (long)cc * 32768);
      acc[0] = cd * acc[0] + lo2f(kv.x); acc[1] = cd * acc[1] + hi2f(kv.x);
      acc[2] = cd * acc[2] + lo2f(kv.y); acc[3] = cd * acc[3] + hi2f(kv.y);
      acc[4] = cd * acc[4] + lo2f(kv.z); acc[5] = cd * acc[5] + hi2f(kv.z);
      acc[6] = cd * acc[6] + lo2f(kv.w); acc[7] = cd * acc[7] + hi2f(kv.w);
    }
    u16* base = (u16*)p.out + (long)bhd * 64 * 32768 + e8 * 8;
    const long cstep = dir == 0 ? 32768 : -32768;
    u16* cur = base + (long)(dir == 0 ? 0 : 63) * 32768;
    uint4 k0 = *(const uint4*)(cur), k1 = *(const uint4*)(cur + cstep), k2 = *(const uint4*)(cur + 2 * cstep), k3 = *(const uint4*)(cur + 3 * cstep);
#define SCAN_STEP(KV, s)                                                                       \
    {                                                                                          \
      uint4 kv = KV;                                                                           \
      if ((s) + 4 < 64) KV = *(const uint4*)(cur + 4 * cstep);                                 \
      uint4 o;                                                                                 \
      o.x = pack2(acc[0], acc[1]); o.y = pack2(acc[2], acc[3]); o.z = pack2(acc[4], acc[5]); o.w = pack2(acc[6], acc[7]); \
      *(uint4*)(cur) = o;                                                                      \
      acc[0] = cd * acc[0] + lo2f(kv.x); acc[1] = cd * acc[1] + hi2f(kv.x);                    \
      acc[2] = cd * acc[2] + lo2f(kv.y); acc[3] = cd * acc[3] + hi2f(kv.y);                    \
      acc[4] = cd * acc[4] + lo2f(kv.z); acc[5] = cd * acc[5] + hi2f(kv.z);                    \
      acc[6] = cd * acc[6] + lo2f(kv.w); acc[7] = cd * acc[7] + hi2f(kv.w);                    \
      cur += cstep;                                                                            \
    }
#pragma unroll 1
    for (int s = 0; s < 64; s += 4) {
      SCAN_STEP(k0, s)
      SCAN_STEP(k1, s + 1)
      SCAN_STEP(k2, s + 2)
      SCAN_STEP(k3, s + 3)
    }
#undef SCAN_STEP
  }
}

DI float one_minus_exp(float x) {
  float ser = -x * (1.f + x * (0.5f + x * (0.16666667f + x * (0.041666668f + x * 0.008333334f))));
  return x > -0.25f ? ser : 1.f - __expf(x);
}

DI void lru_tile(const Params& p, int cid, int blk, int nh, int mode, u16* smem) {
  const int tid = threadIdx.x, lane = tid & 63, wid = tid >> 6, wm = wid >> 1, wn = wid & 1, fr = lane & 15, fq = lane >> 4;
  const u16* P4 = (const u16*)(p.ws + OFF_P4);
  const u16* WAT = (const u16*)(p.ws + OFF_WAT);
  float* LA = (float*)(p.ws + OFF_LA);
  float* LB = (float*)(p.ws + OFF_LB);
  const float* LH = (const float*)(p.ws + OFF_LH);
  u16* Y = (u16*)(p.ws + OFF_Y);
  const long r0 = (long)cid * 128;
  long seq_lo, seq_hi;
  if (cid < 256) { seq_lo = (long)(cid / 64) * LS; seq_hi = seq_lo + LS; }
  else { seq_lo = NTOK + (long)((cid - 256) / 2) * LCX; seq_hi = seq_lo + LCX; }
  __syncthreads();
  {
    const int cv = (tid & 15) * 8;
    const int chc = blk * 128 + cv;
    float cw[4][8], cb8[8];
    {
      float4 b0 = *(const float4*)(p.conv_b + chc), b1 = *(const float4*)(p.conv_b + chc + 4);
      cb8[0] = b0.x; cb8[1] = b0.y; cb8[2] = b0.z; cb8[3] = b0.w; cb8[4] = b1.x; cb8[5] = b1.y; cb8[6] = b1.z; cb8[7] = b1.w;
#pragma unroll
      for (int tap = 0; tap < 4; ++tap) {
        float4 w0 = *(const float4*)(p.conv_w + tap * 1024 + chc), w1 = *(const float4*)(p.conv_w + tap * 1024 + chc + 4);
        cw[tap][0] = w0.x; cw[tap][1] = w0.y; cw[tap][2] = w0.z; cw[tap][3] = w0.w;
        cw[tap][4] = w1.x; cw[tap][5] = w1.y; cw[tap][6] = w1.z; cw[tap][7] = w1.w;
      }
    }
#pragma unroll 4
    for (int i = 0; i < 8; ++i) {
      const int row = (tid >> 4) + i * 16;
      uint4 v[4];
#pragma unroll
      for (int tap = 0; tap < 4; ++tap) {
        long rr = r0 + row + tap - 2;
        v[tap] = (rr >= seq_lo && rr < seq_hi) ? *(const uint4*)(P4 + rr * 1024 + chc) : make_uint4(0u, 0u, 0u, 0u);
      }
      float u[8];
#pragma unroll
      for (int e = 0; e < 8; ++e) u[e] = cb8[e];
#pragma unroll
      for (int tap = 0; tap < 4; ++tap) {
        u[0] += lo2f(v[tap].x) * cw[tap][0]; u[1] += hi2f(v[tap].x) * cw[tap][1];
        u[2] += lo2f(v[tap].y) * cw[tap][2]; u[3] += hi2f(v[tap].y) * cw[tap][3];
        u[4] += lo2f(v[tap].z) * cw[tap][4]; u[5] += hi2f(v[tap].z) * cw[tap][5];
        u[6] += lo2f(v[tap].w) * cw[tap][6]; u[7] += hi2f(v[tap].w) * cw[tap][7];
      }
      uint4 o;
      o.x = pack2(u[0], u[1]); o.y = pack2(u[2], u[3]); o.z = pack2(u[4], u[5]); o.w = pack2(u[6], u[7]);
      *(uint4*)(smem + row * 144 + cv) = o;
    }
  }
  u16* sW = smem + 128 * 144;
  float* abuf = (float*)(smem + 128 * 144);
  float* bbuf = abuf + 64 * 65;
  float* sg = bbuf + 64 * 65;
  const int ch = tid & 63, sgi = tid >> 6;
  const long chg = (long)blk * 128 + nh * 64 + ch;
#pragma unroll 1
  for (int dir = 0; dir < 2; ++dir) {
    f32x4 acc[2][4][2];
    __syncthreads();
#pragma unroll 1
    for (int i0 = 0; i0 < 8; i0 += 4) {
      uint4 v[4];
#pragma unroll
      for (int i = 0; i < 4; ++i) {
        int c = tid + (i0 + i) * 256;
        int g = c >> 10, cc = c & 1023, row = cc >> 4, kc = (cc & 15) * 8;
        v[i] = *(const uint4*)(WAT + (long)((dir * 2 + g) * 8 + blk) * 16384 + (nh * 64 + row) * 128 + kc);
      }
#pragma unroll
      for (int i = 0; i < 4; ++i) {
        int c = tid + (i0 + i) * 256;
        int g = c >> 10, cc = c & 1023, row = cc >> 4, kc = (cc & 15) * 8;
        *(uint4*)(sW + g * (64 * 144) + row * 144 + kc) = v[i];
      }
    }
    __syncthreads();
#pragma unroll
    for (int g = 0; g < 2; ++g) {
      zero_acc(acc[g]);
#pragma unroll
      for (int ks = 0; ks < 4; ++ks) {
        bf16x8 af[4];
#pragma unroll
        for (int mi = 0; mi < 4; ++mi) af[mi] = *(const bf16x8*)(smem + (wm * 64 + mi * 16 + fr) * 144 + ks * 32 + fq * 8);
#pragma unroll
        for (int ni = 0; ni < 2; ++ni) {
          bf16x8 bq = *(const bf16x8*)(sW + g * (64 * 144) + (wn * 32 + ni * 16 + fr) * 144 + ks * 32 + fq * 8);
#pragma unroll
          for (int mi = 0; mi < 4; ++mi)
            acc[g][mi][ni] = __builtin_amdgcn_mfma_f32_16x16x32_bf16(af[mi], bq, acc[g][mi][ni], 0, 0, 0);
        }
      }
    }
#pragma unroll
    for (int ni = 0; ni < 2; ++ni) {
      int cl = wn * 32 + ni * 16 + fr;
      int chn = blk * 128 + nh * 64 + cl;
      float ba = p.lru_ba[dir * 1024 + chn], bx = p.lru_bx[dir * 1024 + chn];
      float spl = softplusf_(-p.lru_lambda[dir * 1024 + chn]);
#pragma unroll
      for (int mi = 0; mi < 4; ++mi)
#pragma unroll
        for (int j = 0; j < 4; ++j) {
          int r = wm * 64 + mi * 16 + fq * 4 + j;
          float rg = sigmoidf_(acc[0][mi][ni][j] + ba);
          float ig = sigmoidf_(acc[1][mi][ni][j] + bx);
          float la = -8.f * rg * spl;
          float a = __expf(la);
          float uu = bf2f(smem[r * 144 + nh * 64 + cl]);
          float x2 = 2.f * la;
          float ser = -x2 * (1.f + x2 * (0.5f + x2 * (0.16666667f + x2 * (0.041666668f + x2 * 0.008333334f))));
          float bt = __builtin_amdgcn_sqrtf(x2 > -0.25f ? ser : 1.f - a * a) * (ig * uu);
          acc[0][mi][ni][j] = a;
          acc[1][mi][ni][j] = bt;
        }
    }
    float cP = 1.f, cQ = 0.f;
    if (mode == 1) cQ = LH[((long)dir * NCHUNK + cid) * 1024 + chg];
#pragma unroll
    for (int half = 0; half < 2; ++half) {
      const int hw = dir == 0 ? half : 1 - half;
      __syncthreads();
      if (wm == hw) {
#pragma unroll
        for (int mi = 0; mi < 4; ++mi)
#pragma unroll
          for (int ni = 0; ni < 2; ++ni)
#pragma unroll
            for (int j = 0; j < 4; ++j) {
              int lr = mi * 16 + fq * 4 + j, cl = wn * 32 + ni * 16 + fr;
              abuf[lr * 65 + cl] = acc[0][mi][ni][j];
              bbuf[lr * 65 + cl] = acc[1][mi][ni][j];
            }
      }
      __syncthreads();
      {
        float P = 1.f, Q = 0.f;
#pragma unroll
        for (int s = 0; s < 16; ++s) {
          int pos = sgi * 16 + s;
          int lr = dir == 0 ? pos : 63 - pos;
          float a = abuf[lr * 65 + ch], bb = bbuf[lr * 65 + ch];
          P *= a;
          Q = a * Q + bb;
        }
        sg[(sgi * 64 + ch) * 2] = P;
        sg[(sgi * 64 + ch) * 2 + 1] = Q;
      }
      __syncthreads();
      if (mode == 0) {
#pragma unroll
        for (int k = 0; k < 4; ++k) {
          float pk = sg[(k * 64 + ch) * 2], qk = sg[(k * 64 + ch) * 2 + 1];
          cQ = pk * cQ + qk;
          cP *= pk;
        }
      } else {
        float h = cQ;
#pragma unroll
        for (int k = 0; k < 4; ++k) {
          float pk = sg[(k * 64 + ch) * 2], qk = sg[(k * 64 + ch) * 2 + 1];
          if (k < sgi) h = pk * h + qk;
          cQ = pk * cQ + qk;
        }
#pragma unroll
        for (int s = 0; s < 16; ++s) {
          int pos = sgi * 16 + s;
          int lr = dir == 0 ? pos : 63 - pos;
          float a = abuf[lr * 65 + ch], bb = bbuf[lr * 65 + ch];
          h = a * h + bb;
          bbuf[lr * 65 + ch] = h;
        }
        __syncthreads();
#pragma unroll 1
        for (int i = 0; i < 2; ++i) {
          int idx = tid + i * 256;
          int row = idx >> 3, c8 = (idx & 7) * 8;
          const float* hp = bbuf + row * 65 + c8;
          float4 h0 = make_float4(hp[0], hp[1], hp[2], hp[3]), h1 = make_float4(hp[4], hp[5], hp[6], hp[7]);
          u16* yp = Y + (r0 + hw * 64 + row) * 1024 + blk * 128 + nh * 64 + c8;
          if (dir == 1) {
            uint4 y = *(const uint4*)yp;
            h0.x += lo2f(y.x); h0.y += hi2f(y.x); h0.z += lo2f(y.y); h0.w += hi2f(y.y);
            h1.x += lo2f(y.z); h1.y += hi2f(y.z); h1.z += lo2f(y.w); h1.w += hi2f(y.w);
          }
          *(uint4*)yp = pack8(h0, h1);
        }
      }
    }
    if (mode == 0 && sgi == 0) {
      LA[((long)dir * NCHUNK + cid) * 1024 + chg] = cP;
      LB[((long)dir * NCHUNK + cid) * 1024 + chg] = cQ;
    }
  }
}

DI void phase3(const Params& p, u16* smem, float* tabs) {
#ifndef REP_SUB
#define REP_SUB 0
#endif
  for (int rep = 0; rep <= (REP_SUB & 1); ++rep)
    for (int t = blockIdx.x; t < 2112; t += gridDim.x) kv_item(p, t, smem, tabs);
  for (int rep = 0; rep <= ((REP_SUB >> 1) & 1); ++rep)
    for (int u = blockIdx.x; u < NCHUNK * 16; u += gridDim.x) lru_tile(p, u >> 4, (u >> 1) & 7, u & 1, 0, smem);
}

DI void lru_cross(const Params& p) {
  const long gtid = (long)blockIdx.x * blockDim.x + threadIdx.x;
  if (gtid >= 8192) return;
  const int ch = (int)(gtid & 1023), b = (int)((gtid >> 10) & 3), dir = (int)(gtid >> 12);
  const float* LA = (const float*)(p.ws + OFF_LA) + (long)dir * NCHUNK * 1024;
  const float* LB = (const float*)(p.ws + OFF_LB) + (long)dir * NCHUNK * 1024;
  float* LH = (float*)(p.ws + OFF_LH) + (long)dir * NCHUNK * 1024;
  float h = 0.f;
  for (int s = 0; s < 2; ++s) {
    int cid = 256 + b * 2 + (dir == 0 ? s : 1 - s);
    h = LA[(long)cid * 1024 + ch] * h + LB[(long)cid * 1024 + ch];
  }
  for (int s = 0; s < 64; ++s) {
    int cid = b * 64 + (dir == 0 ? s : 63 - s);
    LH[(long)cid * 1024 + ch] = h;
    h = LA[(long)cid * 1024 + ch] * h + LB[(long)cid * 1024 + ch];
  }
}

DI void ret_out_item(const Params& p, int item, u16* smem, float* tabs) {
  const int tid = threadIdx.x, lane = tid & 63, wid = tid >> 6, wm = wid >> 1, wn = wid & 1, fr = lane & 15, fq = lane >> 4;
  const int half = item & 1, c = (item >> 1) & 63, h = (item >> 7) & 3, b = item >> 9;
  const float lgf = log_gamma_of(p, 0, h), lgb = log_gamma_of(p, 1, h);
  __syncthreads();
  for (int i = tid; i < 129; i += 256) {
    tabs[i] = __expf(lgf * (float)i);
    tabs[129 + i] = __expf(lgb * (float)i);
  }
  if (tid < 128) {
    tabs[258 + tid] = __expf(lgf * (float)(tid + 1));
    tabs[386 + tid] = __expf(lgb * (float)(128 - tid));
  }
  __syncthreads();
  const u16* Q = (const u16*)(p.ws + OFF_Q);
  const u16* Kb = (const u16*)(p.ws + OFF_K);
  const u16* VT = (const u16*)(p.ws + OFF_VT);
  const u16* ST = (const u16*)p.out;
  u16* O = (u16*)(p.ws + OFF_O);
  float* STATS = (float*)(p.ws + OFF_STATS);
  const long row0 = ((long)b * 64 + c) * 128;
  f32x4 ao[4][4];
  zero_acc(ao);
  mma_loop<false>(ao, Q + row0 * 512 + h * 128, 512, Kb + row0 * 512 + h * 128, 512, 128, smem, Ident{});
  const float ddbase = (float)(wm * 64 - wn * 64 + fq * 4 - fr);
#pragma unroll
  for (int mi = 0; mi < 4; ++mi)
#pragma unroll
    for (int ni = 0; ni < 4; ++ni)
#pragma unroll
      for (int j = 0; j < 4; ++j) {
        int i = wm * 64 + mi * 16 + fq * 4 + j, jj = wn * 64 + ni * 16 + fr;
        float dd = ddbase + (float)((mi - ni) * 16 + j);
        float d = __expf(dd >= 0.f ? lgf * dd : -lgb * dd);
        smem[i * 144 + jj] = f2bf(ao[mi][ni][j] * d);
      }
  zero_acc(ao);
#pragma unroll 1
  for (int seg = 0; seg < 3; ++seg) {
    const u16* Bt;
    long ldb;
    if (seg == 0) {
      Bt = VT + ((long)(b * 1024 + h * 256 + half * 128)) * LS + c * 128;
      ldb = LS;
    } else {
      const int dir = seg - 1;
      build_resident<1>(smem, Q + row0 * 512 + h * 128, 512, tabs + 258 + dir * 128);
      Bt = ST + ((((long)(b * 4 + h) * 2 + dir) * 64 + c) * 256 + half * 128) * 128;
      ldb = 128;
    }
    mma_loop<true>(ao, nullptr, 0, Bt, ldb, 128, smem, Ident{});
  }
  float* T = (float*)smem;
  acc_to_lds(ao, T);
  __syncthreads();
#pragma unroll 1
  for (int i = 0; i < 8; ++i) {
    int idx = tid + i * 256;
    int r = idx >> 4, c0 = (idx & 15) * 8;
    float4 a = *(const float4*)(T + r * 132 + c0), bq = *(const float4*)(T + r * 132 + c0 + 4);
    uint4 o = pack8(a, bq);
    *(uint4*)(O + (row0 + r) * 1024 + h * 256 + half * 128 + c0) = o;
    float v0 = lo2f(o.x), v1 = hi2f(o.x), v2 = lo2f(o.y), v3 = hi2f(o.y), v4 = lo2f(o.z), v5 = hi2f(o.z), v6 = lo2f(o.w), v7 = hi2f(o.w);
    float s1 = v0 + v1 + v2 + v3 + v4 + v5 + v6 + v7;
    float s2 = v0 * v0 + v1 * v1 + v2 * v2 + v3 * v3 + v4 * v4 + v5 * v5 + v6 * v6 + v7 * v7;
#pragma unroll
    for (int o2 = 1; o2 < 16; o2 <<= 1) {
      s1 += __shfl_xor(s1, o2);
      s2 += __shfl_xor(s2, o2);
    }
    if ((idx & 15) == 0) {
      float* st = STATS + ((row0 + r) * 4 + h) * 4 + half * 2;
      st[0] = s1;
      st[1] = s2;
    }
  }
}

DI void phase4(const Params& p) {
  lru_cross(p);
  state_scan(p);
}

DI void phase5(const Params& p, u16* smem, float* tabs) {
  for (int rep = 0; rep <= ((REP_SUB >> 2) & 1); ++rep)
    for (int t = blockIdx.x; t < 2048; t += gridDim.x) ret_out_item(p, t, smem, tabs);
  for (int rep = 0; rep <= ((REP_SUB >> 3) & 1); ++rep)
    for (int u = blockIdx.x; u < 256 * 16; u += gridDim.x) lru_tile(p, u >> 4, (u >> 1) & 7, u & 1, 1, smem);
}

DI void phase_gemm_b(const Params& p, u16* smem) {
  const int tid = threadIdx.x, lane = tid & 63, wid = tid >> 6, wm = wid >> 1, wn = wid & 1, fr = lane & 15, fq = lane >> 4;
  const u16* hx = (const u16*)(p.ws + OFF_HX);
  const u16* wt = (const u16*)(p.ws + OFF_WTIN);
  u16* O = (u16*)(p.ws + OFF_O);
  u16* Y = (u16*)(p.ws + OFF_Y);
  u16* S6 = (u16*)(p.ws + OFF_VT);
  u16* S7 = (u16*)(p.ws + OFF_P4);
  int mt2, nt;
  for (int it = 0; tile_at(it, 128, 32, mt2, nt); ++it) {
    const int seg = nt >> 3;
    const int wrow0 = (seg == 0 ? 2048 : 4096 + (seg - 1) * 1024) + (nt & 7) * 128;
    f32x4 acc[4][8];
    zero_big(acc);
    mma_big3(acc, hx + (long)mt2 * 256 * 1024, wt + (long)wrow0 * 1024, smem);
    u16* dst = seg == 0 ? O : (seg == 1 ? Y : (seg == 2 ? S6 : S7));
    const float* STATS = (const float*)(p.ws + OFF_STATS);
    float* T = (float*)smem;
#pragma unroll 1
   for (int h = 0; h < 2; ++h) {
    const long row0 = (long)(mt2 * 2 + h) * 128;
    __syncthreads();
    big_to_lds(acc, T, h);
    __syncthreads();
#pragma unroll 1
    for (int i = 0; i < 8; ++i) {
      int idx = tid + i * 256;
      int r = idx >> 4, c0 = (idx & 15) * 8;
      float v[8];
      {
        float4 a = *(const float4*)(T + r * 132 + c0), bq = *(const float4*)(T + r * 132 + c0 + 4);
        v[0] = a.x; v[1] = a.y; v[2] = a.z; v[3] = a.w; v[4] = bq.x; v[5] = bq.y; v[6] = bq.z; v[7] = bq.w;
      }
      long ad = (row0 + r) * 1024 + (nt & 7) * 128 + c0;
      float o[8];
      if (seg >= 2) {
#pragma unroll
        for (int e = 0; e < 8; ++e) o[e] = sigmoidf_(v[e]);
      } else {
        uint4 d = *(const uint4*)(dst + ad);
        float dv[8] = {lo2f(d.x), hi2f(d.x), lo2f(d.y), hi2f(d.y), lo2f(d.z), hi2f(d.z), lo2f(d.w), hi2f(d.w)};
        if (seg == 0) {
          float4 st = *(const float4*)(STATS + ((row0 + r) * 4 + ((nt & 7) >> 1)) * 4);
          float mu = (st.x + st.z) * (1.f / 256.f);
          float var = fmaxf((st.y + st.w) * (1.f / 256.f) - mu * mu, 0.f);
          float rstd = rsqrtf(var + EPSV);
#pragma unroll
          for (int e = 0; e < 8; ++e) o[e] = (dv[e] - mu) * rstd * siluf_(v[e]);
        } else {
#pragma unroll
          for (int e = 0; e < 8; ++e) o[e] = dv[e] * geluf_(v[e]);
        }
      }
      uint4 ov;
      ov.x = pack2(o[0], o[1]); ov.y = pack2(o[2], o[3]); ov.z = pack2(o[4], o[5]); ov.w = pack2(o[6], o[7]);
      *(uint4*)(dst + ad) = ov;
    }
   }
  }
}

DI void phase_gemm_c(const Params& p, u16* smem) {
  const int tid = threadIdx.x, lane = tid & 63, wid = tid >> 6, wm = wid >> 1, wn = wid & 1, fr = lane & 15, fq = lane >> 4;
  const u16* A3 = (const u16*)(p.ws + OFF_O);
  const u16* A5 = (const u16*)(p.ws + OFF_Y);
  const u16* S6 = (const u16*)(p.ws + OFF_VT);
  const u16* S7 = (const u16*)(p.ws + OFF_P4);
  const u16* wro = (const u16*)(p.ws + OFF_WTRO);
  const u16* wlo = (const u16*)(p.ws + OFF_WTLO);
  u16* YM = (u16*)(p.ws + OFF_HX);
  int mt2, nt;
  for (int it = 0; tile_at(it, 128, 8, mt2, nt); ++it) {
    f32x4 a1[4][8];
    float* T = (float*)smem;
    zero_big(a1);
    mma_big3(a1, A3 + (long)mt2 * 256 * 1024, wro + (long)nt * 128 * 1024, smem);
#pragma unroll 1
    for (int h = 0; h < 2; ++h) {
      const long row0 = (long)(mt2 * 2 + h) * 128;
      __syncthreads();
      big_to_lds(a1, T, h);
      __syncthreads();
#pragma unroll 1
      for (int i = 0; i < 8; ++i) {
        int idx = tid + i * 256;
        int r = idx >> 4, c0 = (idx & 15) * 8;
        float4 a = *(const float4*)(T + r * 132 + c0), bq = *(const float4*)(T + r * 132 + c0 + 4);
        long ad = (row0 + r) * 1024 + nt * 128 + c0;
        uint4 g = *(const uint4*)(S6 + ad);
        a.x *= lo2f(g.x); a.y *= hi2f(g.x); a.z *= lo2f(g.y); a.w *= hi2f(g.y);
        bq.x *= lo2f(g.z); bq.y *= hi2f(g.z); bq.z *= lo2f(g.w); bq.w *= hi2f(g.w);
        *(uint4*)(YM + ad) = pack8(a, bq);
      }
    }
    zero_big(a1);
    mma_big3(a1, A5 + (long)mt2 * 256 * 1024, wlo + (long)nt * 128 * 1024, smem);
#pragma unroll 1
    for (int h = 0; h < 2; ++h) {
      const long row0 = (long)(mt2 * 2 + h) * 128;
      __syncthreads();
      big_to_lds(a1, T, h);
      __syncthreads();
#pragma unroll 1
      for (int i = 0; i < 8; ++i) {
        int idx = tid + i * 256;
        int r = idx >> 4, c0 = (idx & 15) * 8;
        float4 a = *(const float4*)(T + r * 132 + c0), bq = *(const float4*)(T + r * 132 + c0 + 4);
        long ad = (row0 + r) * 1024 + nt * 128 + c0;
        uint4 g = *(const uint4*)(S7 + ad);
        uint4 y = *(const uint4*)(YM + ad);
        a.x = lo2f(y.x) + a.x * lo2f(g.x); a.y = hi2f(y.x) + a.y * hi2f(g.x); a.z = lo2f(y.y) + a.z * lo2f(g.y); a.w = hi2f(y.y) + a.w * hi2f(g.y);
        bq.x = lo2f(y.z) + bq.x * lo2f(g.z); bq.y = hi2f(y.z) + bq.y * hi2f(g.z); bq.z = lo2f(y.w) + bq.z * lo2f(g.w); bq.w = hi2f(y.w) + bq.w * hi2f(g.w);
        *(uint4*)(YM + ad) = pack8(a, bq);
      }
    }
  }
}

DI void phase_gemm_d(const Params& p, u16* smem) {
  const int tid = threadIdx.x, lane = tid & 63, wid = tid >> 6, wm = wid >> 1, wn = wid & 1, fr = lane & 15, fq = lane >> 4;
  const u16* YM = (const u16*)(p.ws + OFF_HX);
  const u16* wo = (const u16*)(p.ws + OFF_WTO);
  const float* mod = (const float*)(p.ws + OFF_MOD);
  int mt2, nt;
  for (int it = 0; tile_at(it, 128, 8, mt2, nt); ++it) {
    const int b = mt2 / 32;
    f32x4 acc[4][8];
    zero_big(acc);
    mma_big3(acc, YM + (long)mt2 * 256 * 1024, wo + (long)nt * 128 * 1024, smem);
    float* T = (float*)smem;
#pragma unroll 1
   for (int h = 0; h < 2; ++h) {
    const long row0 = (long)(mt2 * 2 + h) * 128;
    __syncthreads();
    big_to_lds(acc, T, h);
    __syncthreads();
#pragma unroll 1
    for (int i = 0; i < 8; ++i) {
      int idx = tid + i * 256;
      int r = idx >> 4, c0 = (idx & 15) * 8;
      float4 a = *(const float4*)(T + r * 132 + c0), bq = *(const float4*)(T + r * 132 + c0 + 4);
      long ad = (row0 + r) * 1024 + nt * 128 + c0;
      float4 ga = *(const float4*)(mod + b * 6144 + 2048 + nt * 128 + c0), gb = *(const float4*)(mod + b * 6144 + 2048 + nt * 128 + c0 + 4);
      float4 xa = *(const float4*)(p.x + ad), xb = *(const float4*)(p.x + ad + 4);
      a.x = xa.x + ga.x * a.x; a.y = xa.y + ga.y * a.y; a.z = xa.z + ga.z * a.z; a.w = xa.w + ga.w * a.w;
      bq.x = xb.x + gb.x * bq.x; bq.y = xb.y + gb.y * bq.y; bq.z = xb.z + gb.z * bq.z; bq.w = xb.w + gb.w * bq.w;
      *(float4*)(p.out + ad) = a;
      *(float4*)(p.out + ad + 4) = bq;
    }
   }
  }
}

DI void phase_gemm_e(const Params& p, u16* smem) {
  const int tid = threadIdx.x, lane = tid & 63, wid = tid >> 6, wm = wid >> 1, wn = wid & 1, fr = lane & 15, fq = lane >> 4;
  const u16* HX2 = (const u16*)(p.ws + OFF_O);
  const u16* wq = (const u16*)(p.ws + OFF_WTQ);
  u16* QP = (u16*)(p.ws + OFF_Q);
  int mt2, nt;
  for (int it = 0; tile_at(it, 128, 8, mt2, nt); ++it) {
    f32x4 acc[4][8];
    zero_big(acc);
    mma_big3(acc, HX2 + (long)mt2 * 256 * 1024, wq + (long)nt * 128 * 1024, smem);
#pragma unroll 1
    for (int h = 0; h < 2; ++h) {
      const long row0 = (long)(mt2 * 2 + h) * 128;
      __syncthreads();
      big_to_lds(acc, (float*)smem, h);
      __syncthreads();
      tile_store_bf16((const float*)smem, QP + row0 * 1024 + nt * 128, 1024);
    }
  }
}

DI void ins16(float (&L)[16], float v) {
#pragma unroll
  for (int j = 15; j >= 1; --j) L[j] = __builtin_amdgcn_fmed3f(L[j - 1], L[j], v);
  L[0] = fmaxf(L[0], v);
}

DI void phase_peer_topk(const Params& p, u16* smem) {
  const int tid = threadIdx.x, lane = tid & 63, wid = tid >> 6, wm = wid >> 1, wn = wid & 1, fr = lane & 15, fq = lane >> 4;
  const u16* QP = (const u16*)(p.ws + OFF_Q);
  const u16* KEYS = (const u16*)(p.ws + OFF_KEYS);
  int* PIDX = (int*)(p.ws + OFF_KT);
  float* PG = (float*)(p.ws + OFF_KT + (size_t)NTOK * 128 * 4);
  float* sc = (float*)smem;
  const float NINF = -__builtin_inff();
  int mt, h;
  for (int it = 0; tile_at(it, 256, 8, mt, h); ++it) {
    const long row0 = (long)mt * 128;
    float L1[16], L2[16];
#pragma unroll
    for (int j = 0; j < 16; ++j) { L1[j] = NINF; L2[j] = NINF; }
#pragma unroll
    for (int ph = 0; ph < 2; ++ph) {
      f32x4 acc[4][4];
      zero_acc(acc);
      mma_loop<false>(acc, QP + row0 * 1024 + h * 128 + ph * 64, 1024, KEYS + (long)((h * 2 + ph) * 128) * 64, 64, 64, smem, Ident{});
#pragma unroll
      for (int mi = 0; mi < 4; ++mi)
#pragma unroll
        for (int ni = 0; ni < 4; ++ni)
#pragma unroll
          for (int j = 0; j < 4; ++j) {
            int r = wm * 64 + mi * 16 + fq * 4 + j, cl = wn * 64 + ni * 16 + fr;
            sc[r * 129 + cl] = acc[mi][ni][j];
          }
      __syncthreads();
      {
        const int row = tid & 127, kh = tid >> 7;
        float Lt[16];
#pragma unroll
        for (int j = 0; j < 16; ++j) Lt[j] = NINF;
        for (int kk = 0; kk < 64; ++kk) {
          const int k = kh * 64 + kk;
          float v = sc[row * 129 + k];
          v = __uint_as_float((__float_as_uint(v) & ~0x7Fu) | (unsigned)k);
          ins16(Lt, v);
        }
        if (kh == 1) {
#pragma unroll
          for (int j = 0; j < 16; ++j) sc[row * 129 + 64 + j] = Lt[j];
        }
        __syncthreads();
        if (kh == 0) {
#pragma unroll
          for (int j = 0; j < 16; ++j) ins16(Lt, sc[row * 129 + 64 + j]);
#pragma unroll
          for (int j = 0; j < 16; ++j) {
            if (ph == 0) L1[j] = Lt[j];
            else L2[j] = Lt[j];
          }
        }
      }
    }
    if (tid < 128) {
      int* myrow = (int*)(sc + tid * 129);
      float C[16];
#pragma unroll
      for (int j = 0; j < 16; ++j) {
        C[j] = NINF;
        myrow[j] = (int)(__float_as_uint(L1[j]) & 0x7Fu);
        myrow[16 + j] = (int)(__float_as_uint(L2[j]) & 0x7Fu);
      }
#pragma unroll
      for (int a = 0; a < 16; ++a)
#pragma unroll
        for (int b = 0; b < 16; ++b)
          if ((a + 1) * (b + 1) <= 16) {
            float s = __uint_as_float(__float_as_uint(L1[a]) & ~0x7Fu) + __uint_as_float(__float_as_uint(L2[b]) & ~0x7Fu);
            s = __uint_as_float((__float_as_uint(s) & ~0xFFu) | (unsigned)(a * 16 + b));
            ins16(C, s);
          }
      float m = __uint_as_float(__float_as_uint(C[0]) & ~0xFFu);
      float w[16];
      float sum = 0.f;
#pragma unroll
      for (int k = 0; k < 16; ++k) {
        w[k] = __expf(__uint_as_float(__float_as_uint(C[k]) & ~0xFFu) - m);
        sum += w[k];
      }
      float rs = 1.f / sum;
      long base = (row0 + tid) * 128 + h * 16;
#pragma unroll
      for (int k = 0; k < 16; ++k) {
        unsigned ab = __float_as_uint(C[k]) & 0xFFu;
        int e = myrow[ab >> 4] * 128 + myrow[16 + (ab & 15)];
        PIDX[base + k] = e;
        PG[base + k] = w[k] * rs;
      }
    }
  }
}

DI float dotq16(uint4 q, const float* x) {
  float s = 0.f;
  s += (float)(q.x & 0xffu) * x[0] + (float)((q.x >> 8) & 0xffu) * x[1] + (float)((q.x >> 16) & 0xffu) * x[2] + (float)(q.x >> 24) * x[3];
  s += (float)(q.y & 0xffu) * x[4] + (float)((q.y >> 8) & 0xffu) * x[5] + (float)((q.y >> 16) & 0xffu) * x[6] + (float)(q.y >> 24) * x[7];
  s += (float)(q.z & 0xffu) * x[8] + (float)((q.z >> 8) & 0xffu) * x[9] + (float)((q.z >> 16) & 0xffu) * x[10] + (float)(q.z >> 24) * x[11];
  s += (float)(q.w & 0xffu) * x[12] + (float)((q.w >> 8) & 0xffu) * x[13] + (float)((q.w >> 16) & 0xffu) * x[14] + (float)(q.w >> 24) * x[15];
  return s;
}
DI void axpyq16(float* o, float c, uint4 q) {
  o[0] += c * (float)(q.x & 0xffu); o[1] += c * (float)((q.x >> 8) & 0xffu); o[2] += c * (float)((q.x >> 16) & 0xffu); o[3] += c * (float)(q.x >> 24);
  o[4] += c * (float)(q.y & 0xffu); o[5] += c * (float)((q.y >> 8) & 0xffu); o[6] += c * (float)((q.y >> 16) & 0xffu); o[7] += c * (float)(q.y >> 24);
  o[8] += c * (float)(q.z & 0xffu); o[9] += c * (float)((q.z >> 8) & 0xffu); o[10] += c * (float)((q.z >> 16) & 0xffu); o[11] += c * (float)(q.z >> 24);
  o[12] += c * (float)(q.w & 0xffu); o[13] += c * (float)((q.w >> 8) & 0xffu); o[14] += c * (float)((q.w >> 16) & 0xffu); o[15] += c * (float)(q.w >> 24);
}

template <int MODE>
DI void phase_peer_gather(const Params& p, float* outp) {
  const int lane = threadIdx.x & 63;
  const long gw = ((long)blockIdx.x * blockDim.x + threadIdx.x) >> 6;
  const long nw = ((long)gridDim.x * blockDim.x) >> 6;
  const u16* HX2 = (const u16*)(p.ws + OFF_O);
  const unsigned char* UT = p.ws + OFF_UT;
  const unsigned char* VTAB = p.ws + OFF_VTAB;
  const float* USC = (const float*)(p.ws + OFF_USC);
  const float* VSC = (const float*)(p.ws + OFF_VSC);
  const int* PIDX = (const int*)(p.ws + OFF_KT);
  const float* PG = (const float*)(p.ws + OFF_KT + (size_t)NTOK * 128 * 4);
  const float* mod = (const float*)(p.ws + OFF_MOD);
  for (long t = gw; t < NTOK; t += nw) {
    float x[16];
    float xl = 0.f;
    {
      uint4 v0 = *(const uint4*)(HX2 + t * 1024 + lane * 16);
      uint4 v1 = *(const uint4*)(HX2 + t * 1024 + lane * 16 + 8);
      x[0] = lo2f(v0.x); x[1] = hi2f(v0.x); x[2] = lo2f(v0.y); x[3] = hi2f(v0.y);
      x[4] = lo2f(v0.z); x[5] = hi2f(v0.z); x[6] = lo2f(v0.w); x[7] = hi2f(v0.w);
      x[8] = lo2f(v1.x); x[9] = hi2f(v1.x); x[10] = lo2f(v1.y); x[11] = hi2f(v1.y);
      x[12] = lo2f(v1.z); x[13] = hi2f(v1.z); x[14] = lo2f(v1.w); x[15] = hi2f(v1.w);
#pragma unroll
      for (int i = 0; i < 16; ++i) xl += x[i];
    }
    float xm = 0.f;
#pragma unroll
    for (int i = 0; i < 16; ++i) xm = fmaxf(xm, fabsf(x[i]));
#pragma unroll
    for (int o = 32; o > 0; o >>= 1) xm = fmaxf(xm, __shfl_xor(xm, o));
    xm = fmaxf(xm, 1e-30f);
    const float xinv = 127.f / xm, xsc = xm * (1.f / 127.f);
    int xq[4];
#pragma unroll
    for (int w = 0; w < 4; ++w) {
      unsigned b0 = (unsigned)((int)rintf(x[w * 4 + 0] * xinv)) & 0xffu, b1 = (unsigned)((int)rintf(x[w * 4 + 1] * xinv)) & 0xffu;
      unsigned b2 = (unsigned)((int)rintf(x[w * 4 + 2] * xinv)) & 0xffu, b3 = (unsigned)((int)rintf(x[w * 4 + 3] * xinv)) & 0xffu;
      xq[w] = (int)(b0 | (b1 << 8) | (b2 << 16) | (b3 << 24));
    }
    const int e0 = PIDX[t * 128 + lane], e1 = PIDX[t * 128 + 64 + lane];
    const float g0 = PG[t * 128 + lane], g1 = PG[t * 128 + 64 + lane];
    float d0 = 0.f, d1 = 0.f;
#pragma unroll 1
    for (int pi = 0; pi < (MODE == 2 ? 0 : 128); pi += 8) {
      uint4 ua[8];
#pragma unroll
      for (int q = 0; q < 8; ++q) {
        int e = __shfl(pi < 64 ? e0 : e1, (pi + q) & 63);
        ua[q] = *(const uint4*)(UT + (long)e * 1024 + lane * 16);
      }
      int a8[8];
#pragma unroll
      for (int q = 0; q < 8; ++q) {
        int acc = __builtin_amdgcn_sdot4((int)ua[q].x, xq[0], 0, false);
        acc = __builtin_amdgcn_sdot4((int)ua[q].y, xq[1], acc, false);
        acc = __builtin_amdgcn_sdot4((int)ua[q].z, xq[2], acc, false);
        a8[q] = __builtin_amdgcn_sdot4((int)ua[q].w, xq[3], acc, false);
      }
      {
        const bool h5 = (lane & 32) != 0, h4 = (lane & 16) != 0, h3 = (lane & 8) != 0;
        int b4[4], b2[2], b1;
#pragma unroll
        for (int i = 0; i < 4; ++i) {
          int keep = h5 ? a8[4 + i] : a8[i], send = h5 ? a8[i] : a8[4 + i];
          b4[i] = keep + __shfl_xor(send, 32);
        }
#pragma unroll
        for (int i = 0; i < 2; ++i) {
          int keep = h4 ? b4[2 + i] : b4[i], send = h4 ? b4[i] : b4[2 + i];
          b2[i] = keep + __shfl_xor(send, 16);
        }
        {
          int keep = h3 ? b2[1] : b2[0], send = h3 ? b2[0] : b2[1];
          b1 = keep + __shfl_xor(send, 8);
        }
        b1 += __shfl_xor(b1, 4);
        b1 += __shfl_xor(b1, 2);
        b1 += __shfl_xor(b1, 1);
        int got = __shfl(b1, (lane & 7) * 8);
        if ((lane >> 3) == ((pi & 63) >> 3)) {
          if (pi < 64) d0 = (float)got * xsc;
          else d1 = (float)got * xsc;
        }
      }
    }
    float* COEF = (float*)(p.ws + OFF_HX);
    float c0, c1;
    if (MODE != 2) {
      c0 = g0 * geluf_(d0 * USC[e0]) * VSC[e0];
      c1 = g1 * geluf_(d1 * USC[e1]) * VSC[e1];
      if (MODE == 1) {
        COEF[t * 128 + lane] = c0;
        COEF[t * 128 + 64 + lane] = c1;
        continue;
      }
    } else {
      c0 = COEF[t * 128 + lane];
      c1 = COEF[t * 128 + 64 + lane];
    }
    const float csum = wave_sum(c0 + c1);
    float o[16];
#pragma unroll
    for (int i = 0; i < 16; ++i) o[i] = 0.f;
#pragma unroll 1
    for (int pi = 0; pi < 128; pi += 8) {
      uint4 va[8];
      float cf[8];
#pragma unroll
      for (int q = 0; q < 8; ++q) {
        int e = __shfl(pi < 64 ? e0 : e1, (pi + q) & 63);
        cf[q] = __shfl(pi < 64 ? c0 : c1, (pi + q) & 63);
        va[q] = *(const uint4*)(VTAB + (long)e * 1024 + lane * 16);
      }
#pragma unroll
      for (int q = 0; q < 8; ++q) axpyq16(o, cf[q], va[q]);
    }
    const int b = (int)(t / LS);
    const float* g2 = mod + b * 6144 + 5120;
    const float* xr = p.out + t * 1024;
    float* xw = outp + t * 1024;
    float ss = 0.f;
#pragma unroll
    for (int q4 = 0; q4 < 4; ++q4) {
      int c = lane * 16 + q4 * 4;
      float4 xv = *(const float4*)(xr + c);
      float4 gv = *(const float4*)(g2 + c);
      float* oo = o + q4 * 4;
      oo[0] = xv.x + gv.x * (oo[0] - 128.f * csum);
      oo[1] = xv.y + gv.y * (oo[1] - 128.f * csum);
      oo[2] = xv.z + gv.z * (oo[2] - 128.f * csum);
      oo[3] = xv.w + gv.w * (oo[3] - 128.f * csum);
      ss += oo[0] * oo[0] + oo[1] * oo[1] + oo[2] * oo[2] + oo[3] * oo[3];
    }
    ss = wave_sum(ss);
    float rstd = rsqrtf(ss * (1.f / 1024.f) + EPSV);
#pragma unroll
    for (int q4 = 0; q4 < 4; ++q4) {
      int c = lane * 16 + q4 * 4;
      float4 fg = *(const float4*)(p.final_g + c);
      float* oo = o + q4 * 4;
      float4 r;
      r.x = oo[0] * rstd * fg.x;
      r.y = oo[1] * rstd * fg.y;
      r.z = oo[2] * rstd * fg.z;
      r.w = oo[3] * rstd * fg.w;
      *(float4*)(xw + c) = r;
    }
  }
}

#define XB_TMO      128
#define XB_XCNT(j)  (256  + 64 * (j))
#define XB_XSUB(j)  (1280 + 64 * (j))
#define XB_XGEN(j)  (2304 + 64 * (j))
#define XB_TOP      3328
#define XB_TOPGEN   3392
#define XCD_BAR_WORDS 3456
#define XB_SPIN_CAP (1u << 18)
#define LAS __attribute__((address_space(3)))
DI unsigned xb_ld(unsigned* p) { return __hip_atomic_load(p, __ATOMIC_RELAXED, __HIP_MEMORY_SCOPE_AGENT); }
DI unsigned xb_add(unsigned* p, unsigned v) { return __hip_atomic_fetch_add(p, v, __ATOMIC_RELAXED, __HIP_MEMORY_SCOPE_AGENT); }
DI unsigned xb_xcc_id() { return (unsigned)__builtin_amdgcn_s_getreg((3 << 11) | 20) & 0xFu; }
#define XB_SPIN(cond, bar) do { unsigned _sp = 0; while (cond) { __builtin_amdgcn_s_sleep(1); \
    if ((++_sp & 255u) == 0u) { if (xb_ld(&(bar)[XB_TMO])) break; if (_sp > XB_SPIN_CAP) { atomicAdd(&(bar)[XB_TMO], 1u); break; } } } } while (0)
struct XcdBarrier {
  unsigned* bar;
  unsigned x;
  volatile LAS unsigned* st;
};
DI XcdBarrier xcd_barrier_post(unsigned* bar, volatile LAS unsigned* st) {
  XcdBarrier b;
  b.bar = bar;
  b.x = xb_xcc_id();
  b.st = st;
  if (threadIdx.x == 0) (void)xb_add(&bar[XB_XCNT(b.x)], 1u);
  return b;
}
DI void xcd_barrier_complete(unsigned* bar, unsigned x, unsigned& nloc, unsigned& nx) {
  const unsigned G = gridDim.x * gridDim.y * gridDim.z;
  unsigned sum, cnt, mine, sp = 0u;
  for (;;) {
    sum = 0u; cnt = 0u; mine = 0u;
#pragma unroll
    for (unsigned j = 0; j < 16; ++j) {
      const unsigned c = xb_ld(&bar[XB_XCNT(j)]);
      sum += c;
      cnt += (c > 0u) ? 1u : 0u;
      mine = (j == x) ? c : mine;
    }
    if (sum == G) break;
    __builtin_amdgcn_s_sleep(1);
    if ((++sp & 255u) == 0u) {
      if (xb_ld(&bar[XB_TMO])) break;
      if (sp > XB_SPIN_CAP) { atomicAdd(&bar[XB_TMO], 1u); break; }
    }
  }
  nloc = mine > 0u ? mine : 1u;
  nx = cnt > 0u ? cnt : 1u;
}
DI void xcd_barrier(const XcdBarrier& b) {
  asm volatile("s_waitcnt vmcnt(0)" ::: "memory");
  __syncthreads();
  if (threadIdx.x == 0) {
    unsigned* bar = b.bar;
    __builtin_amdgcn_s_waitcnt(0);
    unsigned nloc = b.st[0], nx = b.st[1];
    if (nloc == 0u) { xcd_barrier_complete(bar, b.x, nloc, nx); b.st[0] = nloc; b.st[1] = nx; }
    const unsigned old = xb_add(&bar[XB_XSUB(b.x)], 1u);
    const unsigned gen = old / nloc;
    if (old + 1u == (gen + 1u) * nloc) {
      __builtin_amdgcn_fence(__ATOMIC_RELEASE, "agent");
      asm volatile("s_waitcnt vmcnt(0)" ::: "memory");
      const unsigned og = xb_add(&bar[XB_TOP], 1u);
      const unsigned tg = og / nx;
      if (og + 1u == (tg + 1u) * nx) xb_add(&bar[XB_TOPGEN], 1u);
      else XB_SPIN(xb_ld(&bar[XB_TOPGEN]) == tg, bar);
      __builtin_amdgcn_fence(__ATOMIC_ACQUIRE, "agent");
      xb_add(&bar[XB_XGEN(b.x)], 1u);
      asm volatile("s_waitcnt vmcnt(0)" ::: "memory");
    } else {
      XB_SPIN(xb_ld(&bar[XB_XGEN(b.x)]) == gen, bar);
      __builtin_amdgcn_fence(__ATOMIC_ACQUIRE, "agent");
      asm volatile("s_waitcnt vmcnt(0)" ::: "memory");
    }
  }
  __syncthreads();
}

constexpr int NPHASE = 14;

__global__ void __launch_bounds__(256, 2) mega(Params p) {
  extern __shared__ __attribute__((aligned(16))) unsigned char lds_raw[];
  u16* smem = (u16*)lds_raw;
  float* tabs = (float*)(lds_raw + LDS_MAIN);
#ifndef ONLY
#define ONLY -1
#endif
  const int lo = (int)p.ph_lo, hi = (int)p.ph_hi;
  volatile LAS unsigned* xst = (volatile LAS unsigned*)(lds_raw + LDS_MAIN + 3072);
  if (threadIdx.x == 0) { xst[0] = 0u; xst[1] = 0u; }
  __syncthreads();
  XcdBarrier xb = xcd_barrier_post((unsigned*)(p.ws + OFF_BAR), xst);
#ifndef REP_MASK
#define REP_MASK 0
#endif
#define PHS(n, call)                                        \
  if ((ONLY < 0 || ONLY == n) && lo <= n && n < hi) {       \
    if ((REP_MASK >> n) & 1) {                              \
      call;                                                 \
      cg::this_grid().sync();                               \
    }                                                       \
    call;                                                   \
    if (n + 1 < hi) {                                       \
      if (lo < 0) cg::this_grid().sync();                   \
      else xcd_barrier(xb);                                 \
    }                                                       \
  }
  PHS(0, phase_prep(p, smem))
#ifndef REP_SYNC
#define REP_SYNC 0
#endif
  for (int i = 0; i < REP_SYNC; ++i) xcd_barrier(xb);
  PHS(1, phase_norm1(p))
  PHS(2, phase_gemm_a(p, smem))
  PHS(3, phase3(p, smem, tabs))
  PHS(4, phase4(p))
  PHS(5, phase5(p, smem, tabs))
  PHS(6, phase_gemm_b(p, smem))
  PHS(7, phase_gemm_c(p, smem))
  PHS(8, phase_gemm_d(p, smem))
  PHS(9, phase_norm2(p))
  PHS(10, phase_gemm_e(p, smem))
  PHS(11, phase_peer_topk(p, smem))
#ifndef REP_GATHER
#define REP_GATHER 0
#endif
  PHS(12, phase_peer_gather<1>(p, p.out))
  PHS(13, phase_peer_gather<2>(p, p.out))
}

extern "C" void kernel_launch(void* const* d_in, const int* in_sizes, int n_in, void* d_out, int out_size, void* d_ws,
                              size_t ws_size, hipStream_t stream) {
  static int grid_blocks = 0;
  if (!grid_blocks) {
    int dev = 0, cus = 0, per_cu = 0;
    hipGetDevice(&dev);
    hipDeviceGetAttribute(&cus, hipDeviceAttributeMultiprocessorCount, dev);
    hipFuncSetAttribute((const void*)mega, hipFuncAttributeMaxDynamicSharedMemorySize, LDS_BYTES);
    hipOccupancyMaxActiveBlocksPerMultiprocessor(&per_cu, (const void*)mega, 256, LDS_BYTES);
    if (per_cu < 1) per_cu = 1;
    if (per_cu > 2) per_cu = 2;
    grid_blocks = cus * per_cu;
    fprintf(stderr, "mega: cus=%d per_cu=%d grid=%d ws_need=%zu ws_size=%zu\n", cus, per_cu, grid_blocks, (size_t)WS_END, ws_size);
  }
  if (ws_size < WS_END2 || n_in != 25) {
    fprintf(stderr, "mega: workspace too small (%zu < %zu) or n_in=%d\n", ws_size, (size_t)WS_END, n_in);
    return;
  }
  hipMemsetAsync((unsigned char*)d_ws + OFF_BAR, 0, 16384, stream);
  Params p{};
  const float** pp = (const float**)&p;
  for (int i = 0; i < 25; ++i) pp[i] = (const float*)d_in[i];
  p.out = (float*)d_out;
  p.ws = (unsigned char*)d_ws;
#if MULTI
  for (int ph = 0; ph < NPHASE; ++ph) {
    p.ph_lo = ph;
    p.ph_hi = ph + 1;
    hipLaunchKernelGGL(mega, dim3(grid_blocks), dim3(256), LDS_BYTES, stream, p);
  }
#else
  p.ph_lo = 0;
  p.ph_hi = NPHASE;
  void* args[] = {&p};
  hipError_t e = hipLaunchCooperativeKernel((const void*)mega, dim3(grid_blocks), dim3(256), args, LDS_BYTES, stream);
  if (e != hipSuccess) fprintf(stderr, "cooperative launch failed: %s (grid %d)\n", hipGetErrorString(e), grid_blocks);
#endif
}
```

```cpp
#include <hip/hip_runtime.h>
#include <hip/hip_bf16.h>
#include <hip/hip_cooperative_groups.h>
#include <cstdio>
namespace cg = cooperative_groups;

typedef unsigned short u16;
using bf16x8 = __attribute__((ext_vector_type(8))) short;
using f32x4 = __attribute__((ext_vector_type(4))) float;
#define DI __device__ __forceinline__

#ifndef MULTI
#define MULTI 0
#endif

constexpr int NB = 4, LS = 8192, LCX = 256, DM = 1024;
constexpr int NTOK = NB * LS;
constexpr int NCTX = NB * LCX;
constexpr int NROW = NTOK + NCTX;
constexpr int NCHUNK = NROW / 128;
constexpr int INC = 7168;
constexpr float EPSV = 1e-6f;

constexpr size_t al256(size_t x) { return (x + 255) & ~size_t(255); }
constexpr size_t OFF_WTIN = 0;
constexpr size_t OFF_WTRO = OFF_WTIN + al256((size_t)INC * 1024 * 2);
constexpr size_t OFF_WTLO = OFF_WTRO + al256((size_t)1024 * 1024 * 2);
constexpr size_t OFF_WTO = OFF_WTLO + al256((size_t)1024 * 1024 * 2);
constexpr size_t OFF_WTQ = OFF_WTO + al256((size_t)1024 * 1024 * 2);
constexpr size_t OFF_WAT = OFF_WTQ + al256((size_t)1024 * 1024 * 2);
constexpr size_t OFF_KEYS = OFF_WAT + al256((size_t)2 * 2 * 8 * 128 * 128 * 2);
constexpr size_t OFF_MOD = OFF_KEYS + al256((size_t)8 * 2 * 128 * 64 * 2);
constexpr size_t OFF_LA = OFF_MOD + al256((size_t)5 * 6144 * 4);
constexpr size_t OFF_LB = OFF_LA + al256((size_t)2 * NCHUNK * 1024 * 4);
constexpr size_t OFF_LH = OFF_LB + al256((size_t)2 * NCHUNK * 1024 * 4);
constexpr size_t OFF_UT = OFF_LH + al256((size_t)2 * NCHUNK * 1024 * 4);
constexpr size_t OFF_VTAB = OFF_UT + al256((size_t)16384 * 1024);
constexpr size_t OFF_USC = OFF_VTAB + al256((size_t)16384 * 1024);
constexpr size_t OFF_VSC = OFF_USC + al256((size_t)16384 * 4);
constexpr size_t OFF_HX = OFF_VSC + al256((size_t)16384 * 4);
constexpr size_t OFF_Q = OFF_HX + al256((size_t)NROW * 1024 * 2);
constexpr size_t OFF_K = OFF_Q + al256((size_t)NROW * 512 * 2);
constexpr size_t OFF_VT = OFF_K + al256((size_t)NROW * 512 * 2);
constexpr size_t OFF_P4 = OFF_VT + al256((size_t)NROW * 1024 * 2);
constexpr size_t OFF_O = OFF_P4 + al256((size_t)NROW * 1024 * 2);
constexpr size_t OFF_STATS = OFF_O + al256((size_t)NTOK * 1024 * 2);
constexpr size_t OFF_KVC = OFF_STATS + al256((size_t)NTOK * 16 * 4);
constexpr size_t OFF_KT = OFF_KVC + al256((size_t)32 * 2 * 32768 * 2);
constexpr size_t OFF_Y = OFF_KT;
constexpr size_t WS_END = OFF_Y + al256((size_t)NTOK * 1024 * 2);

constexpr size_t OFF_BAR = WS_END;
constexpr size_t WS_END2 = OFF_BAR + 16384;
constexpr int LDS_MAIN = 4 * 128 * 72 * 2;
constexpr int LDS_BYTES = LDS_MAIN + 4096;

struct Params {
  const float *x, *c, *ctx, *c_ctx, *mod_w, *mod_b, *norm1_g, *norm2_g, *w_in, *ret_decay, *conv_w, *conv_b, *lru_wa,
      *lru_ba, *lru_wx, *lru_bx, *lru_lambda, *w_ret_out, *w_lru_out, *w_out, *peer_wq, *peer_keys, *peer_u, *peer_v,
      *final_g;
  float* out;
  unsigned char* ws;
  long ph_lo, ph_hi;
};

typedef __bf16 bf16x2_t __attribute__((ext_vector_type(2)));
DI u16 f2bf(float f) { return __builtin_bit_cast(u16, (__bf16)f); }
DI float bf2f(u16 h) { return __uint_as_float(((unsigned)h) << 16); }
DI unsigned pack2(float a, float b) {
  bf16x2_t v = {(__bf16)a, (__bf16)b};
  return __builtin_bit_cast(unsigned, v);
}
DI float lo2f(unsigned w) { return __uint_as_float(w << 16); }
DI float hi2f(unsigned w) { return __uint_as_float(w & 0xffff0000u); }
DI float wave_sum(float v) {
#pragma unroll
  for (int o = 32; o > 0; o >>= 1) v += __shfl_xor(v, o);
  return v;
}
DI float sigmoidf_(float x) { return __builtin_amdgcn_rcpf(1.f + __expf(-x)); }
DI float siluf_(float x) { return x * __builtin_amdgcn_rcpf(1.f + __expf(-x)); }
DI float geluf_(float x) {
  float z2 = 1.5957691216057308f * (x + 0.044715f * x * x * x);
  return x * __builtin_amdgcn_rcpf(1.f + __expf(-z2));
}
DI float softplusf_(float x) { return x > 20.f ? x : log1pf(__expf(x)); }

struct Ident {
  static constexpr bool id = true;
  DI float operator()(float v, int, int) const { return v; }
};
struct ColScale {
  static constexpr bool id = false;
  const float* tab;
  DI float operator()(float v, int, int k) const { return v * tab[k]; }
};
struct RowScale {
  static constexpr bool id = false;
  const float* tab;
  DI float operator()(float v, int r, int) const { return v * tab[r]; }
};

template <class AX>
DI uint4 xform8(uint4 v, int row, int k, const AX& ax) {
  if constexpr (AX::id) {
    return v;
  } else {
    uint4 o;
    o.x = pack2(ax(lo2f(v.x), row, k + 0), ax(hi2f(v.x), row, k + 1));
    o.y = pack2(ax(lo2f(v.y), row, k + 2), ax(hi2f(v.y), row, k + 3));
    o.z = pack2(ax(lo2f(v.z), row, k + 4), ax(hi2f(v.z), row, k + 5));
    o.w = pack2(ax(lo2f(v.w), row, k + 6), ax(hi2f(v.w), row, k + 7));
    return o;
  }
}

template <bool A_LDS, int NI, class AX>
DI void mma_loop(f32x4 (&acc)[4][NI], const u16* __restrict__ A, long lda, const u16* __restrict__ Bt, long ldb, int K,
                 u16* smem, const AX& ax) {
  const int tid = threadIdx.x, lane = tid & 63, wid = tid >> 6, wm = wid >> 1, wn = wid & 1, fr = lane & 15,
            fq = lane >> 4;
  u16* sA = smem;
  u16* sB = smem + 2 * 128 * 72;
  const int nk = K >> 6;
  uint4 ra[4], rb[NI];
  __syncthreads();
#pragma unroll
  for (int i = 0; i < 4; ++i) {
    int c = tid + i * 256;
    int row = c >> 3, kc = (c & 7) * 8;
    if (!A_LDS) ra[i] = *(const uint4*)(A + (long)row * lda + kc);
    if (i < NI) rb[i] = *(const uint4*)(Bt + (long)row * ldb + kc);
  }
#pragma unroll
  for (int i = 0; i < 4; ++i) {
    int c = tid + i * 256;
    int row = c >> 3, kc = (c & 7) * 8;
    const int pk = (((c & 7) ^ ((row >> 1) & 7)) << 3);
    if (!A_LDS) *(uint4*)(sA + row * 64 + pk) = xform8(ra[i], row, kc, ax);
    if (i < NI) *(uint4*)(sB + row * 64 + pk) = rb[i];
  }
  __syncthreads();
  for (int kt = 0; kt < nk; ++kt) {
    const int cur = kt & 1;
    if (kt + 1 < nk) {
#pragma unroll
      for (int i = 0; i < 4; ++i) {
        int c = tid + i * 256;
        int row = c >> 3, kc = (c & 7) * 8;
        if (!A_LDS) ra[i] = *(const uint4*)(A + (long)row * lda + (kt + 1) * 64 + kc);
        if (i < NI) rb[i] = *(const uint4*)(Bt + (long)row * ldb + (kt + 1) * 64 + kc);
      }
    }
#pragma unroll
    for (int ks = 0; ks < 2; ++ks) {
      bf16x8 af[4];
#pragma unroll
      for (int mi = 0; mi < 4; ++mi) {
        if (A_LDS)
          af[mi] = *(const bf16x8*)(smem + (wm * 64 + mi * 16 + fr) * 144 + kt * 64 + ks * 32 + fq * 8);
        else
          af[mi] = *(const bf16x8*)(sA + cur * (128 * 64) + (wm * 64 + mi * 16 + fr) * 64 + (((ks * 4 + fq) ^ (fr >> 1)) << 3));
      }
#pragma unroll
      for (int ni = 0; ni < NI; ++ni) {
        bf16x8 bq = *(const bf16x8*)(sB + cur * (128 * 64) + (wn * (16 * NI) + ni * 16 + fr) * 64 + (((ks * 4 + fq) ^ (fr >> 1)) << 3));
#pragma unroll
        for (int mi = 0; mi < 4; ++mi)
          acc[mi][ni] = __builtin_amdgcn_mfma_f32_16x16x32_bf16(af[mi], bq, acc[mi][ni], 0, 0, 0);
      }
    }
    if (kt + 1 < nk) {
      const int nx = cur ^ 1;
#pragma unroll
      for (int i = 0; i < 4; ++i) {
        int c = tid + i * 256;
        int row = c >> 3, kc = (c & 7) * 8;
        const int pk = (((c & 7) ^ ((row >> 1) & 7)) << 3);
        if (!A_LDS) *(uint4*)(sA + nx * (128 * 64) + row * 64 + pk) = xform8(ra[i], row, (kt + 1) * 64 + kc, ax);
        if (i < NI) *(uint4*)(sB + nx * (128 * 64) + row * 64 + pk) = rb[i];
      }
    }
    __syncthreads();
  }
}

DI void mma_loop2(f32x4 (&acc)[4][4], const u16* __restrict__ A, long lda, const u16* __restrict__ Bt, long ldb, int K, u16* smem) {
  const int tid = threadIdx.x, lane = tid & 63, wid = tid >> 6, wm = wid >> 1, wn = wid & 1, fr = lane & 15,
            fq = lane >> 4;
  u16* sA = smem;
  u16* sB = smem + 2 * 128 * 72;
  const int nk = K >> 6;
  uint4 a00, b00, a01, b01, a02, b02, a03, b03, a10, b10, a11, b11, a12, b12, a13, b13;
  const int lrow = tid >> 3, kc = (tid & 7) * 8;
  const u16* ap = A + (long)lrow * lda + kc;
  const u16* bp = Bt + (long)lrow * ldb + kc;
  const int soff = lrow * 64 + ((((tid & 7) ^ ((lrow >> 1) & 7))) << 3);
  __syncthreads();
  {
    a00 = *(const uint4*)(ap + (long)(0) * lda + (0) * 64);
    b00 = *(const uint4*)(bp + (long)(0) * ldb + (0) * 64);
    a01 = *(const uint4*)(ap + (long)(32) * lda + (0) * 64);
    b01 = *(const uint4*)(bp + (long)(32) * ldb + (0) * 64);
    a02 = *(const uint4*)(ap + (long)(64) * lda + (0) * 64);
    b02 = *(const uint4*)(bp + (long)(64) * ldb + (0) * 64);
    a03 = *(const uint4*)(ap + (long)(96) * lda + (0) * 64);
    b03 = *(const uint4*)(bp + (long)(96) * ldb + (0) * 64);
    a10 = *(const uint4*)(ap + (long)(0) * lda + (1) * 64);
    b10 = *(const uint4*)(bp + (long)(0) * ldb + (1) * 64);
    a11 = *(const uint4*)(ap + (long)(32) * lda + (1) * 64);
    b11 = *(const uint4*)(bp + (long)(32) * ldb + (1) * 64);
    a12 = *(const uint4*)(ap + (long)(64) * lda + (1) * 64);
    b12 = *(const uint4*)(bp + (long)(64) * ldb + (1) * 64);
    a13 = *(const uint4*)(ap + (long)(96) * lda + (1) * 64);
    b13 = *(const uint4*)(bp + (long)(96) * ldb + (1) * 64);
    *(uint4*)(sA + 0 * (128 * 64) + soff + 0) = a00;
    *(uint4*)(sB + 0 * (128 * 64) + soff + 0) = b00;
    *(uint4*)(sA + 0 * (128 * 64) + soff + 2048) = a01;
    *(uint4*)(sB + 0 * (128 * 64) + soff + 2048) = b01;
    *(uint4*)(sA + 0 * (128 * 64) + soff + 4096) = a02;
    *(uint4*)(sB + 0 * (128 * 64) + soff + 4096) = b02;
    *(uint4*)(sA + 0 * (128 * 64) + soff + 6144) = a03;
    *(uint4*)(sB + 0 * (128 * 64) + soff + 6144) = b03;
  }
  __syncthreads();
  for (int kt = 0; kt < nk; kt += 2) {
    if (kt + 2 < nk) {
    a00 = *(const uint4*)(ap + (long)(0) * lda + (kt + 2) * 64);
    b00 = *(const uint4*)(bp + (long)(0) * ldb + (kt + 2) * 64);
    a01 = *(const uint4*)(ap + (long)(32) * lda + (kt + 2) * 64);
    b01 = *(const uint4*)(bp + (long)(32) * ldb + (kt + 2) * 64);
    a02 = *(const uint4*)(ap + (long)(64) * lda + (kt + 2) * 64);
    b02 = *(const uint4*)(bp + (long)(64) * ldb + (kt + 2) * 64);
    a03 = *(const uint4*)(ap + (long)(96) * lda + (kt + 2) * 64);
    b03 = *(const uint4*)(bp + (long)(96) * ldb + (kt + 2) * 64);
    }
    __builtin_amdgcn_s_setprio(1);
#pragma unroll
    for (int ks = 0; ks < 2; ++ks) {
      bf16x8 af[4];
#pragma unroll
      for (int mi = 0; mi < 4; ++mi)
        af[mi] = *(const bf16x8*)(sA + 0 * (128 * 64) + (wm * 64 + mi * 16 + fr) * 64 + (((ks * 4 + fq) ^ (fr >> 1)) << 3));
#pragma unroll
      for (int ni = 0; ni < 4; ++ni) {
        bf16x8 bq = *(const bf16x8*)(sB + 0 * (128 * 64) + (wn * 64 + ni * 16 + fr) * 64 + (((ks * 4 + fq) ^ (fr >> 1)) << 3));
#pragma unroll
        for (int mi = 0; mi < 4; ++mi)
          acc[mi][ni] = __builtin_amdgcn_mfma_f32_16x16x32_bf16(af[mi], bq, acc[mi][ni], 0, 0, 0);
      }
    }
    __builtin_amdgcn_s_setprio(0);
    *(uint4*)(sA + 1 * (128 * 64) + soff + 0) = a10;
    *(uint4*)(sB + 1 * (128 * 64) + soff + 0) = b10;
    *(uint4*)(sA + 1 * (128 * 64) + soff + 2048) = a11;
    *(uint4*)(sB + 1 * (128 * 64) + soff + 2048) = b11;
    *(uint4*)(sA + 1 * (128 * 64) + soff + 4096) = a12;
    *(uint4*)(sB + 1 * (128 * 64) + soff + 4096) = b12;
    *(uint4*)(sA + 1 * (128 * 64) + soff + 6144) = a13;
    *(uint4*)(sB + 1 * (128 * 64) + soff + 6144) = b13;
    __syncthreads();
    if (kt + 3 < nk) {
    a10 = *(const uint4*)(ap + (long)(0) * lda + (kt + 3) * 64);
    b10 = *(const uint4*)(bp + (long)(0) * ldb + (kt + 3) * 64);
    a11 = *(const uint4*)(ap + (long)(32) * lda + (kt + 3) * 64);
    b11 = *(const uint4*)(bp + (long)(32) * ldb + (kt + 3) * 64);
    a12 = *(const uint4*)(ap + (long)(64) * lda + (kt + 3) * 64);
    b12 = *(const uint4*)(bp + (long)(64) * ldb + (kt + 3) * 64);
    a13 = *(const uint4*)(ap + (long)(96) * lda + (kt + 3) * 64);
    b13 = *(const uint4*)(bp + (long)(96) * ldb + (kt + 3) * 64);
    }
    __builtin_amdgcn_s_setprio(1);
#pragma unroll
    for (int ks = 0; ks < 2; ++ks) {
      bf16x8 af[4];
#pragma unroll
      for (int mi = 0; mi < 4; ++mi)
        af[mi] = *(const bf16x8*)(sA + 1 * (128 * 64) + (wm * 64 + mi * 16 + fr) * 64 + (((ks * 4 + fq) ^ (fr >> 1)) << 3));
#pragma unroll
      for (int ni = 0; ni < 4; ++ni) {
        bf16x8 bq = *(const bf16x8*)(sB + 1 * (128 * 64) + (wn * 64 + ni * 16 + fr) * 64 + (((ks * 4 + fq) ^ (fr >> 1)) << 3));
#pragma unroll
        for (int mi = 0; mi < 4; ++mi)
          acc[mi][ni] = __builtin_amdgcn_mfma_f32_16x16x32_bf16(af[mi], bq, acc[mi][ni], 0, 0, 0);
      }
    }
    __builtin_amdgcn_s_setprio(0);
    if (kt + 2 < nk) {
    *(uint4*)(sA + 0 * (128 * 64) + soff + 0) = a00;
    *(uint4*)(sB + 0 * (128 * 64) + soff + 0) = b00;
    *(uint4*)(sA + 0 * (128 * 64) + soff + 2048) = a01;
    *(uint4*)(sB + 0 * (128 * 64) + soff + 2048) = b01;
    *(uint4*)(sA + 0 * (128 * 64) + soff + 4096) = a02;
    *(uint4*)(sB + 0 * (128 * 64) + soff + 4096) = b02;
    *(uint4*)(sA + 0 * (128 * 64) + soff + 6144) = a03;
    *(uint4*)(sB + 0 * (128 * 64) + soff + 6144) = b03;
    }
    __syncthreads();
  }
}

DI void mma_big(f32x4 (&acc)[4][8], const u16* __restrict__ A, const u16* __restrict__ Bt, u16* smem) {
  const int tid = threadIdx.x, lane = tid & 63, wid = tid >> 6, fr = lane & 15, fq = lane >> 4;
  u16* sA = smem;
  u16* sB = smem + 16384;
  uint4 a00, a01, a02, a03, a10, a11, a12, a13, b00, b01, b10, b11;
  const u16* ap = A + (long)(tid >> 2) * 1024 + (tid & 3) * 8;
  const u16* bp = Bt + (long)(tid >> 2) * 1024 + (tid & 3) * 8;
  const int soff = (tid >> 2) * 32 + ((((tid & 3) ^ ((0 - (tid >> 4)) & 3))) << 3);
  const int rpk = ((fq ^ ((0 - (fr >> 2)) & 3)) << 3);
  __syncthreads();
  {
    a00 = *(const uint4*)(ap + (long)(0) * 1024 + (0) * 32);
    a01 = *(const uint4*)(ap + (long)(64) * 1024 + (0) * 32);
    a02 = *(const uint4*)(ap + (long)(128) * 1024 + (0) * 32);
    a03 = *(const uint4*)(ap + (long)(192) * 1024 + (0) * 32);
    b00 = *(const uint4*)(bp + (long)(0) * 1024 + (0) * 32);
    b01 = *(const uint4*)(bp + (long)(64) * 1024 + (0) * 32);
    a10 = *(const uint4*)(ap + (long)(0) * 1024 + (1) * 32);
    a11 = *(const uint4*)(ap + (long)(64) * 1024 + (1) * 32);
    a12 = *(const uint4*)(ap + (long)(128) * 1024 + (1) * 32);
    a13 = *(const uint4*)(ap + (long)(192) * 1024 + (1) * 32);
    b10 = *(const uint4*)(bp + (long)(0) * 1024 + (1) * 32);
    b11 = *(const uint4*)(bp + (long)(64) * 1024 + (1) * 32);
    *(uint4*)(sA + 0 * 8192 + soff + 0) = a00;
    *(uint4*)(sA + 0 * 8192 + soff + 2048) = a01;
    *(uint4*)(sA + 0 * 8192 + soff + 4096) = a02;
    *(uint4*)(sA + 0 * 8192 + soff + 6144) = a03;
    *(uint4*)(sB + 0 * 4096 + soff + 0) = b00;
    *(uint4*)(sB + 0 * 4096 + soff + 2048) = b01;
  }
  __syncthreads();
  for (int kt = 0; kt < 32; kt += 2) {
    *(uint4*)(sA + 1 * 8192 + soff + 0) = a10;
    *(uint4*)(sA + 1 * 8192 + soff + 2048) = a11;
    *(uint4*)(sA + 1 * 8192 + soff + 4096) = a12;
    *(uint4*)(sA + 1 * 8192 + soff + 6144) = a13;
    *(uint4*)(sB + 1 * 4096 + soff + 0) = b10;
    *(uint4*)(sB + 1 * 4096 + soff + 2048) = b11;
    if (kt + 2 < 32) {
    a00 = *(const uint4*)(ap + (long)(0) * 1024 + (kt + 2) * 32);
    a01 = *(const uint4*)(ap + (long)(64) * 1024 + (kt + 2) * 32);
    a02 = *(const uint4*)(ap + (long)(128) * 1024 + (kt + 2) * 32);
    a03 = *(const uint4*)(ap + (long)(192) * 1024 + (kt + 2) * 32);
    b00 = *(const uint4*)(bp + (long)(0) * 1024 + (kt + 2) * 32);
    b01 = *(const uint4*)(bp + (long)(64) * 1024 + (kt + 2) * 32);
    a10 = *(const uint4*)(ap + (long)(0) * 1024 + (kt + 3) * 32);
    a11 = *(const uint4*)(ap + (long)(64) * 1024 + (kt + 3) * 32);
    a12 = *(const uint4*)(ap + (long)(128) * 1024 + (kt + 3) * 32);
    a13 = *(const uint4*)(ap + (long)(192) * 1024 + (kt + 3) * 32);
    b10 = *(const uint4*)(bp + (long)(0) * 1024 + (kt + 3) * 32);
    b11 = *(const uint4*)(bp + (long)(64) * 1024 + (kt + 3) * 32);
    }
    {
      bf16x8 af[4];
      __builtin_amdgcn_s_setprio(1);
#pragma unroll
      for (int mi = 0; mi < 4; ++mi) af[mi] = *(const bf16x8*)(sA + 0 * 8192 + (wid * 64 + mi * 16 + fr) * 32 + rpk);
#pragma unroll
      for (int ni = 0; ni < 8; ++ni) {
        bf16x8 bq = *(const bf16x8*)(sB + 0 * 4096 + (ni * 16 + fr) * 32 + rpk);
#pragma unroll
        for (int mi = 0; mi < 4; ++mi)
          acc[mi][ni] = __builtin_amdgcn_mfma_f32_16x16x32_bf16(af[mi], bq, acc[mi][ni], 0, 0, 0);
      }
      __builtin_amdgcn_s_setprio(0);
    }
    __syncthreads();
    {
      bf16x8 af[4];
      __builtin_amdgcn_s_setprio(1);
#pragma unroll
      for (int mi = 0; mi < 4; ++mi) af[mi] = *(const bf16x8*)(sA + 1 * 8192 + (wid * 64 + mi * 16 + fr) * 32 + rpk);
#pragma unroll
      for (int ni = 0; ni < 8; ++ni) {
        bf16x8 bq = *(const bf16x8*)(sB + 1 * 4096 + (ni * 16 + fr) * 32 + rpk);
#pragma unroll
        for (int mi = 0; mi < 4; ++mi)
          acc[mi][ni] = __builtin_amdgcn_mfma_f32_16x16x32_bf16(af[mi], bq, acc[mi][ni], 0, 0, 0);
      }
      __builtin_amdgcn_s_setprio(0);
    }
    if (kt + 2 < 32) {
    *(uint4*)(sA + 0 * 8192 + soff + 0) = a00;
    *(uint4*)(sA + 0 * 8192 + soff + 2048) = a01;
    *(uint4*)(sA + 0 * 8192 + soff + 4096) = a02;
    *(uint4*)(sA + 0 * 8192 + soff + 6144) = a03;
    *(uint4*)(sB + 0 * 4096 + soff + 0) = b00;
    *(uint4*)(sB + 0 * 4096 + soff + 2048) = b01;
    }
    __syncthreads();
  }
}
DI void mma_big3(f32x4 (&acc)[4][8], const u16* __restrict__ A, const u16* __restrict__ Bt, u16* smem) {
  const int tid = threadIdx.x, lane = tid & 63, wid = tid >> 6, fr = lane & 15, fq = lane >> 4;
  const int rpk = ((fq ^ ((0 - (fr >> 2)) & 3)) << 3);
  const int lrow = lane >> 2, lc = ((lane & 3) ^ ((0 - (lane >> 4)) & 3));
  const u16* ap = A + (long)(wid * 64 + lrow) * 1024 + lc * 8;
  const u16* bp = Bt + (long)(wid * 32 + lrow) * 1024 + lc * 8;
  char* lbase = (char*)smem;
  auto issue = [&](int kt, int buf) {
    char* la = lbase + buf * 24576 + wid * 4096;
    char* lb = lbase + buf * 24576 + 16384 + wid * 2048;
#pragma unroll
    for (int i = 0; i < 4; ++i)
      __builtin_amdgcn_global_load_lds((const unsigned*)(ap + (long)(16 * i) * 1024 + kt * 32), (unsigned __attribute__((address_space(3)))*)(la + i * 1024), 16, 0, 0);
#pragma unroll
    for (int i = 0; i < 2; ++i)
      __builtin_amdgcn_global_load_lds((const unsigned*)(bp + (long)(16 * i) * 1024 + kt * 32), (unsigned __attribute__((address_space(3)))*)(lb + i * 1024), 16, 0, 0);
  };
  __syncthreads();
  issue(0, 0);
  issue(1, 1);
  int cur = 0;
#pragma unroll 1
  for (int kt = 0; kt < 32; ++kt) {
    if (kt < 31) asm volatile("s_waitcnt vmcnt(6)" ::: "memory");
    else asm volatile("s_waitcnt vmcnt(0)" ::: "memory");
    asm volatile("s_waitcnt lgkmcnt(0)" ::: "memory");
    __builtin_amdgcn_s_barrier();
    if (kt + 2 < 32) {
      int nb = cur + 2;
      if (nb >= 3) nb -= 3;
      issue(kt + 2, nb);
    }
    const u16* sA = smem + cur * 12288;
    const u16* sB = sA + 8192;
    {
      bf16x8 af[4];
      __builtin_amdgcn_s_setprio(1);
#pragma unroll
      for (int mi = 0; mi < 4; ++mi) af[mi] = *(const bf16x8*)(sA + (wid * 64 + mi * 16 + fr) * 32 + rpk);
#pragma unroll
      for (int ni = 0; ni < 8; ++ni) {
        bf16x8 bq = *(const bf16x8*)(sB + (ni * 16 + fr) * 32 + rpk);
#pragma unroll
        for (int mi = 0; mi < 4; ++mi)
          acc[mi][ni] = __builtin_amdgcn_mfma_f32_16x16x32_bf16(af[mi], bq, acc[mi][ni], 0, 0, 0);
      }
      __builtin_amdgcn_s_setprio(0);
    }
    cur = cur + 1;
    if (cur == 3) cur = 0;
  }
  __syncthreads();
}

DI void zero_big(f32x4 (&acc)[4][8]) {
#pragma unroll
  for (int mi = 0; mi < 4; ++mi)
#pragma unroll
    for (int ni = 0; ni < 8; ++ni) acc[mi][ni] = f32x4{0.f, 0.f, 0.f, 0.f};
}
DI void big_to_lds(const f32x4 (&acc)[4][8], float* T, int h) {
  const int tid = threadIdx.x, lane = tid & 63, wid = tid >> 6, fr = lane & 15, fq = lane >> 4;
  if ((wid >> 1) != h) return;
#pragma unroll
  for (int mi = 0; mi < 4; ++mi)
#pragma unroll
    for (int ni = 0; ni < 8; ++ni)
#pragma unroll
      for (int j = 0; j < 4; ++j) T[((wid & 1) * 64 + mi * 16 + fq * 4 + j) * 132 + ni * 16 + fr] = acc[mi][ni][j];
}
DI void big_to_lds_T(const f32x4 (&acc)[4][8], float* T, int h) {
  const int tid = threadIdx.x, lane = tid & 63, wid = tid >> 6, fr = lane & 15, fq = lane >> 4;
  if ((wid >> 1) != h) return;
#pragma unroll
  for (int mi = 0; mi < 4; ++mi)
#pragma unroll
    for (int ni = 0; ni < 8; ++ni) *(f32x4*)(T + (ni * 16 + fr) * 132 + (wid & 1) * 64 + mi * 16 + fq * 4) = acc[mi][ni];
}
DI int tile_at_pad(int it, int MT, int NT, int& mt, int& nt) {
  const int G = gridDim.x >> 3, xcd = blockIdx.x & 7, lb = blockIdx.x >> 3;
  const int NT8 = NT >> 3, nst = ((MT + 7) >> 3) * NT8;
  const int f = it * G + lb;
  const int st = xcd + 8 * (f >> 6);
  if (st >= nst) return 0;
  const int w = f & 63;
  mt = (st / NT8) * 8 + (w >> 3);
  nt = (st % NT8) * 8 + (w & 7);
  return mt < MT ? 1 : 2;
}

DI void mma_glds128(f32x4 (&acc)[4][4], const u16* __restrict__ A, long lda, const u16* __restrict__ Bt, long ldb, int K, u16* smem) {
  const int tid = threadIdx.x, lane = tid & 63, wid = tid >> 6, wm = wid >> 1, wn = wid & 1, fr = lane & 15, fq = lane >> 4;
  u16* sA = smem;
  u16* sB = smem + 2 * 128 * 72;
  const int nk = K >> 6;
  typedef unsigned __attribute__((address_space(3))) lds_u32;
  auto issue = [&](int kt, int buf) {
#pragma unroll
    for (int i = 0; i < 4; ++i) {
      const int row = wid * 32 + i * 8 + (lane >> 3);
      const int lc = (lane & 7) ^ ((row >> 1) & 7);
      __builtin_amdgcn_global_load_lds((const unsigned*)(A + (long)row * lda + kt * 64 + lc * 8),
                                       (lds_u32*)(sA + buf * (128 * 64) + (wid * 32 + i * 8) * 64), 16, 0, 0);
      __builtin_amdgcn_global_load_lds((const unsigned*)(Bt + (long)row * ldb + kt * 64 + lc * 8),
                                       (lds_u32*)(sB + buf * (128 * 64) + (wid * 32 + i * 8) * 64), 16, 0, 0);
    }
  };
  __syncthreads();
  issue(0, 0);
  asm volatile("s_waitcnt vmcnt(0)" ::: "memory");
  __syncthreads();
  for (int kt = 0; kt < nk; ++kt) {
    const int cur = kt & 1;
    if (kt + 1 < nk) issue(kt + 1, cur ^ 1);
    __builtin_amdgcn_s_setprio(1);
#pragma unroll
    for (int ks = 0; ks < 2; ++ks) {
      bf16x8 af[4];
#pragma unroll
      for (int mi = 0; mi < 4; ++mi)
        af[mi] = *(const bf16x8*)(sA + cur * (128 * 64) + (wm * 64 + mi * 16 + fr) * 64 + (((ks * 4 + fq) ^ (fr >> 1)) << 3));
#pragma unroll
      for (int ni = 0; ni < 4; ++ni) {
        bf16x8 bq = *(const bf16x8*)(sB + cur * (128 * 64) + (wn * 64 + ni * 16 + fr) * 64 + (((ks * 4 + fq) ^ (fr >> 1)) << 3));
#pragma unroll
        for (int mi = 0; mi < 4; ++mi)
          acc[mi][ni] = __builtin_amdgcn_mfma_f32_16x16x32_bf16(af[mi], bq, acc[mi][ni], 0, 0, 0);
      }
    }
    __builtin_amdgcn_s_setprio(0);
    asm volatile("s_waitcnt vmcnt(0)" ::: "memory");
    __syncthreads();
  }
}

template <int NI>
DI void zero_acc(f32x4 (&acc)[4][NI]) {
#pragma unroll
  for (int mi = 0; mi < 4; ++mi)
#pragma unroll
    for (int ni = 0; ni < NI; ++ni) acc[mi][ni] = f32x4{0.f, 0.f, 0.f, 0.f};
}

DI void acc_to_lds(const f32x4 (&acc)[4][4], float* T) {
  const int tid = threadIdx.x, lane = tid & 63, wid = tid >> 6, wm = wid >> 1, wn = wid & 1, fr = lane & 15, fq = lane >> 4;
#pragma unroll
  for (int mi = 0; mi < 4; ++mi)
#pragma unroll
    for (int ni = 0; ni < 4; ++ni)
#pragma unroll
      for (int j = 0; j < 4; ++j) T[(wm * 64 + mi * 16 + fq * 4 + j) * 132 + wn * 64 + ni * 16 + fr] = acc[mi][ni][j];
}
DI void acc_to_lds_T(const f32x4 (&acc)[4][4], float* T) {
  const int tid = threadIdx.x, lane = tid & 63, wid = tid >> 6, wm = wid >> 1, wn = wid & 1, fr = lane & 15, fq = lane >> 4;
#pragma unroll
  for (int mi = 0; mi < 4; ++mi)
#pragma unroll
    for (int ni = 0; ni < 4; ++ni) *(f32x4*)(T + (wn * 64 + ni * 16 + fr) * 132 + wm * 64 + mi * 16 + fq * 4) = acc[mi][ni];
}
DI uint4 pack8(float4 a, float4 b) {
  uint4 o;
  o.x = pack2(a.x, a.y); o.y = pack2(a.z, a.w); o.z = pack2(b.x, b.y); o.w = pack2(b.z, b.w);
  return o;
}
DI void tile_store_bf16(const float* T, u16* dst, long ld) {
  const int tid = threadIdx.x;
#pragma unroll 1
  for (int i = 0; i < 8; ++i) {
    int idx = tid + i * 256;
    int r = idx >> 4, c0 = (idx & 15) * 8;
    float4 a = *(const float4*)(T + r * 132 + c0), b = *(const float4*)(T + r * 132 + c0 + 4);
    *(uint4*)(dst + (long)r * ld + c0) = pack8(a, b);
  }
}

template <int MODE>
DI void build_resident(u16* smem, const u16* __restrict__ A, long lda, const float* tab) {
  const int tid = threadIdx.x;
#pragma unroll 1
  for (int i = 0; i < 8; ++i) {
    int idx = tid + i * 256;
    int r = idx >> 4, c0 = (idx & 15) * 8;
    uint4 v = *(const uint4*)(A + (long)r * lda + c0);
    float s[8];
#pragma unroll
    for (int e = 0; e < 8; ++e) s[e] = MODE == 1 ? tab[r] : tab[c0 + e];
    uint4 o;
    o.x = pack2(lo2f(v.x) * s[0], hi2f(v.x) * s[1]);
    o.y = pack2(lo2f(v.y) * s[2], hi2f(v.y) * s[3]);
    o.z = pack2(lo2f(v.z) * s[4], hi2f(v.z) * s[5]);
    o.w = pack2(lo2f(v.w) * s[6], hi2f(v.w) * s[7]);
    *(uint4*)(smem + r * 144 + c0) = o;
  }
}

DI bool tile_at(int it, int MT, int NT, int& mt, int& nt) {
  const int G = gridDim.x >> 3, xcd = blockIdx.x & 7, lb = blockIdx.x >> 3;
  const int NT8 = NT >> 3, nst = (MT >> 3) * NT8;
  const int f = it * G + lb;
  const int st = xcd + 8 * (f >> 6);
  if (st >= nst) return false;
  const int w = f & 63;
  mt = (st / NT8) * 8 + (w >> 3);
  nt = (st % NT8) * 8 + (w & 7);
  return true;
}

DI void tr_items(const float* __restrict__ src, u16* __restrict__ dst, int K, int N, long nmat, long gtid,
                 long gstride) {
  const long per = (long)N * (K / 8);
  const long total = nmat * per;
  for (long i = gtid; i < total; i += gstride) {
    long mat = i / per;
    long r = i - mat * per;
    int k8 = (int)(r / N);
    int n = (int)(r - (long)k8 * N);
    const float* s = src + mat * (long)K * N + (long)k8 * 8 * N + n;
    uint4 o;
    o.x = pack2(s[0], s[(long)N]);
    o.y = pack2(s[2L * N], s[3L * N]);
    o.z = pack2(s[4L * N], s[5L * N]);
    o.w = pack2(s[6L * N], s[7L * N]);
    *(uint4*)(dst + mat * (long)K * N + (long)n * K + k8 * 8) = o;
  }
}
DI void cvt_items(const float* __restrict__ src, u16* __restrict__ dst, long n8, long gtid, long gstride) {
  for (long i = gtid; i < n8; i += gstride) {
    float4 a = *(const float4*)(src + i * 8);
    float4 b = *(const float4*)(src + i * 8 + 4);
    uint4 o;
    o.x = pack2(a.x, a.y);
    o.y = pack2(a.z, a.w);
    o.z = pack2(b.x, b.y);
    o.w = pack2(b.z, b.w);
    *(uint4*)(dst + i * 8) = o;
  }
}

DI void phase_prep(const Params& p, u16* smem) {
  const long gtid = (long)blockIdx.x * blockDim.x + threadIdx.x;
  const long gstride = (long)gridDim.x * blockDim.x;
  unsigned char* ws = p.ws;
  {
    float* mod = (float*)(ws + OFF_MOD);
    float* red = (float*)smem;
    const int tid = threadIdx.x;
    for (int it = blockIdx.x; it < 192; it += gridDim.x) {
      const int col = it * 32 + (tid & 31), ks = tid >> 5;
      float a0 = 0.f, a1 = 0.f, a2 = 0.f, a3 = 0.f, a4 = 0.f;
      for (int k = ks * 128; k < ks * 128 + 128; ++k) {
        float w = p.mod_w[(long)k * 6144 + col];
        a0 += siluf_(p.c[k]) * w;
        a1 += siluf_(p.c[1024 + k]) * w;
        a2 += siluf_(p.c[2048 + k]) * w;
        a3 += siluf_(p.c[3072 + k]) * w;
        a4 += siluf_(p.c_ctx[k]) * w;
      }
      __syncthreads();
      red[(ks * 5 + 0) * 32 + (tid & 31)] = a0;
      red[(ks * 5 + 1) * 32 + (tid & 31)] = a1;
      red[(ks * 5 + 2) * 32 + (tid & 31)] = a2;
      red[(ks * 5 + 3) * 32 + (tid & 31)] = a3;
      red[(ks * 5 + 4) * 32 + (tid & 31)] = a4;
      __syncthreads();
      if (tid < 160) {
        int r = tid >> 5, cc = tid & 31;
        float sum = p.mod_b[it * 32 + cc];
        for (int q = 0; q < 8; ++q) sum += red[(q * 5 + r) * 32 + cc];
        mod[r * 6144 + it * 32 + cc] = sum;
      }
    }
  }
  tr_items(p.w_in, (u16*)(ws + OFF_WTIN), 1024, INC, 1, gtid, gstride);
  tr_items(p.w_ret_out, (u16*)(ws + OFF_WTRO), 1024, 1024, 1, gtid, gstride);
  tr_items(p.w_lru_out, (u16*)(ws + OFF_WTLO), 1024, 1024, 1, gtid, gstride);
  tr_items(p.w_out, (u16*)(ws + OFF_WTO), 1024, 1024, 1, gtid, gstride);
  tr_items(p.peer_wq, (u16*)(ws + OFF_WTQ), 1024, 1024, 1, gtid, gstride);
  for (int d = 0; d < 2; ++d) {
    tr_items(p.lru_wa + (long)d * 8 * 16384, (u16*)(ws + OFF_WAT) + (long)(d * 2 + 0) * 8 * 16384, 128, 128, 8, gtid, gstride);
    tr_items(p.lru_wx + (long)d * 8 * 16384, (u16*)(ws + OFF_WAT) + (long)(d * 2 + 1) * 8 * 16384, 128, 128, 8, gtid, gstride);
  }
  cvt_items(p.peer_keys, (u16*)(ws + OFF_KEYS), 8L * 2 * 128 * 64 / 8, gtid, gstride);
  {
    const int lane = threadIdx.x & 63;
    const long gw = gtid >> 6, nw = gstride >> 6;
    for (long rr = gw; rr < 2L * 16384; rr += nw) {
      const int tb = (int)(rr >> 14);
      const long row = rr & 16383;
      const float* src = (tb ? p.peer_v : p.peer_u) + row * 1024 + lane * 16;
      float4 v0 = *(const float4*)(src), v1 = *(const float4*)(src + 4), v2 = *(const float4*)(src + 8), v3 = *(const float4*)(src + 12);
      float m = fmaxf(fmaxf(fmaxf(fabsf(v0.x), fabsf(v0.y)), fmaxf(fabsf(v0.z), fabsf(v0.w))),
                      fmaxf(fmaxf(fabsf(v1.x), fabsf(v1.y)), fmaxf(fabsf(v1.z), fabsf(v1.w))));
      m = fmaxf(m, fmaxf(fmaxf(fmaxf(fabsf(v2.x), fabsf(v2.y)), fmaxf(fabsf(v2.z), fabsf(v2.w))),
                         fmaxf(fmaxf(fabsf(v3.x), fabsf(v3.y)), fmaxf(fabsf(v3.z), fabsf(v3.w)))));
#pragma unroll
      for (int o = 32; o > 0; o >>= 1) m = fmaxf(m, __shfl_xor(m, o));
      m = fmaxf(m, 1e-30f);
      const float inv = 127.f / m;
      const int qoff = tb ? 128 : 0;
#define Q8(x) ((unsigned)((int)rintf((x) * inv) + qoff) & 0xffu)
      uint4 o;
      o.x = Q8(v0.x) | (Q8(v0.y) << 8) | (Q8(v0.z) << 16) | (Q8(v0.w) << 24);
      o.y = Q8(v1.x) | (Q8(v1.y) << 8) | (Q8(v1.z) << 16) | (Q8(v1.w) << 24);
      o.z = Q8(v2.x) | (Q8(v2.y) << 8) | (Q8(v2.z) << 16) | (Q8(v2.w) << 24);
      o.w = Q8(v3.x) | (Q8(v3.y) << 8) | (Q8(v3.z) << 16) | (Q8(v3.w) << 24);
#undef Q8
      *(uint4*)(ws + (tb ? OFF_VTAB : OFF_UT) + row * 1024 + lane * 16) = o;
      if (lane == 0) ((float*)(ws + (tb ? OFF_VSC : OFF_USC)))[row] = m * (1.f / 127.f);
    }
  }
}

DI void norm_row(const float* __restrict__ src, const float* __restrict__ g, const float* __restrict__ shift,
                 const float* __restrict__ scale, u16* __restrict__ dst, int lane) {
  float4 v[4];
  float ss = 0.f;
#pragma unroll
  for (int i = 0; i < 4; ++i) {
    v[i] = *(const float4*)(src + (i * 64 + lane) * 4);
    ss += v[i].x * v[i].x + v[i].y * v[i].y + v[i].z * v[i].z + v[i].w * v[i].w;
  }
  ss = wave_sum(ss);
  float rstd = rsqrtf(ss * (1.f / 1024.f) + EPSV);
#pragma unroll
  for (int i = 0; i < 4; ++i) {
    int c = (i * 64 + lane) * 4;
    float4 gg = *(const float4*)(g + c);
    float4 sh = *(const float4*)(shift + c);
    float4 sc = *(const float4*)(scale + c);
    float y0 = v[i].x * rstd * gg.x * (1.f + sc.x) + sh.x;
    float y1 = v[i].y * rstd * gg.y * (1.f + sc.y) + sh.y;
    float y2 = v[i].z * rstd * gg.z * (1.f + sc.z) + sh.z;
    float y3 = v[i].w * rstd * gg.w * (1.f + sc.w) + sh.w;
    uint2 o;
    o.x = pack2(y0, y1);
    o.y = pack2(y2, y3);
    *(uint2*)(dst + c) = o;
  }
}

DI void phase_norm1(const Params& p) {
  const int lane = threadIdx.x & 63;
  const long gw = ((long)blockIdx.x * blockDim.x + threadIdx.x) >> 6;
  const long nw = ((long)gridDim.x * blockDim.x) >> 6;
  const float* mod = (const float*)(p.ws + OFF_MOD);
  u16* hx = (u16*)(p.ws + OFF_HX);
  for (long r = gw; r < NROW; r += nw) {
    const float* src;
    int mr;
    if (r < NTOK) { src = p.x + r * 1024; mr = (int)(r / LS); }
    else { src = p.ctx + (r - NTOK) * 1024; mr = 4; }
    norm_row(src, p.norm1_g, mod + mr * 6144, mod + mr * 6144 + 1024, hx + r * 1024, lane);
  }
}
DI void phase_norm2(const Params& p) {
  const int lane = threadIdx.x & 63;
  const long gw = ((long)blockIdx.x * blockDim.x + threadIdx.x) >> 6;
  const long nw = ((long)gridDim.x * blockDim.x) >> 6;
  const float* mod = (const float*)(p.ws + OFF_MOD);
  u16* hx2 = (u16*)(p.ws + OFF_O);
  for (long r = gw; r < NTOK; r += nw) {
    int mr = (int)(r / LS);
    norm_row(p.out + r * 1024, p.norm2_g, mod + mr * 6144 + 3072, mod + mr * 6144 + 4096, hx2 + r * 1024, lane);
  }
}

DI void phase_gemm_a(const Params& p, u16* smem) {
  const int tid = threadIdx.x, lane = tid & 63, wid = tid >> 6, wm = wid >> 1, wn = wid & 1, fr = lane & 15, fq = lane >> 4;
  const u16* hx = (const u16*)(p.ws + OFF_HX);
  const u16* wt = (const u16*)(p.ws + OFF_WTIN);
  u16* Q = (u16*)(p.ws + OFF_Q);
  u16* Kb = (u16*)(p.ws + OFF_K);
  u16* KT = (u16*)(p.ws + OFF_KT);
  u16* VT = (u16*)(p.ws + OFF_VT);
  u16* P4 = (u16*)(p.ws + OFF_P4);
  int mt, nt;
  for (int it = 0; tile_at(it, NCHUNK, 24, mt, nt); ++it) {
    const int wrow0 = nt < 16 ? nt * 128 : 3072 + (nt - 16) * 128;
    const bool latent = mt < 256;
    if (!latent && nt < 4) continue;
    f32x4 acc[4][4];
    zero_acc(acc);
    mma_glds128(acc, hx + (long)mt * 128 * 1024, 1024, wt + (long)wrow0 * 1024, 1024, 1024, smem);
    const int b = latent ? mt / 64 : (mt - 256) / 2;
    const int tseq0 = latent ? (mt % 64) * 128 : ((mt - 256) % 2) * 128;
    const long row0 = (long)mt * 128;
    const int Lseq = latent ? LS : LCX;
    float* T = (float*)smem;
    if (nt < 8) {
      if (latent) {
#pragma unroll
        for (int mi = 0; mi < 4; ++mi)
#pragma unroll
          for (int j = 0; j < 4; ++j) {
            int tok = tseq0 + wm * 64 + mi * 16 + fq * 4 + j;
            float pos = (float)(wn == 0 ? (tok >> 6) : (tok & 63));
#pragma unroll
            for (int n2 = 0; n2 < 2; ++n2) {
              float f = (float)(n2 * 16 + fr);
              float inv = exp2f(-f * (13.287712379549449f / 32.f));
              float ang = pos * inv;
              float cs = __cosf(ang), sn = __sinf(ang);
              float u1 = acc[mi][n2][j], u2 = acc[mi][n2 + 2][j];
              acc[mi][n2][j] = u1 * cs - u2 * sn;
              acc[mi][n2 + 2][j] = u2 * cs + u1 * sn;
            }
          }
      }
      if (nt < 4) {
        acc_to_lds(acc, T);
        __syncthreads();
        tile_store_bf16(T, Q + row0 * 512 + nt * 128, 512);
      } else {
        const int h = nt - 4;
#pragma unroll
        for (int mi = 0; mi < 4; ++mi)
#pragma unroll
          for (int ni = 0; ni < 4; ++ni) acc[mi][ni] *= 0.08838834764831845f;
        acc_to_lds(acc, T);
        __syncthreads();
        tile_store_bf16(T, Kb + row0 * 512 + h * 128, 512);
        __syncthreads();
        acc_to_lds_T(acc, T);
        __syncthreads();
        u16* ktb = latent ? KT : KT + (size_t)4 * 512 * LS;
        tile_store_bf16(T, ktb + ((long)(b * 512 + h * 128)) * Lseq + tseq0, Lseq);
      }
    } else if (nt < 16) {
      acc_to_lds_T(acc, T);
      __syncthreads();
      u16* vtb = latent ? VT : VT + (size_t)4 * 1024 * LS;
      tile_store_bf16(T, vtb + ((long)(b * 1024 + (nt - 8) * 128)) * Lseq + tseq0, Lseq);
    } else {
      acc_to_lds(acc, T);
      __syncthreads();
      tile_store_bf16(T, P4 + row0 * 1024 + (nt - 16) * 128, 1024);
    }
  }
}

DI float log_gamma_of(const Params& p, int dir, int h) {
  float x = p.ret_decay[dir * 4 + h];
  return -softplusf_(-x);
}

DI void kv_item(const Params& p, int item, u16* smem, float* tabs) {
  const int tid = threadIdx.x;
  const int dvh = item & 1, cc = (item >> 1) % 66, bh = (item >> 1) / 66, h = bh & 3, b = bh >> 2;
  const float lgf = log_gamma_of(p, 0, h), lgb = log_gamma_of(p, 1, h);
  __syncthreads();
  if (tid < 128) {
    tabs[tid] = __expf(lgf * (float)(127 - tid));
    tabs[128 + tid] = __expf(lgb * (float)tid);
  }
  __syncthreads();
  const u16* KT = (const u16*)(p.ws + OFF_KT);
  const u16* VT = (const u16*)(p.ws + OFF_VT);
  const u16 *asrc, *bsrc;
  long ld;
  if (cc < 2) {
    asrc = VT + (size_t)4 * 1024 * LS + ((long)(b * 1024 + h * 256 + dvh * 128)) * LCX + cc * 128;
    bsrc = KT + (size_t)4 * 512 * LS + ((long)(b * 512 + h * 128)) * LCX + cc * 128;
    ld = LCX;
  } else {
    asrc = VT + ((long)(b * 1024 + h * 256 + dvh * 128)) * LS + (cc - 2) * 128;
    bsrc = KT + ((long)(b * 512 + h * 128)) * LS + (cc - 2) * 128;
    ld = LS;
  }
#pragma unroll 1
  for (int dir = 0; dir < 2; ++dir) {
    __syncthreads();
    build_resident<2>(smem, asrc, ld, tabs + dir * 128);
    f32x4 acc[4][4];
    zero_acc(acc);
    mma_loop<true>(acc, nullptr, 0, bsrc, ld, 128, smem, Ident{});
    const int bhd = (b * 4 + h) * 2 + dir;
    u16* dst = cc < 2 ? (u16*)(p.ws + OFF_KVC) + ((long)(bhd * 2 + cc)) * 32768 + dvh * 128 * 128
                      : (u16*)p.out + ((long)bhd * 64 + (cc - 2)) * 32768 + dvh * 128 * 128;
    acc_to_lds(acc, (float*)smem);
    __syncthreads();
    tile_store_bf16((const float*)smem, dst, 128);
  }
}

DI void state_scan(const Params& p) {
  const long gtid = (long)blockIdx.x * blockDim.x + threadIdx.x;
  const long gstride = (long)gridDim.x * blockDim.x;
  for (long idx = gtid; idx < 32L * 4096; idx += gstride) {
    const int e8 = (int)(idx & 4095), bhd = (int)(idx >> 12);
    const int dir = bhd & 1, h = (bhd >> 1) & 3;
    const float cd = __expf(log_gamma_of(p, dir, h) * 128.f);
    float acc[8];
#pragma unroll
    for (int e = 0; e < 8; ++e) acc[e] = 0.f;
    const u16* kvc = (const u16*)(p.ws + OFF_KVC) + (long)bhd * 2 * 32768 + e8 * 8;
#pragma unroll
    for (int s = 0; s < 2; ++s) {
      int cc = dir == 0 ? s : 1 - s;
      uint4 kv = *(const uint4*)(kvc + (long)cc * 32768);
      acc[0] = cd * acc[0] + lo2f(kv.x); acc[1] = cd * acc[1] + hi2f(kv.x);
      acc[2] = cd * acc[2] + lo2f(kv.y); acc[3] = cd * acc[3] + hi2f(kv.y);
      acc[4] = cd * acc[4] + lo2f(kv.z); acc[5] = cd * acc[5] + hi2f(kv.z);
      acc[6] = cd * acc[6] + lo2f(kv.w); acc[7] = cd * acc[7] + hi2f(kv.w);
    }
    u16* base = (u16*)p.out + (long)bhd * 64 * 32768 + e8 * 8;
    const long cstep = dir == 0 ? 32768 : -32768;
    u16* cur = base + (long)(dir == 0 ? 0 : 63) * 32768;
    uint4 k0 = *(const uint4*)(cur), k1 = *(const uint4*)(cur + cstep), k2 = *(const uint4*)(cur + 2 * cstep), k3 = *(const uint4*)(cur + 3 * cstep);
#define SCAN_STEP(KV, s)                                                                       \
    {                                                                                          \
      uint4 kv = KV;                                                                           \
      if ((s) + 4 < 64) KV = *(const uint4*)(cur + 4 * cstep);                                 \
      uint4 o;                                                                                 \
      o.x = pack2(acc[0], acc[1]); o.y = pack2(acc[2], acc[3]); o.z = pack2(acc[4], acc[5]); o.w = pack2(acc[6], acc[7]); \
      *(uint4*)(cur) = o;                                                                      \
      acc[0] = cd * acc[0] + lo2f(kv.x); acc[1] = cd * acc[1] + hi2f(kv.x);                    \
      acc[2] = cd * acc[2] + lo2f(kv.y); acc[3] = cd * acc[3] + hi2f(kv.y);                    \
      acc[4] = cd * acc[4] + lo2f(kv.z); acc[5] = cd * acc[5] + hi2f(kv.z);                    \
      acc[6] = cd * acc[6] + lo2f(kv.w); acc[7] = cd * acc[7] + hi2f(kv.w);                    \
      cur += cstep;                                                                            \
    }
#pragma unroll 1
    for (int s = 0; s < 64; s += 4) {
      SCAN_STEP(k0, s)
      SCAN_STEP(k1, s + 1)
      SCAN_STEP(k2, s + 2)
      SCAN_STEP(k3, s + 3)
    }
#undef SCAN_STEP
  }
}

DI float one_minus_exp(float x) {
  float ser = -x * (1.f + x * (0.5f + x * (0.16666667f + x * (0.041666668f + x * 0.008333334f))));
  return x > -0.25f ? ser : 1.f - __expf(x);
}

DI void lru_tile(const Params& p, int cid, int blk, int nh, int mode, u16* smem) {
  const int tid = threadIdx.x, lane = tid & 63, wid = tid >> 6, wm = wid >> 1, wn = wid & 1, fr = lane & 15, fq = lane >> 4;
  const u16* P4 = (const u16*)(p.ws + OFF_P4);
  const u16* WAT = (const u16*)(p.ws + OFF_WAT);
  float* LA = (float*)(p.ws + OFF_LA);
  float* LB = (float*)(p.ws + OFF_LB);
  const float* LH = (const float*)(p.ws + OFF_LH);
  u16* Y = (u16*)(p.ws + OFF_Y);
  const long r0 = (long)cid * 128;
  long seq_lo, seq_hi;
  if (cid < 256) { seq_lo = (long)(cid / 64) * LS; seq_hi = seq_lo + LS; }
  else { seq_lo = NTOK + (long)((cid - 256) / 2) * LCX; seq_hi = seq_lo + LCX; }
  __syncthreads();
  {
    const int cv = (tid & 15) * 8;
    const int chc = blk * 128 + cv;
    float cw[4][8], cb8[8];
    {
      float4 b0 = *(const float4*)(p.conv_b + chc), b1 = *(const float4*)(p.conv_b + chc + 4);
      cb8[0] = b0.x; cb8[1] = b0.y; cb8[2] = b0.z; cb8[3] = b0.w; cb8[4] = b1.x; cb8[5] = b1.y; cb8[6] = b1.z; cb8[7] = b1.w;
#pragma unroll
      for (int tap = 0; tap < 4; ++tap) {
        float4 w0 = *(const float4*)(p.conv_w + tap * 1024 + chc), w1 = *(const float4*)(p.conv_w + tap * 1024 + chc + 4);
        cw[tap][0] = w0.x; cw[tap][1] = w0.y; cw[tap][2] = w0.z; cw[tap][3] = w0.w;
        cw[tap][4] = w1.x; cw[tap][5] = w1.y; cw[tap][6] = w1.z; cw[tap][7] = w1.w;
      }
    }
#pragma unroll 4
    for (int i = 0; i < 8; ++i) {
      const int row = (tid >> 4) + i * 16;
      uint4 v[4];
#pragma unroll
      for (int tap = 0; tap < 4; ++tap) {
        long rr = r0 + row + tap - 2;
        v[tap] = (rr >= seq_lo && rr < seq_hi) ? *(const uint4*)(P4 + rr * 1024 + chc) : make_uint4(0u, 0u, 0u, 0u);
      }
      float u[8];
#pragma unroll
      for (int e = 0; e < 8; ++e) u[e] = cb8[e];
#pragma unroll
      for (int tap = 0; tap < 4; ++tap) {
        u[0] += lo2f(v[tap].x) * cw[tap][0]; u[1] += hi2f(v[tap].x) * cw[tap][1];
        u[2] += lo2f(v[tap].y) * cw[tap][2]; u[3] += hi2f(v[tap].y) * cw[tap][3];
        u[4] += lo2f(v[tap].z) * cw[tap][4]; u[5] += hi2f(v[tap].z) * cw[tap][5];
        u[6] += lo2f(v[tap].w) * cw[tap][6]; u[7] += hi2f(v[tap].w) * cw[tap][7];
      }
      uint4 o;
      o.x = pack2(u[0], u[1]); o.y = pack2(u[2], u[3]); o.z = pack2(u[4], u[5]); o.w = pack2(u[6], u[7]);
      *(uint4*)(smem + row * 144 + cv) = o;
    }
  }
  u16* sW = smem + 128 * 144;
  float* abuf = (float*)(smem + 128 * 144);
  float* bbuf = abuf + 64 * 65;
  float* sg = bbuf + 64 * 65;
  const int ch = tid & 63, sgi = tid >> 6;
  const long chg = (long)blk * 128 + nh * 64 + ch;
#pragma unroll 1
  for (int dir = 0; dir < 2; ++dir) {
    f32x4 acc[2][4][2];
    __syncthreads();
#pragma unroll 1
    for (int i0 = 0; i0 < 8; i0 += 4) {
      uint4 v[4];
#pragma unroll
      for (int i = 0; i < 4; ++i) {
        int c = tid + (i0 + i) * 256;
        int g = c >> 10, cc = c & 1023, row = cc >> 4, kc = (cc & 15) * 8;
        v[i] = *(const uint4*)(WAT + (long)((dir * 2 + g) * 8 + blk) * 16384 + (nh * 64 + row) * 128 + kc);
      }
#pragma unroll
      for (int i = 0; i < 4; ++i) {
        int c = tid + (i0 + i) * 256;
        int g = c >> 10, cc = c & 1023, row = cc >> 4, kc = (cc & 15) * 8;
        *(uint4*)(sW + g * (64 * 144) + row * 144 + kc) = v[i];
      }
    }
    __syncthreads();
#pragma unroll
    for (int g = 0; g < 2; ++g) {
      zero_acc(acc[g]);
#pragma unroll
      for (int ks = 0; ks < 4; ++ks) {
        bf16x8 af[4];
#pragma unroll
        for (int mi = 0; mi < 4; ++mi) af[mi] = *(const bf16x8*)(smem + (wm * 64 + mi * 16 + fr) * 144 + ks * 32 + fq * 8);
#pragma unroll
        for (int ni = 0; ni < 2; ++ni) {
          bf16x8 bq = *(const bf16x8*)(sW + g * (64 * 144) + (wn * 32 + ni * 16 + fr) * 144 + ks * 32 + fq * 8);
#pragma unroll
          for (int mi = 0; mi < 4; ++mi)
            acc[g][mi][ni] = __builtin_amdgcn_mfma_f32_16x16x32_bf16(af[mi], bq, acc[g][mi][ni], 0, 0, 0);
        }
      }
    }
#pragma unroll
    for (int ni = 0; ni < 2; ++ni) {
      int cl = wn * 32 + ni * 16 + fr;
      int chn = blk * 128 + nh * 64 + cl;
      float ba = p.lru_ba[dir * 1024 + chn], bx = p.lru_bx[dir * 1024 + chn];
      float spl = softplusf_(-p.lru_lambda[dir * 1024 + chn]);
#pragma unroll
      for (int mi = 0; mi < 4; ++mi)
#pragma unroll
        for (int j = 0; j < 4; ++j) {
          int r = wm * 64 + mi * 16 + fq * 4 + j;
          float rg = sigmoidf_(acc[0][mi][ni][j] + ba);
          float ig = sigmoidf_(acc[1][mi][ni][j] + bx);
          float la = -8.f * rg * spl;
          float a = __expf(la);
          float uu = bf2f(smem[r * 144 + nh * 64 + cl]);
          float x2 = 2.f * la;
          float ser = -x2 * (1.f + x2 * (0.5f + x2 * (0.16666667f + x2 * (0.041666668f + x2 * 0.008333334f))));
          float bt = __builtin_amdgcn_sqrtf(x2 > -0.25f ? ser : 1.f - a * a) * (ig * uu);
          acc[0][mi][ni][j] = a;
          acc[1][mi][ni][j] = bt;
        }
    }
    float cP = 1.f, cQ = 0.f;
    if (mode == 1) cQ = LH[((long)dir * NCHUNK + cid) * 1024 + chg];
#pragma unroll
    for (int half = 0; half < 2; ++half) {
      const int hw = dir == 0 ? half : 1 - half;
      __syncthreads();
      if (wm == hw) {
#pragma unroll
        for (int mi = 0; mi < 4; ++mi)
#pragma unroll
          for (int ni = 0; ni < 2; ++ni)
#pragma unroll
            for (int j = 0; j < 4; ++j) {
              int lr = mi * 16 + fq * 4 + j, cl = wn * 32 + ni * 16 + fr;
              abuf[lr * 65 + cl] = acc[0][mi][ni][j];
              bbuf[lr * 65 + cl] = acc[1][mi][ni][j];
            }
      }
      __syncthreads();
      {
        float P = 1.f, Q = 0.f;
#pragma unroll
        for (int s = 0; s < 16; ++s) {
          int pos = sgi * 16 + s;
          int lr = dir == 0 ? pos : 63 - pos;
          float a = abuf[lr * 65 + ch], bb = bbuf[lr * 65 + ch];
          P *= a;
          Q = a * Q + bb;
        }
        sg[(sgi * 64 + ch) * 2] = P;
        sg[(sgi * 64 + ch) * 2 + 1] = Q;
      }
      __syncthreads();
      if (mode == 0) {
#pragma unroll
        for (int k = 0; k < 4; ++k) {
          float pk = sg[(k * 64 + ch) * 2], qk = sg[(k * 64 + ch) * 2 + 1];
          cQ = pk * cQ + qk;
          cP *= pk;
        }
      } else {
        float h = cQ;
#pragma unroll
        for (int k = 0; k < 4; ++k) {
          float pk = sg[(k * 64 + ch) * 2], qk = sg[(k * 64 + ch) * 2 + 1];
          if (k < sgi) h = pk * h + qk;
          cQ = pk * cQ + qk;
        }
#pragma unroll
        for (int s = 0; s < 16; ++s) {
          int pos = sgi * 16 + s;
          int lr = dir == 0 ? pos : 63 - pos;
          float a = abuf[lr * 65 + ch], bb = bbuf[lr * 65 + ch];
          h = a * h + bb;
          bbuf[lr * 65 + ch] = h;
        }
        __syncthreads();
#pragma unroll 1
        for (int i = 0; i < 2; ++i) {
          int idx = tid + i * 256;
          int row = idx >> 3, c8 = (idx & 7) * 8;
          const float* hp = bbuf + row * 65 + c8;
          float4 h0 = make_float4(hp[0], hp[1], hp[2], hp[3]), h1 = make_float4(hp[4], hp[5], hp[6], hp[7]);
          u16* yp = Y + (r0 + hw * 64 + row) * 1024 + blk * 128 + nh * 64 + c8;
          if (dir == 1) {
            uint4 y = *(const uint4*)yp;
            h0.x += lo2f(y.x); h0.y += hi2f(y.x); h0.z += lo2f(y.y); h0.w += hi2f(y.y);
            h1.x += lo2f(y.z); h1.y += hi2f(y.z); h1.z += lo2f(y.w); h1.w += hi2f(y.w);
          }
          *(uint4*)yp = pack8(h0, h1);
        }
      }
    }
    if (mode == 0 && sgi == 0) {
      LA[((long)dir * NCHUNK + cid) * 1024 + chg] = cP;
      LB[((long)dir * NCHUNK + cid) * 1024 + chg] = cQ;
    }
  }
}

DI void phase3(const Params& p, u16* smem, float* tabs) {
#ifndef REP_SUB
#define REP_SUB 0
#endif
  for (int rep = 0; rep <= (REP_SUB & 1); ++rep)
    for (int t = blockIdx.x; t < 2112; t += gridDim.x) kv_item(p, t, smem, tabs);
  for (int rep = 0; rep <= ((REP_SUB >> 1) & 1); ++rep)
    for (int u = blockIdx.x; u < NCHUNK * 16; u += gridDim.x) lru_tile(p, u >> 4, (u >> 1) & 7, u & 1, 0, smem);
}

DI void lru_cross(const Params& p) {
  const long gtid = (long)blockIdx.x * blockDim.x + threadIdx.x;
  if (gtid >= 8192) return;
  const int ch = (int)(gtid & 1023), b = (int)((gtid >> 10) & 3), dir = (int)(gtid >> 12);
  const float* LA = (const float*)(p.ws + OFF_LA) + (long)dir * NCHUNK * 1024;
  const float* LB = (const float*)(p.ws + OFF_LB) + (long)dir * NCHUNK * 1024;
  float* LH = (float*)(p.ws + OFF_LH) + (long)dir * NCHUNK * 1024;
  float h = 0.f;
  for (int s = 0; s < 2; ++s) {
    int cid = 256 + b * 2 + (dir == 0 ? s : 1 - s);
    h = LA[(long)cid * 1024 + ch] * h + LB[(long)cid * 1024 + ch];
  }
  for (int s = 0; s < 64; ++s) {
    int cid = b * 64 + (dir == 0 ? s : 63 - s);
    LH[(long)cid * 1024 + ch] = h;
    h = LA[(long)cid * 1024 + ch] * h + LB[(long)cid * 1024 + ch];
  }
}

DI void ret_out_item(const Params& p, int item, u16* smem, float* tabs) {
  const int tid = threadIdx.x, lane = tid & 63, wid = tid >> 6, wm = wid >> 1, wn = wid & 1, fr = lane & 15, fq = lane >> 4;
  const int half = item & 1, c = (item >> 1) & 63, h = (item >> 7) & 3, b = item >> 9;
  const float lgf = log_gamma_of(p, 0, h), lgb = log_gamma_of(p, 1, h);
  __syncthreads();
  for (int i = tid; i < 129; i += 256) {
    tabs[i] = __expf(lgf * (float)i);
    tabs[129 + i] = __expf(lgb * (float)i);
  }
  if (tid < 128) {
    tabs[258 + tid] = __expf(lgf * (float)(tid + 1));
    tabs[386 + tid] = __expf(lgb * (float)(128 - tid));
  }
  __syncthreads();
  const u16* Q = (const u16*)(p.ws + OFF_Q);
  const u16* Kb = (const u16*)(p.ws + OFF_K);
  const u16* VT = (const u16*)(p.ws + OFF_VT);
  const u16* ST = (const u16*)p.out;
  u16* O = (u16*)(p.ws + OFF_O);
  float* STATS = (float*)(p.ws + OFF_STATS);
  const long row0 = ((long)b * 64 + c) * 128;
  f32x4 ao[4][4];
  zero_acc(ao);
  mma_loop<false>(ao, Q + row0 * 512 + h * 128, 512, Kb + row0 * 512 + h * 128, 512, 128, smem, Ident{});
  const float ddbase = (float)(wm * 64 - wn * 64 + fq * 4 - fr);
#pragma unroll
  for (int mi = 0; mi < 4; ++mi)
#pragma unroll
    for (int ni = 0; ni < 4; ++ni)
#pragma unroll
      for (int j = 0; j < 4; ++j) {
        int i = wm * 64 + mi * 16 + fq * 4 + j, jj = wn * 64 + ni * 16 + fr;
        float dd = ddbase + (float)((mi - ni) * 16 + j);
        float d = __expf(dd >= 0.f ? lgf * dd : -lgb * dd);
        smem[i * 144 + jj] = f2bf(ao[mi][ni][j] * d);
      }
  zero_acc(ao);
#pragma unroll 1
  for (int seg = 0; seg < 3; ++seg) {
    const u16* Bt;
    long ldb;
    if (seg == 0) {
      Bt = VT + ((long)(b * 1024 + h * 256 + half * 128)) * LS + c * 128;
      ldb = LS;
    } else {
      const int dir = seg - 1;
      build_resident<1>(smem, Q + row0 * 512 + h * 128, 512, tabs + 258 + dir * 128);
      Bt = ST + ((((long)(b * 4 + h) * 2 + dir) * 64 + c) * 256 + half * 128) * 128;
      ldb = 128;
    }
    mma_loop<true>(ao, nullptr, 0, Bt, ldb, 128, smem, Ident{});
  }
  float* T = (float*)smem;
  acc_to_lds(ao, T);
  __syncthreads();
#pragma unroll 1
  for (int i = 0; i < 8; ++i) {
    int idx = tid + i * 256;
    int r = idx >> 4, c0 = (idx & 15) * 8;
    float4 a = *(const float4*)(T + r * 132 + c0), bq = *(const float4*)(T + r * 132 + c0 + 4);
    uint4 o = pack8(a, bq);
    *(uint4*)(O + (row0 + r) * 1024 + h * 256 + half * 128 + c0) = o;
    float v0 = lo2f(o.x), v1 = hi2f(o.x), v2 = lo2f(o.y), v3 = hi2f(o.y), v4 = lo2f(o.z), v5 = hi2f(o.z), v6 = lo2f(o.w), v7 = hi2f(o.w);
    float s1 = v0 + v1 + v2 + v3 + v4 + v5 + v6 + v7;
    float s2 = v0 * v0 + v1 * v1 + v2 * v2 + v3 * v3 + v4 * v4 + v5 * v5 + v6 * v6 + v7 * v7;
#pragma unroll
    for (int o2 = 1; o2 < 16; o2 <<= 1) {
      s1 += __shfl_xor(s1, o2);
      s2 += __shfl_xor(s2, o2);
    }
    if ((idx & 15) == 0) {
      float* st = STATS + ((row0 + r) * 4 + h) * 4 + half * 2;
      st[0] = s1;
      st[1] = s2;
    }
  }
}

DI void phase4(const Params& p) {
  lru_cross(p);
  state_scan(p);
}

DI void phase5(const Params& p, u16* smem, float* tabs) {
  for (int rep = 0; rep <= ((REP_SUB >> 2) & 1); ++rep)
    for (int t = blockIdx.x; t < 2048; t += gridDim.x) ret_out_item(p, t, smem, tabs);
  for (int rep = 0; rep <= ((REP_SUB >> 3) & 1); ++rep)
    for (int u = blockIdx.x; u < 256 * 16; u += gridDim.x) lru_tile(p, u >> 4, (u >> 1) & 7, u & 1, 1, smem);
}

DI void phase_gemm_b(const Params& p, u16* smem) {
  const int tid = threadIdx.x, lane = tid & 63, wid = tid >> 6, wm = wid >> 1, wn = wid & 1, fr = lane & 15, fq = lane >> 4;
  const u16* hx = (const u16*)(p.ws + OFF_HX);
  const u16* wt = (const u16*)(p.ws + OFF_WTIN);
  u16* O = (u16*)(p.ws + OFF_O);
  u16* Y = (u16*)(p.ws + OFF_Y);
  u16* S6 = (u16*)(p.ws + OFF_VT);
  u16* S7 = (u16*)(p.ws + OFF_P4);
  int mt2, nt;
  for (int it = 0; tile_at(it, 128, 32, mt2, nt); ++it) {
    const int seg = nt >> 3;
    const int wrow0 = (seg == 0 ? 2048 : 4096 + (seg - 1) * 1024) + (nt & 7) * 128;
    f32x4 acc[4][8];
    zero_big(acc);
    mma_big3(acc, hx + (long)mt2 * 256 * 1024, wt + (long)wrow0 * 1024, smem);
    u16* dst = seg == 0 ? O : (seg == 1 ? Y : (seg == 2 ? S6 : S7));
    const float* STATS = (const float*)(p.ws + OFF_STATS);
    float* T = (float*)smem;
#pragma unroll 1
   for (int h = 0; h < 2; ++h) {
    const long row0 = (long)(mt2 * 2 + h) * 128;
    __syncthreads();
    big_to_lds(acc, T, h);
    __syncthreads();
#pragma unroll 1
    for (int i = 0; i < 8; ++i) {
      int idx = tid + i * 256;
      int r = idx >> 4, c0 = (idx & 15) * 8;
      float v[8];
      {
        float4 a = *(const float4*)(T + r * 132 + c0), bq = *(const float4*)(T + r * 132 + c0 + 4);
        v[0] = a.x; v[1] = a.y; v[2] = a.z; v[3] = a.w; v[4] = bq.x; v[5] = bq.y; v[6] = bq.z; v[7] = bq.w;
      }
      long ad = (row0 + r) * 1024 + (nt & 7) * 128 + c0;
      float o[8];
      if (seg >= 2) {
#pragma unroll
        for (int e = 0; e < 8; ++e) o[e] = sigmoidf_(v[e]);
      } else {
        uint4 d = *(const uint4*)(dst + ad);
        float dv[8] = {lo2f(d.x), hi2f(d.x), lo2f(d.y), hi2f(d.y), lo2f(d.z), hi2f(d.z), lo2f(d.w), hi2f(d.w)};
        if (seg == 0) {
          float4 st = *(const float4*)(STATS + ((row0 + r) * 4 + ((nt & 7) >> 1)) * 4);
          float mu = (st.x + st.z) * (1.f / 256.f);
          float var = fmaxf((st.y + st.w) * (1.f / 256.f) - mu * mu, 0.f);
          float rstd = rsqrtf(var + EPSV);
#pragma unroll
          for (int e = 0; e < 8; ++e) o[e] = (dv[e] - mu) * rstd * siluf_(v[e]);
        } else {
#pragma unroll
          for (int e = 0; e < 8; ++e) o[e] = dv[e] * geluf_(v[e]);
        }
      }
      uint4 ov;
      ov.x = pack2(o[0], o[1]); ov.y = pack2(o[2], o[3]); ov.z = pack2(o[4], o[5]); ov.w = pack2(o[6], o[7]);
      *(uint4*)(dst + ad) = ov;
    }
   }
  }
}

DI void phase_gemm_c(const Params& p, u16* smem) {
  const int tid = threadIdx.x, lane = tid & 63, wid = tid >> 6, wm = wid >> 1, wn = wid & 1, fr = lane & 15, fq = lane >> 4;
  const u16* A3 = (const u16*)(p.ws + OFF_O);
  const u16* A5 = (const u16*)(p.ws + OFF_Y);
  const u16* S6 = (const u16*)(p.ws + OFF_VT);
  const u16* S7 = (const u16*)(p.ws + OFF_P4);
  const u16* wro = (const u16*)(p.ws + OFF_WTRO);
  const u16* wlo = (const u16*)(p.ws + OFF_WTLO);
  u16* YM = (u16*)(p.ws + OFF_HX);
  int mt2, nt;
  for (int it = 0; tile_at(it, 128, 8, mt2, nt); ++it) {
    f32x4 a1[4][8];
    float* T = (float*)smem;
    zero_big(a1);
    mma_big3(a1, A3 + (long)mt2 * 256 * 1024, wro + (long)nt * 128 * 1024, smem);
#pragma unroll 1
    for (int h = 0; h < 2; ++h) {
      const long row0 = (long)(mt2 * 2 + h) * 128;
      __syncthreads();
      big_to_lds(a1, T, h);
      __syncthreads();
#pragma unroll 1
      for (int i = 0; i < 8; ++i) {
        int idx = tid + i * 256;
        int r = idx >> 4, c0 = (idx & 15) * 8;
        float4 a = *(const float4*)(T + r * 132 + c0), bq = *(const float4*)(T + r * 132 + c0 + 4);
        long ad = (row0 + r) * 1024 + nt * 128 + c0;
        uint4 g = *(const uint4*)(S6 + ad);
        a.x *= lo2f(g.x); a.y *= hi2f(g.x); a.z *= lo2f(g.y); a.w *= hi2f(g.y);
        bq.x *= lo2f(g.z); bq.y *= hi2f(g.z); bq.z *= lo2f(g.w); bq.w *= hi2f(g.w);
        *(uint4*)(YM + ad) = pack8(a, bq);
      }
    }
    zero_big(a1);
    mma_big3(a1, A5 + (long)mt2 * 256 * 1024, wlo + (long)nt * 128 * 1024, smem);
#pragma unroll 1
    for (int h = 0; h < 2; ++h) {
      const long row0 = (long)(mt2 * 2 + h) * 128;
      __syncthreads();
      big_to_lds(a1, T, h);
      __syncthreads();
#pragma unroll 1
      for (int i = 0; i < 8; ++i) {
        int idx = tid + i * 256;
        int r = idx >> 4, c0 = (idx & 15) * 8;
        float4 a = *(const float4*)(T + r * 132 + c0), bq = *(const float4*)(T + r * 132 + c0 + 4);
        long ad = (row0 + r) * 1024 + nt * 128 + c0;
        uint4 g = *(const uint4*)(S7 + ad);
        uint4 y = *(const uint4*)(YM + ad);
        a.x = lo2f(y.x) + a.x * lo2f(g.x); a.y = hi2f(y.x) + a.y * hi2f(g.x); a.z = lo2f(y.y) + a.z * lo2f(g.y); a.w = hi2f(y.y) + a.w * hi2f(g.y);
        bq.x = lo2f(y.z) + bq.x * lo2f(g.z); bq.y = hi2f(y.z) + bq.y * hi2f(g.z); bq.z = lo2f(y.w) + bq.z * lo2f(g.w); bq.w = hi2f(y.w) + bq.w * hi2f(g.w);
        *(uint4*)(YM + ad) = pack8(a, bq);
      }
    }
  }
}

DI void phase_gemm_d(const Params& p, u16* smem) {
  const int tid = threadIdx.x, lane = tid & 63, wid = tid >> 6, wm = wid >> 1, wn = wid & 1, fr = lane & 15, fq = lane >> 4;
  const u16* YM = (const u16*)(p.ws + OFF_HX);
  const u16* wo = (const u16*)(p.ws + OFF_WTO);
  const float* mod = (const float*)(p.ws + OFF_MOD);
  int mt2, nt;
  for (int it = 0; tile_at(it, 128, 8, mt2, nt); ++it) {
    const int b = mt2 / 32;
    f32x4 acc[4][8];
    zero_big(acc);
    mma_big3(acc, YM + (long)mt2 * 256 * 1024, wo + (long)nt * 128 * 1024, smem);
    float* T = (float*)smem;
#pragma unroll 1
   for (int h = 0; h < 2; ++h) {
    const long row0 = (long)(mt2 * 2 + h) * 128;
    __syncthreads();
    big_to_lds(acc, T, h);
    __syncthreads();
#pragma unroll 1
    for (int i = 0; i < 8; ++i) {
      int idx = tid + i * 256;
      int r = idx >> 4, c0 = (idx & 15) * 8;
      float4 a = *(const float4*)(T + r * 132 + c0), bq = *(const float4*)(T + r * 132 + c0 + 4);
      long ad = (row0 + r) * 1024 + nt * 128 + c0;
      float4 ga = *(const float4*)(mod + b * 6144 + 2048 + nt * 128 + c0), gb = *(const float4*)(mod + b * 6144 + 2048 + nt * 128 + c0 + 4);
      float4 xa = *(const float4*)(p.x + ad), xb = *(const float4*)(p.x + ad + 4);
      a.x = xa.x + ga.x * a.x; a.y = xa.y + ga.y * a.y; a.z = xa.z + ga.z * a.z; a.w = xa.w + ga.w * a.w;
      bq.x = xb.x + gb.x * bq.x; bq.y = xb.y + gb.y * bq.y; bq.z = xb.z + gb.z * bq.z; bq.w = xb.w + gb.w * bq.w;
      *(float4*)(p.out + ad) = a;
      *(float4*)(p.out + ad + 4) = bq;
    }
   }
  }
}

DI void phase_gemm_e(const Params& p, u16* smem) {
  const int tid = threadIdx.x, lane = tid & 63, wid = tid >> 6, wm = wid >> 1, wn = wid & 1, fr = lane & 15, fq = lane >> 4;
  const u16* HX2 = (const u16*)(p.ws + OFF_O);
  const u16* wq = (const u16*)(p.ws + OFF_WTQ);
  u16* QP = (u16*)(p.ws + OFF_Q);
  int mt2, nt;
  for (int it = 0; tile_at(it, 128, 8, mt2, nt); ++it) {
    f32x4 acc[4][8];
    zero_big(acc);
    mma_big3(acc, HX2 + (long)mt2 * 256 * 1024, wq + (long)nt * 128 * 1024, smem);
#pragma unroll 1
    for (int h = 0; h < 2; ++h) {
      const long row0 = (long)(mt2 * 2 + h) * 128;
      __syncthreads();
      big_to_lds(acc, (float*)smem, h);
      __syncthreads();
      tile_store_bf16((const float*)smem, QP + row0 * 1024 + nt * 128, 1024);
    }
  }
}

DI void ins16(float (&L)[16], float v) {
#pragma unroll
  for (int j = 15; j >= 1; --j) L[j] = __builtin_amdgcn_fmed3f(L[j - 1], L[j], v);
  L[0] = fmaxf(L[0], v);
}

DI void phase_peer_topk(const Params& p, u16* smem) {
  const int tid = threadIdx.x, lane = tid & 63, wid = tid >> 6, wm = wid >> 1, wn = wid & 1, fr = lane & 15, fq = lane >> 4;
  const u16* QP = (const u16*)(p.ws + OFF_Q);
  const u16* KEYS = (const u16*)(p.ws + OFF_KEYS);
  int* PIDX = (int*)(p.ws + OFF_KT);
  float* PG = (float*)(p.ws + OFF_KT + (size_t)NTOK * 128 * 4);
  float* sc = (float*)smem;
  const float NINF = -__builtin_inff();
  int mt, h;
  for (int it = 0; tile_at(it, 256, 8, mt, h); ++it) {
    const long row0 = (long)mt * 128;
    float L1[16], L2[16];
#pragma unroll
    for (int j = 0; j < 16; ++j) { L1[j] = NINF; L2[j] = NINF; }
#pragma unroll
    for (int ph = 0; ph < 2; ++ph) {
      f32x4 acc[4][4];
      zero_acc(acc);
      mma_loop<false>(acc, QP + row0 * 1024 + h * 128 + ph * 64, 1024, KEYS + (long)((h * 2 + ph) * 128) * 64, 64, 64, smem, Ident{});
#pragma unroll
      for (int mi = 0; mi < 4; ++mi)
#pragma unroll
        for (int ni = 0; ni < 4; ++ni)
#pragma unroll
          for (int j = 0; j < 4; ++j) {
            int r = wm * 64 + mi * 16 + fq * 4 + j, cl = wn * 64 + ni * 16 + fr;
            sc[r * 129 + cl] = acc[mi][ni][j];
          }
      __syncthreads();
      {
        const int row = tid & 127, kh = tid >> 7;
        float Lt[16];
#pragma unroll
        for (int j = 0; j < 16; ++j) Lt[j] = NINF;
        for (int kk = 0; kk < 64; ++kk) {
          const int k = kh * 64 + kk;
          float v = sc[row * 129 + k];
          v = __uint_as_float((__float_as_uint(v) & ~0x7Fu) | (unsigned)k);
          ins16(Lt, v);
        }
        if (kh == 1) {
#pragma unroll
          for (int j = 0; j < 16; ++j) sc[row * 129 + 64 + j] = Lt[j];
        }
        __syncthreads();
        if (kh == 0) {
#pragma unroll
          for (int j = 0; j < 16; ++j) ins16(Lt, sc[row * 129 + 64 + j]);
#pragma unroll
          for (int j = 0; j < 16; ++j) {
            if (ph == 0) L1[j] = Lt[j];
            else L2[j] = Lt[j];
          }
        }
      }
    }
    if (tid < 128) {
      int* myrow = (int*)(sc + tid * 129);
      float C[16];
#pragma unroll
      for (int j = 0; j < 16; ++j) {
        C[j] = NINF;
        myrow[j] = (int)(__float_as_uint(L1[j]) & 0x7Fu);
        myrow[16 + j] = (int)(__float_as_uint(L2[j]) & 0x7Fu);
      }
#pragma unroll
      for (int a = 0; a < 16; ++a)
#pragma unroll
        for (int b = 0; b < 16; ++b)
          if ((a + 1) * (b + 1) <= 16) {
            float s = __uint_as_float(__float_as_uint(L1[a]) & ~0x7Fu) + __uint_as_float(__float_as_uint(L2[b]) & ~0x7Fu);
            s = __uint_as_float((__float_as_uint(s) & ~0xFFu) | (unsigned)(a * 16 + b));
            ins16(C, s);
          }
      float m = __uint_as_float(__float_as_uint(C[0]) & ~0xFFu);
      float w[16];
      float sum = 0.f;
#pragma unroll
      for (int k = 0; k < 16; ++k) {
        w[k] = __expf(__uint_as_float(__float_as_uint(C[k]) & ~0xFFu) - m);
        sum += w[k];
      }
      float rs = 1.f / sum;
      long base = (row0 + tid) * 128 + h * 16;
#pragma unroll
      for (int k = 0; k < 16; ++k) {
        unsigned ab = __float_as_uint(C[k]) & 0xFFu;
        int e = myrow[ab >> 4] * 128 + myrow[16 + (ab & 15)];
        PIDX[base + k] = e;
        PG[base + k] = w[k] * rs;
      }
    }
  }
}

DI float dotq16(uint4 q, const float* x) {
  float s = 0.f;
  s += (float)(q.x & 0xffu) * x[0] + (float)((q.x >> 8) & 0xffu) * x[1] + (float)((q.x >> 16) & 0xffu) * x[2] + (float)(q.x >> 24) * x[3];
  s += (float)(q.y & 0xffu) * x[4] + (float)((q.y >> 8) & 0xffu) * x[5] + (float)((q.y >> 16) & 0xffu) * x[6] + (float)(q.y >> 24) * x[7];
  s += (float)(q.z & 0xffu) * x[8] + (float)((q.z >> 8) & 0xffu) * x[9] + (float)((q.z >> 16) & 0xffu) * x[10] + (float)(q.z >> 24) * x[11];
  s += (float)(q.w & 0xffu) * x[12] + (float)((q.w >> 8) & 0xffu) * x[13] + (float)((q.w >> 16) & 0xffu) * x[14] + (float)(q.w >> 24) * x[15];
  return s;
}
DI void axpyq16(float* o, float c, uint4 q) {
  o[0] += c * (float)(q.x & 0xffu); o[1] += c * (float)((q.x >> 8) & 0xffu); o[2] += c * (float)((q.x >> 16) & 0xffu); o[3] += c * (float)(q.x >> 24);
  o[4] += c * (float)(q.y & 0xffu); o[5] += c * (float)((q.y >> 8) & 0xffu); o[6] += c * (float)((q.y >> 16) & 0xffu); o[7] += c * (float)(q.y >> 24);
  o[8] += c * (float)(q.z & 0xffu); o[9] += c * (float)((q.z >> 8) & 0xffu); o[10] += c * (float)((q.z >> 16) & 0xffu); o[11] += c * (float)(q.z >> 24);
  o[12] += c * (float)(q.w & 0xffu); o[13] += c * (float)((q.w >> 8) & 0xffu); o[14] += c * (float)((q.w >> 16) & 0xffu); o[15] += c * (float)(q.w >> 24);
}

template <int MODE>
DI void phase_peer_gather(const Params& p, float* outp) {
  const int lane = threadIdx.x & 63;
  const long gw = ((long)blockIdx.x * blockDim.x + threadIdx.x) >> 6;
  const long nw = ((long)gridDim.x * blockDim.x) >> 6;
  const u16* HX2 = (const u16*)(p.ws + OFF_O);
  const unsigned char* UT = p.ws + OFF_UT;
  const unsigned char* VTAB = p.ws + OFF_VTAB;
  const float* USC = (const float*)(p.ws + OFF_USC);
  const float* VSC = (const float*)(p.ws + OFF_VSC);
  const int* PIDX = (const int*)(p.ws + OFF_KT);
  const float* PG = (const float*)(p.ws + OFF_KT + (size_t)NTOK * 128 * 4);
  const float* mod = (const float*)(p.ws + OFF_MOD);
  for (long t = gw; t < NTOK; t += nw) {
    float x[16];
    float xl = 0.f;
    {
      uint4 v0 = *(const uint4*)(HX2 + t * 1024 + lane * 16);
      uint4 v1 = *(const uint4*)(HX2 + t * 1024 + lane * 16 + 8);
      x[0] = lo2f(v0.x); x[1] = hi2f(v0.x); x[2] = lo2f(v0.y); x[3] = hi2f(v0.y);
      x[4] = lo2f(v0.z); x[5] = hi2f(v0.z); x[6] = lo2f(v0.w); x[7] = hi2f(v0.w);
      x[8] = lo2f(v1.x); x[9] = hi2f(v1.x); x[10] = lo2f(v1.y); x[11] = hi2f(v1.y);
      x[12] = lo2f(v1.z); x[13] = hi2f(v1.z); x[14] = lo2f(v1.w); x[15] = hi2f(v1.w);
#pragma unroll
      for (int i = 0; i < 16; ++i) xl += x[i];
    }
    float xm = 0.f;
#pragma unroll
    for (int i = 0; i < 16; ++i) xm = fmaxf(xm, fabsf(x[i]));
#pragma unroll
    for (int o = 32; o > 0; o >>= 1) xm = fmaxf(xm, __shfl_xor(xm, o));
    xm = fmaxf(xm, 1e-30f);
    const float xinv = 127.f / xm, xsc = xm * (1.f / 127.f);
    int xq[4];
#pragma unroll
    for (int w = 0; w < 4; ++w) {
      unsigned b0 = (unsigned)((int)rintf(x[w * 4 + 0] * xinv)) & 0xffu, b1 = (unsigned)((int)rintf(x[w * 4 + 1] * xinv)) & 0xffu;
      unsigned b2 = (unsigned)((int)rintf(x[w * 4 + 2] * xinv)) & 0xffu, b3 = (unsigned)((int)rintf(x[w * 4 + 3] * xinv)) & 0xffu;
      xq[w] = (int)(b0 | (b1 << 8) | (b2 << 16) | (b3 << 24));
    }
    const int e0 = PIDX[t * 128 + lane], e1 = PIDX[t * 128 + 64 + lane];
    const float g0 = PG[t * 128 + lane], g1 = PG[t * 128 + 64 + lane];
    float d0 = 0.f, d1 = 0.f;
#pragma unroll 1
    for (int pi = 0; pi < (MODE == 2 ? 0 : 128); pi += 8) {
      uint4 ua[8];
#pragma unroll
      for (int q = 0; q < 8; ++q) {
        int e = __shfl(pi < 64 ? e0 : e1, (pi + q) & 63);
        ua[q] = *(const uint4*)(UT + (long)e * 1024 + lane * 16);
      }
      int a8[8];
#pragma unroll
      for (int q = 0; q < 8; ++q) {
        int acc = __builtin_amdgcn_sdot4((int)ua[q].x, xq[0], 0, false);
        acc = __builtin_amdgcn_sdot4((int)ua[q].y, xq[1], acc, false);
        acc = __builtin_amdgcn_sdot4((int)ua[q].z, xq[2], acc, false);
        a8[q] = __builtin_amdgcn_sdot4((int)ua[q].w, xq[3], acc, false);
      }
      {
        const bool h5 = (lane & 32) != 0, h4 = (lane & 16) != 0, h3 = (lane & 8) != 0;
        int b4[4], b2[2], b1;
#pragma unroll
        for (int i = 0; i < 4; ++i) {
          int keep = h5 ? a8[4 + i] : a8[i], send = h5 ? a8[i] : a8[4 + i];
          b4[i] = keep + __shfl_xor(send, 32);
        }
#pragma unroll
        for (int i = 0; i < 2; ++i) {
          int keep = h4 ? b4[2 + i] : b4[i], send = h4 ? b4[i] : b4[2 + i];
          b2[i] = keep + __shfl_xor(send, 16);
        }
        {
          int keep = h3 ? b2[1] : b2[0], send = h3 ? b2[0] : b2[1];
          b1 = keep + __shfl_xor(send, 8);
        }
        b1 += __shfl_xor(b1, 4);
        b1 += __shfl_xor(b1, 2);
        b1 += __shfl_xor(b1, 1);
        int got = __shfl(b1, (lane & 7) * 8);
        if ((lane >> 3) == ((pi & 63) >> 3)) {
          if (pi < 64) d0 = (float)got * xsc;
          else d1 = (float)got * xsc;
        }
      }
    }
    float* COEF = (float*)(p.ws + OFF_HX);
    float c0, c1;
    if (MODE != 2) {
      c0 = g0 * geluf_(d0 * USC[e0]) * VSC[e0];
      c1 = g1 * geluf_(d1 * USC[e1]) * VSC[e1];
      if (MODE == 1) {
        COEF[t * 128 + lane] = c0;
        COEF[t * 128 + 64 + lane] = c1;
        continue;
      }
    } else {
      c0 = COEF[t * 128 + lane];
      c1 = COEF[t * 128 + 64 + lane];
    }
    const float csum = wave_sum(c0 + c1);
    float o[16];
#pragma unroll
    for (int i = 0; i < 16; ++i) o[i] = 0.f;
#pragma unroll 1
    for (int pi = 0; pi < 128; pi += 8) {
      uint4 va[8];
      float cf[8];
#pragma unroll
      for (int q = 0; q < 8; ++q) {
        int e = __shfl(pi < 64 ? e0 : e1, (pi + q) & 63);
        cf[q] = __shfl(pi < 64 ? c0 : c1, (pi + q) & 63);
        va[q] = *(const uint4*)(VTAB + (long)e * 1024 + lane * 16);
      }
#pragma unroll
      for (int q = 0; q < 8; ++q) axpyq16(o, cf[q], va[q]);
    }
    const int b = (int)(t / LS);
    const float* g2 = mod + b * 6144 + 5120;
    const float* xr = p.out + t * 1024;
    float* xw = outp + t * 1024;
    float ss = 0.f;
#pragma unroll
    for (int q4 = 0; q4 < 4; ++q4) {
      int c = lane * 16 + q4 * 4;
      float4 xv = *(const float4*)(xr + c);
      float4 gv = *(const float4*)(g2 + c);
      float* oo = o + q4 * 4;
      oo[0] = xv.x + gv.x * (oo[0] - 128.f * csum);
      oo[1] = xv.y + gv.y * (oo[1] - 128.f * csum);
      oo[2] = xv.z + gv.z * (oo[2] - 128.f * csum);
      oo[3] = xv.w + gv.w * (oo[3] - 128.f * csum);
      ss += oo[0] * oo[0] + oo[1] * oo[1] + oo[2] * oo[2] + oo[3] * oo[3];
    }
    ss = wave_sum(ss);
    float rstd = rsqrtf(ss * (1.f / 1024.f) + EPSV);
#pragma unroll
    for (int q4 = 0; q4 < 4; ++q4) {
      int c = lane * 16 + q4 * 4;
      float4 fg = *(const float4*)(p.final_g + c);
      float* oo = o + q4 * 4;
      float4 r;
      r.x = oo[0] * rstd * fg.x;
      r.y = oo[1] * rstd * fg.y;
      r.z = oo[2] * rstd * fg.z;
      r.w = oo[3] * rstd * fg.w;
      *(float4*)(xw + c) = r;
    }
  }
}

#define XB_TMO      128
#define XB_XCNT(j)  (256  + 64 * (j))
#define XB_XSUB(j)  (1280 + 64 * (j))
#define XB_XGEN(j)  (2304 + 64 * (j))
#define XB_TOP      3328
#define XB_TOPGEN   3392
#define XCD_BAR_WORDS 3456
#define XB_SPIN_CAP (1u << 18)
#define LAS __attribute__((address_space(3)))
DI unsigned xb_ld(unsigned* p) { return __hip_atomic_load(p, __ATOMIC_RELAXED, __HIP_MEMORY_SCOPE_AGENT); }
DI unsigned xb_add(unsigned* p, unsigned v) { return __hip_atomic_fetch_add(p, v, __ATOMIC_RELAXED, __HIP_MEMORY_SCOPE_AGENT); }
DI unsigned xb_xcc_id() { return (unsigned)__builtin_amdgcn_s_getreg((3 << 11) | 20) & 0xFu; }
#define XB_SPIN(cond, bar) do { unsigned _sp = 0; while (cond) { __builtin_amdgcn_s_sleep(1); \
    if ((++_sp & 255u) == 0u) { if (xb_ld(&(bar)[XB_TMO])) break; if (_sp > XB_SPIN_CAP) { atomicAdd(&(bar)[XB_TMO], 1u); break; } } } } while (0)
struct XcdBarrier {
  unsigned* bar;
  unsigned x;
  volatile LAS unsigned* st;
};
DI XcdBarrier xcd_barrier_post(unsigned* bar, volatile LAS unsigned* st) {
  XcdBarrier b;
  b.bar = bar;
  b.x = xb_xcc_id();
  b.st = st;
  if (threadIdx.x == 0) (void)xb_add(&bar[XB_XCNT(b.x)], 1u);
  return b;
}
DI void xcd_barrier_complete(unsigned* bar, unsigned x, unsigned& nloc, unsigned& nx) {
  const unsigned G = gridDim.x * gridDim.y * gridDim.z;
  unsigned sum, cnt, mine, sp = 0u;
  for (;;) {
    sum = 0u; cnt = 0u; mine = 0u;
#pragma unroll
    for (unsigned j = 0; j < 16; ++j) {
      const unsigned c = xb_ld(&bar[XB_XCNT(j)]);
      sum += c;
      cnt += (c > 0u) ? 1u : 0u;
      mine = (j == x) ? c : mine;
    }
    if (sum == G) break;
    __builtin_amdgcn_s_sleep(1);
    if ((++sp & 255u) == 0u) {
      if (xb_ld(&bar[XB_TMO])) break;
      if (sp > XB_SPIN_CAP) { atomicAdd(&bar[XB_TMO], 1u); break; }
    }
  }
  nloc = mine > 0u ? mine : 1u;
  nx = cnt > 0u ? cnt : 1u;
}
DI void xcd_barrier(const XcdBarrier& b) {
  asm volatile("s_waitcnt vmcnt(0)" ::: "memory");
  __syncthreads();
  if (threadIdx.x == 0) {
    unsigned* bar = b.bar;
    __builtin_amdgcn_s_waitcnt(0);
    unsigned nloc = b.st[0], nx = b.st[1];
    if (nloc == 0u) { xcd_barrier_complete(bar, b.x, nloc, nx); b.st[0] = nloc; b.st[1] = nx; }
    const unsigned old = xb_add(&bar[XB_XSUB(b.x)], 1u);
    const unsigned gen = old / nloc;
    if (old + 1u == (gen + 1u) * nloc) {
      __builtin_amdgcn_fence(__ATOMIC_RELEASE, "agent");
      asm volatile("s_waitcnt vmcnt(0)" ::: "memory");
      const unsigned og = xb_add(&bar[XB_TOP], 1u);
      const unsigned tg = og / nx;
      if (og + 1u == (tg + 1u) * nx) xb_add(&bar[XB_TOPGEN], 1u);
      else XB_SPIN(xb_ld(&bar[XB_TOPGEN]) == tg, bar);
      __builtin_amdgcn_fence(__ATOMIC_ACQUIRE, "agent");
      xb_add(&bar[XB_XGEN(b.x)], 1u);
      asm volatile("s_waitcnt vmcnt(0)" ::: "memory");
    } else {
      XB_SPIN(xb_ld(&bar[XB_XGEN(b.x)]) == gen, bar);
      __builtin_amdgcn_fence(__ATOMIC_ACQUIRE, "agent");
      asm volatile("s_waitcnt vmcnt(0)" ::: "memory");
    }
  }
  __syncthreads();
}

constexpr int NPHASE = 14;

__global__ void __launch_bounds__(256, 2) mega(Params p) {
  extern __shared__ __attribute__((aligned(16))) unsigned char lds_raw[];
  u16* smem = (u16*)lds_raw;
  float* tabs = (float*)(lds_raw + LDS_MAIN);
#ifndef ONLY
#define ONLY -1
#endif
  const int lo = (int)p.ph_lo, hi = (int)p.ph_hi;
  volatile LAS unsigned* xst = (volatile LAS unsigned*)(lds_raw + LDS_MAIN + 3072);
  if (threadIdx.x == 0) { xst[0] = 0u; xst[1] = 0u; }
  __syncthreads();
  XcdBarrier xb = xcd_barrier_post((unsigned*)(p.ws + OFF_BAR), xst);
#ifndef REP_MASK
#define REP_MASK 0
#endif
#define PHS(n, call)                                        \
  if ((ONLY < 0 || ONLY == n) && lo <= n && n < hi) {       \
    if ((REP_MASK >> n) & 1) {                              \
      call;                                                 \
      cg::this_grid().sync();                               \
    }                                                       \
    call;                                                   \
    if (n + 1 < hi) {                                       \
      if (lo < 0) cg::this_grid().sync();                   \
      else xcd_barrier(xb);                                 \
    }                                                       \
  }
  PHS(0, phase_prep(p, smem))
#ifndef REP_SYNC
#define REP_SYNC 0
#endif
  for (int i = 0; i < REP_SYNC; ++i) xcd_barrier(xb);
  PHS(1, phase_norm1(p))
  PHS(2, phase_gemm_a(p, smem))
  PHS(3, phase3(p, smem, tabs))
  PHS(4, phase4(p))
  PHS(5, phase5(p, smem, tabs))
  PHS(6, phase_gemm_b(p, smem))
  PHS(7, phase_gemm_c(p, smem))
  PHS(8, phase_gemm_d(p, smem))
  PHS(9, phase_norm2(p))
  PHS(10, phase_gemm_e(p, smem))
  PHS(11, phase_peer_topk(p, smem))
#ifndef REP_GATHER
#define REP_GATHER 0
#endif
  PHS(12, phase_peer_gather<1>(p, p.out))
  PHS(13, phase_peer_gather<2>(p, p.out))
}

extern "C" void kernel_launch(void* const* d_in, const int* in_sizes, int n_in, void* d_out, int out_size, void* d_ws,
                              size_t ws_size, hipStream_t stream) {
  static int grid_blocks = 0;
  if (!grid_blocks) {
    int dev = 0, cus = 0, per_cu = 0;
    hipGetDevice(&dev);
    hipDeviceGetAttribute(&cus, hipDeviceAttributeMultiprocessorCount, dev);
    hipFuncSetAttribute((const void*)mega, hipFuncAttributeMaxDynamicSharedMemorySize, LDS_BYTES);
    hipOccupancyMaxActiveBlocksPerMultiprocessor(&per_cu, (const void*)mega, 256, LDS_BYTES);
    if (per_cu < 1) per_cu = 1;
    if (per_cu > 2) per_cu = 2;
    grid_blocks = cus * per_cu;
    fprintf(stderr, "mega: cus=%d per_cu=%d grid=%d ws_need=%zu ws_size=%zu\n", cus, per_cu, grid_blocks, (size_t)WS_END, ws_size);
  }
  if (ws_size < WS_END2 || n_in != 25) {
    fprintf(stderr, "mega: workspace too small (%zu < %zu) or n_in=%d\n", ws_size, (size_t)WS_END, n_in);
    return;
  }
  hipMemsetAsync((unsigned char*)d_ws + OFF_BAR, 0, 16384, stream);
  Params p{};
  const float** pp = (const float**)&p;
  for (int i = 0; i < 25; ++i) pp[i] = (const float*)d_in[i];
  p.out = (float*)d_out;
  p.ws = (unsigned char*)d_ws;
#if MULTI
  for (int ph = 0; ph < NPHASE; ++ph) {
    p.ph_lo = ph;
    p.ph_hi = ph + 1;
    hipLaunchKernelGGL(mega, dim3(grid_blocks), dim3(256), LDS_BYTES, stream, p);
  }
#else
  p.ph_lo = 0;
  p.ph_hi = NPHASE;
  void* args[] = {&p};
  hipError_t e = hipLaunchCooperativeKernel((const void*)mega, dim3(grid_blocks), dim3(256), args, LDS_BYTES, stream);
  if (e != hipSuccess) fprintf(stderr, "cooperative launch failed: %s (grid %d)\n", hipGetErrorString(e), grid_blocks);
#endif
}
```

```cpp
#include <hip/hip_runtime.h>
#include <hip/hip_bf16.h>
#include <hip/hip_cooperative_groups.h>
#include <cstdio>
namespace cg = cooperative_groups;

typedef unsigned short u16;
using bf16x8 = __attribute__((ext_vector_type(8))) short;
using f32x4 = __attribute__((ext_vector_type(4))) float;
#define DI __device__ __forceinline__

#ifndef MULTI
#define MULTI 0
#endif

constexpr int NB = 4, LS = 8192, LCX = 256, DM = 1024;
constexpr int NTOK = NB * LS;
constexpr int NCTX = NB * LCX;
constexpr int NROW = NTOK + NCTX;
constexpr int NCHUNK = NROW / 128;
constexpr int INC = 7168;
constexpr float EPSV = 1e-6f;

constexpr size_t al256(size_t x) { return (x + 255) & ~size_t(255); }
constexpr size_t OFF_WTIN = 0;
constexpr size_t OFF_WTRO = OFF_WTIN + al256((size_t)INC * 1024 * 2);
constexpr size_t OFF_WTLO = OFF_WTRO + al256((size_t)1024 * 1024 * 2);
constexpr size_t OFF_WTO = OFF_WTLO + al256((size_t)1024 * 1024 * 2);
constexpr size_t OFF_WTQ = OFF_WTO + al256((size_t)1024 * 1024 * 2);
constexpr size_t OFF_WAT = OFF_WTQ + al256((size_t)1024 * 1024 * 2);
constexpr size_t OFF_KEYS = OFF_WAT + al256((size_t)2 * 2 * 8 * 128 * 128 * 2);
constexpr size_t OFF_MOD = OFF_KEYS + al256((size_t)8 * 2 * 128 * 64 * 2);
constexpr size_t OFF_LA = OFF_MOD + al256((size_t)5 * 6144 * 4);
constexpr size_t OFF_LB = OFF_LA + al256((size_t)2 * NCHUNK * 1024 * 4);
constexpr size_t OFF_LH = OFF_LB + al256((size_t)2 * NCHUNK * 1024 * 4);
constexpr size_t OFF_UT = OFF_LH + al256((size_t)2 * NCHUNK * 1024 * 4);
constexpr size_t OFF_VTAB = OFF_UT + al256((size_t)16384 * 1024);
constexpr size_t OFF_USC = OFF_VTAB + al256((size_t)16384 * 1024);
constexpr size_t OFF_VSC = OFF_USC + al256((size_t)16384 * 4);
constexpr size_t OFF_HX = OFF_VSC + al256((size_t)16384 * 4);
constexpr size_t OFF_Q = OFF_HX + al256((size_t)NROW * 1024 * 2);
constexpr size_t OFF_K = OFF_Q + al256((size_t)NROW * 512 * 2);
constexpr size_t OFF_VT = OFF_K + al256((size_t)NROW * 512 * 2);
constexpr size_t OFF_P4 = OFF_VT + al256((size_t)NROW * 1024 * 2);
constexpr size_t OFF_O = OFF_P4 + al256((size_t)NROW * 1024 * 2);
constexpr size_t OFF_STATS = OFF_O + al256((size_t)NTOK * 1024 * 2);
constexpr size_t OFF_KVC = OFF_STATS + al256((size_t)NTOK * 16 * 4);
constexpr size_t OFF_KT = OFF_KVC + al256((size_t)32 * 2 * 32768 * 2);
constexpr size_t OFF_Y = OFF_KT;
constexpr size_t WS_END = OFF_Y + al256((size_t)NTOK * 1024 * 2);

constexpr size_t OFF_BAR = WS_END;
constexpr size_t WS_END2 = OFF_BAR + 16384;
constexpr int LDS_MAIN = 4 * 128 * 72 * 2;
constexpr int LDS_BYTES = LDS_MAIN + 4096;

struct Params {
  const float *x, *c, *ctx, *c_ctx, *mod_w, *mod_b, *norm1_g, *norm2_g, *w_in, *ret_decay, *conv_w, *conv_b, *lru_wa,
      *lru_ba, *lru_wx, *lru_bx, *lru_lambda, *w_ret_out, *w_lru_out, *w_out, *peer_wq, *peer_keys, *peer_u, *peer_v,
      *final_g;
  float* out;
  unsigned char* ws;
  long ph_lo, ph_hi;
};

typedef __bf16 bf16x2_t __attribute__((ext_vector_type(2)));
DI u16 f2bf(float f) { return __builtin_bit_cast(u16, (__bf16)f); }
DI float bf2f(u16 h) { return __uint_as_float(((unsigned)h) << 16); }
DI unsigned pack2(float a, float b) {
  bf16x2_t v = {(__bf16)a, (__bf16)b};
  return __builtin_bit_cast(unsigned, v);
}
DI float lo2f(unsigned w) { return __uint_as_float(w << 16); }
DI float hi2f(unsigned w) { return __uint_as_float(w & 0xffff0000u); }
DI float wave_sum(float v) {
#pragma unroll
  for (int o = 32; o > 0; o >>= 1) v += __shfl_xor(v, o);
  return v;
}
DI float sigmoidf_(float x) { return __builtin_amdgcn_rcpf(1.f + __expf(-x)); }
DI float siluf_(float x) { return x * __builtin_amdgcn_rcpf(1.f + __expf(-x)); }
DI float geluf_(float x) {
  float z2 = 1.5957691216057308f * (x + 0.044715f * x * x * x);
  return x * __builtin_amdgcn_rcpf(1.f + __expf(-z2));
}
DI float softplusf_(float x) { return x > 20.f ? x : log1pf(__expf(x)); }

struct Ident {
  static constexpr bool id = true;
  DI float operator()(float v, int, int) const { return v; }
};
struct ColScale {
  static constexpr bool id = false;
  const float* tab;
  DI float operator()(float v, int, int k) const { return v * tab[k]; }
};
struct RowScale {
  static constexpr bool id = false;
  const float* tab;
  DI float operator()(float v, int r, int) const { return v * tab[r]; }
};

template <class AX>
DI uint4 xform8(uint4 v, int row, int k, const AX& ax) {
  if constexpr (AX::id) {
    return v;
  } else {
    uint4 o;
    o.x = pack2(ax(lo2f(v.x), row, k + 0), ax(hi2f(v.x), row, k + 1));
    o.y = pack2(ax(lo2f(v.y), row, k + 2), ax(hi2f(v.y), row, k + 3));
    o.z = pack2(ax(lo2f(v.z), row, k + 4), ax(hi2f(v.z), row, k + 5));
    o.w = pack2(ax(lo2f(v.w), row, k + 6), ax(hi2f(v.w), row, k + 7));
    return o;
  }
}

template <bool A_LDS, int NI, class AX>
DI void mma_loop(f32x4 (&acc)[4][NI], const u16* __restrict__ A, long lda, const u16* __restrict__ Bt, long ldb, int K,
                 u16* smem, const AX& ax) {
  const int tid = threadIdx.x, lane = tid & 63, wid = tid >> 6, wm = wid >> 1, wn = wid & 1, fr = lane & 15,
            fq = lane >> 4;
  u16* sA = smem;
  u16* sB = smem + 2 * 128 * 72;
  const int nk = K >> 6;
  uint4 ra[4], rb[NI];
  __syncthreads();
#pragma unroll
  for (int i = 0; i < 4; ++i) {
    int c = tid + i * 256;
    int row = c >> 3, kc = (c & 7) * 8;
    if (!A_LDS) ra[i] = *(const uint4*)(A + (long)row * lda + kc);
    if (i < NI) rb[i] = *(const uint4*)(Bt + (long)row * ldb + kc);
  }
#pragma unroll
  for (int i = 0; i < 4; ++i) {
    int c = tid + i * 256;
    int row = c >> 3, kc = (c & 7) * 8;
    const int pk = (((c & 7) ^ ((row >> 1) & 7)) << 3);
    if (!A_LDS) *(uint4*)(sA + row * 64 + pk) = xform8(ra[i], row, kc, ax);
    if (i < NI) *(uint4*)(sB + row * 64 + pk) = rb[i];
  }
  __syncthreads();
  for (int kt = 0; kt < nk; ++kt) {
    const int cur = kt & 1;
    if (kt + 1 < nk) {
#pragma unroll
      for (int i = 0; i < 4; ++i) {
        int c = tid + i * 256;
        int row = c >> 3, kc = (c & 7) * 8;
        if (!A_LDS) ra[i] = *(const uint4*)(A + (long)row * lda + (kt + 1) * 64 + kc);
        if (i < NI) rb[i] = *(const uint4*)(Bt + (long)row * ldb + (kt + 1) * 64 + kc);
      }
    }
#pragma unroll
    for (int ks = 0; ks < 2; ++ks) {
      bf16x8 af[4];
#pragma unroll
      for (int mi = 0; mi < 4; ++mi) {
        if (A_LDS)
          af[mi] = *(const bf16x8*)(smem + (wm * 64 + mi * 16 + fr) * 144 + kt * 64 + ks * 32 + fq * 8);
        else
          af[mi] = *(const bf16x8*)(sA + cur * (128 * 64) + (wm * 64 + mi * 16 + fr) * 64 + (((ks * 4 + fq) ^ (fr >> 1)) << 3));
      }
#pragma unroll
      for (int ni = 0; ni < NI; ++ni) {
        bf16x8 bq = *(const bf16x8*)(sB + cur * (128 * 64) + (wn * (16 * NI) + ni * 16 + fr) * 64 + (((ks * 4 + fq) ^ (fr >> 1)) << 3));
#pragma unroll
        for (int mi = 0; mi < 4; ++mi)
          acc[mi][ni] = __builtin_amdgcn_mfma_f32_16x16x32_bf16(af[mi], bq, acc[mi][ni], 0, 0, 0);
      }
    }
    if (kt + 1 < nk) {
      const int nx = cur ^ 1;
#pragma unroll
      for (int i = 0; i < 4; ++i) {
        int c = tid + i * 256;
        int row = c >> 3, kc = (c & 7) * 8;
        const int pk = (((c & 7) ^ ((row >> 1) & 7)) << 3);
        if (!A_LDS) *(uint4*)(sA + nx * (128 * 64) + row * 64 + pk) = xform8(ra[i], row, (kt + 1) * 64 + kc, ax);
        if (i < NI) *(uint4*)(sB + nx * (128 * 64) + row * 64 + pk) = rb[i];
      }
    }
    __syncthreads();
  }
}

DI void mma_loop2(f32x4 (&acc)[4][4], const u16* __restrict__ A, long lda, const u16* __restrict__ Bt, long ldb, int K, u16* smem) {
  const int tid = threadIdx.x, lane = tid & 63, wid = tid >> 6, wm = wid >> 1, wn = wid & 1, fr = lane & 15,
            fq = lane >> 4;
  u16* sA = smem;
  u16* sB = smem + 2 * 128 * 72;
  const int nk = K >> 6;
  uint4 a00, b00, a01, b01, a02, b02, a03, b03, a10, b10, a11, b11, a12, b12, a13, b13;
  const int lrow = tid >> 3, kc = (tid & 7) * 8;
  const u16* ap = A + (long)lrow * lda + kc;
  const u16* bp = Bt + (long)lrow * ldb + kc;
  const int soff = lrow * 64 + ((((tid & 7) ^ ((lrow >> 1) & 7))) << 3);
  __syncthreads();
  {
    a00 = *(const uint4*)(ap + (long)(0) * lda + (0) * 64);
    b00 = *(const uint4*)(bp + (long)(0) * ldb + (0) * 64);
    a01 = *(const uint4*)(ap + (long)(32) * lda + (0) * 64);
    b01 = *(const uint4*)(bp + (long)(32) * ldb + (0) * 64);
    a02 = *(const uint4*)(ap + (long)(64) * lda + (0) * 64);
    b02 = *(const uint4*)(bp + (long)(64) * ldb + (0) * 64);
    a03 = *(const uint4*)(ap + (long)(96) * lda + (0) * 64);
    b03 = *(const uint4*)(bp + (long)(96) * ldb + (0) * 64);
    a10 = *(const uint4*)(ap + (long)(0) * lda + (1) * 64);
    b10 = *(const uint4*)(bp + (long)(0) * ldb + (1) * 64);
    a11 = *(const uint4*)(ap + (long)(32) * lda + (1) * 64);
    b11 = *(const uint4*)(bp + (long)(32) * ldb + (1) * 64);
    a12 = *(const uint4*)(ap + (long)(64) * lda + (1) * 64);
    b12 = *(const uint4*)(bp + (long)(64) * ldb + (1) * 64);
    a13 = *(const uint4*)(ap + (long)(96) * lda + (1) * 64);
    b13 = *(const uint4*)(bp + (long)(96) * ldb + (1) * 64);
    *(uint4*)(sA + 0 * (128 * 64) + soff + 0) = a00;
    *(uint4*)(sB + 0 * (128 * 64) + soff + 0) = b00;
    *(uint4*)(sA + 0 * (128 * 64) + soff + 2048) = a01;
    *(uint4*)(sB + 0 * (128 * 64) + soff + 2048) = b01;
    *(uint4*)(sA + 0 * (128 * 64) + soff + 4096) = a02;
    *(uint4*)(sB + 0 * (128 * 64) + soff + 4096) = b02;
    *(uint4*)(sA + 0 * (128 * 64) + soff + 6144) = a03;
    *(uint4*)(sB + 0 * (128 * 64) + soff + 6144) = b03;
  }
  __syncthreads();
  for (int kt = 0; kt < nk; kt += 2) {
    if (kt + 2 < nk) {
    a00 = *(const uint4*)(ap + (long)(0) * lda + (kt + 2) * 64);
    b00 = *(const uint4*)(bp + (long)(0) * ldb + (kt + 2) * 64);
    a01 = *(const uint4*)(ap + (long)(32) * lda + (kt + 2) * 64);
    b01 = *(const uint4*)(bp + (long)(32) * ldb + (kt + 2) * 64);
    a02 = *(const uint4*)(ap + (long)(64) * lda + (kt + 2) * 64);
    b02 = *(const uint4*)(bp + (long)(64) * ldb + (kt + 2) * 64);
    a03 = *(const uint4*)(ap + (long)(96) * lda + (kt + 2) * 64);
    b03 = *(const uint4*)(bp + (long)(96) * ldb + (kt + 2) * 64);
    }
    __builtin_amdgcn_s_setprio(1);
#pragma unroll
    for (int ks = 0; ks < 2; ++ks) {
      bf16x8 af[4];
#pragma unroll
      for (int mi = 0; mi < 4; ++mi)
        af[mi] = *(const bf16x8*)(sA + 0 * (128 * 64) + (wm * 64 + mi * 16 + fr) * 64 + (((ks * 4 + fq) ^ (fr >> 1)) << 3));
#pragma unroll
      for (int ni = 0; ni < 4; ++ni) {
        bf16x8 bq = *(const bf16x8*)(sB + 0 * (128 * 64) + (wn * 64 + ni * 16 + fr) * 64 + (((ks * 4 + fq) ^ (fr >> 1)) << 3));
#pragma unroll
        for (int mi = 0; mi < 4; ++mi)
          acc[mi][ni] = __builtin_amdgcn_mfma_f32_16x16x32_bf16(af[mi], bq, acc[mi][ni], 0, 0, 0);
      }
    }
    __builtin_amdgcn_s_setprio(0);
    *(uint4*)(sA + 1 * (128 * 64) + soff + 0) = a10;
    *(uint4*)(sB + 1 * (128 * 64) + soff + 0) = b10;
    *(uint4*)(sA + 1 * (128 * 64) + soff + 2048) = a11;
    *(uint4*)(sB + 1 * (128 * 64) + soff + 2048) = b11;
    *(uint4*)(sA + 1 * (128 * 64) + soff + 4096) = a12;
    *(uint4*)(sB + 1 * (128 * 64) + soff + 4096) = b12;
    *(uint4*)(sA + 1 * (128 * 64) + soff + 6144) = a13;
    *(uint4*)(sB + 1 * (128 * 64) + soff + 6144) = b13;
    __syncthreads();
    if (kt + 3 < nk) {
    a10 = *(const uint4*)(ap + (long)(0) * lda + (kt + 3) * 64);
    b10 = *(const uint4*)(bp + (long)(0) * ldb + (kt + 3) * 64);
    a11 = *(const uint4*)(ap + (long)(32) * lda + (kt + 3) * 64);
    b11 = *(const uint4*)(bp + (long)(32) * ldb + (kt + 3) * 64);
    a12 = *(const uint4*)(ap + (long)(64) * lda + (kt + 3) * 64);
    b12 = *(const uint4*)(bp + (long)(64) * ldb + (kt + 3) * 64);
    a13 = *(const uint4*)(ap + (long)(96) * lda + (kt + 3) * 64);
    b13 = *(const uint4*)(bp + (long)(96) * ldb + (kt + 3) * 64);
    }
    __builtin_amdgcn_s_setprio(1);
#pragma unroll
    for (int ks = 0; ks < 2; ++ks) {
      bf16x8 af[4];
#pragma unroll
      for (int mi = 0; mi < 4; ++mi)
        af[mi] = *(const bf16x8*)(sA + 1 * (128 * 64) + (wm * 64 + mi * 16 + fr) * 64 + (((ks * 4 + fq) ^ (fr >> 1)) << 3));
#pragma unroll
      for (int ni = 0; ni < 4; ++ni) {
        bf16x8 bq = *(const bf16x8*)(sB + 1 * (128 * 64) + (wn * 64 + ni * 16 + fr) * 64 + (((ks * 4 + fq) ^ (fr >> 1)) << 3));
#pragma unroll
        for (int mi = 0; mi < 4; ++mi)
          acc[mi][ni] = __builtin_amdgcn_mfma_f32_16x16x32_bf16(af[mi], bq, acc[mi][ni], 0, 0, 0);
      }
    }
    __builtin_amdgcn_s_setprio(0);
    if (kt + 2 < nk) {
    *(uint4*)(sA + 0 * (128 * 64) + soff + 0) = a00;
    *(uint4*)(sB + 0 * (128 * 64) + soff + 0) = b00;
    *(uint4*)(sA + 0 * (128 * 64) + soff + 2048) = a01;
    *(uint4*)(sB + 0 * (128 * 64) + soff + 2048) = b01;
    *(uint4*)(sA + 0 * (128 * 64) + soff + 4096) = a02;
    *(uint4*)(sB + 0 * (128 * 64) + soff + 4096) = b02;
    *(uint4*)(sA + 0 * (128 * 64) + soff + 6144) = a03;
    *(uint4*)(sB + 0 * (128 * 64) + soff + 6144) = b03;
    }
    __syncthreads();
  }
}

DI void mma_big(f32x4 (&acc)[4][8], const u16* __restrict__ A, const u16* __restrict__ Bt, u16* smem) {
  const int tid = threadIdx.x, lane = tid & 63, wid = tid >> 6, fr = lane & 15, fq = lane >> 4;
  u16* sA = smem;
  u16* sB = smem + 16384;
  uint4 a00, a01, a02, a03, a10, a11, a12, a13, b00, b01, b10, b11;
  const u16* ap = A + (long)(tid >> 2) * 1024 + (tid & 3) * 8;
  const u16* bp = Bt + (long)(tid >> 2) * 1024 + (tid & 3) * 8;
  const int soff = (tid >> 2) * 32 + ((((tid & 3) ^ ((0 - (tid >> 4)) & 3))) << 3);
  const int rpk = ((fq ^ ((0 - (fr >> 2)) & 3)) << 3);
  __syncthreads();
  {
    a00 = *(const uint4*)(ap + (long)(0) * 1024 + (0) * 32);
    a01 = *(const uint4*)(ap + (long)(64) * 1024 + (0) * 32);
    a02 = *(const uint4*)(ap + (long)(128) * 1024 + (0) * 32);
    a03 = *(const uint4*)(ap + (long)(192) * 1024 + (0) * 32);
    b00 = *(const uint4*)(bp + (long)(0) * 1024 + (0) * 32);
    b01 = *(const uint4*)(bp + (long)(64) * 1024 + (0) * 32);
    a10 = *(const uint4*)(ap + (long)(0) * 1024 + (1) * 32);
    a11 = *(const uint4*)(ap + (long)(64) * 1024 + (1) * 32);
    a12 = *(const uint4*)(ap + (long)(128) * 1024 + (1) * 32);
    a13 = *(const uint4*)(ap + (long)(192) * 1024 + (1) * 32);
    b10 = *(const uint4*)(bp + (long)(0) * 1024 + (1) * 32);
    b11 = *(const uint4*)(bp + (long)(64) * 1024 + (1) * 32);
    *(uint4*)(sA + 0 * 8192 + soff + 0) = a00;
    *(uint4*)(sA + 0 * 8192 + soff + 2048) = a01;
    *(uint4*)(sA + 0 * 8192 + soff + 4096) = a02;
    *(uint4*)(sA + 0 * 8192 + soff + 6144) = a03;
    *(uint4*)(sB + 0 * 4096 + soff + 0) = b00;
    *(uint4*)(sB + 0 * 4096 + soff + 2048) = b01;
  }
  __syncthreads();
  for (int kt = 0; kt < 32; kt += 2) {
    *(uint4*)(sA + 1 * 8192 + soff + 0) = a10;
    *(uint4*)(sA + 1 * 8192 + soff + 2048) = a11;
    *(uint4*)(sA + 1 * 8192 + soff + 4096) = a12;
    *(uint4*)(sA + 1 * 8192 + soff + 6144) = a13;
    *(uint4*)(sB + 1 * 4096 + soff + 0) = b10;
    *(uint4*)(sB + 1 * 4096 + soff + 2048) = b11;
    if (kt + 2 < 32) {
    a00 = *(const uint4*)(ap + (long)(0) * 1024 + (kt + 2) * 32);
    a01 = *(const uint4*)(ap + (long)(64) * 1024 + (kt + 2) * 32);
    a02 = *(const uint4*)(ap + (long)(128) * 1024 + (kt + 2) * 32);
    a03 = *(const uint4*)(ap + (long)(192) * 1024 + (kt + 2) * 32);
    b00 = *(const uint4*)(bp + (long)(0) * 1024 + (kt + 2) * 32);
    b01 = *(const uint4*)(bp + (long)(64) * 1024 + (kt + 2) * 32);
    a10 = *(const uint4*)(ap + (long)(0) * 1024 + (kt + 3) * 32);
    a11 = *(const uint4*)(ap + (long)(64) * 1024 + (kt + 3) * 32);
    a12 = *(const uint4*)(ap + (long)(128) * 1024 + (kt + 3) * 32);
    a13 = *(const uint4*)(ap + (long)(192) * 1024 + (kt + 3) * 32);
    b10 = *(const uint4*)(bp + (long)(0) * 1024 + (kt + 3) * 32);
    b11 = *(const uint4*)(bp + (long)(64) * 1024 + (kt + 3) * 32);
    }
    {
      bf16x8 af[4];
      __builtin_amdgcn_s_setprio(1);
#pragma unroll
      for (int mi = 0; mi < 4; ++mi) af[mi] = *(const bf16x8*)(sA + 0 * 8192 + (wid * 64 + mi * 16 + fr) * 32 + rpk);
#pragma unroll
      for (int ni = 0; ni < 8; ++ni) {
        bf16x8 bq = *(const bf16x8*)(sB + 0 * 4096 + (ni * 16 + fr) * 32 + rpk);
#pragma unroll
        for (int mi = 0; mi < 4; ++mi)
          acc[mi][ni] = __builtin_amdgcn_mfma_f32_16x16x32_bf16(af[mi], bq, acc[mi][ni], 0, 0, 0);
      }
      __builtin_amdgcn_s_setprio(0);
    }
    __syncthreads();
    {
      bf16x8 af[4];
      __builtin_amdgcn_s_setprio(1);
#pragma unroll
      for (int mi = 0; mi < 4; ++mi) af[mi] = *(const bf16x8*)(sA + 1 * 8192 + (wid * 64 + mi * 16 + fr) * 32 + rpk);
#pragma unroll
      for (int ni = 0; ni < 8; ++ni) {
        bf16x8 bq = *(const bf16x8*)(sB + 1 * 4096 + (ni * 16 + fr) * 32 + rpk);
#pragma unroll
        for (int mi = 0; mi < 4; ++mi)
          acc[mi][ni] = __builtin_amdgcn_mfma_f32_16x16x32_bf16(af[mi], bq, acc[mi][ni], 0, 0, 0);
      }
      __builtin_amdgcn_s_setprio(0);
    }
    if (kt + 2 < 32) {
    *(uint4*)(sA + 0 * 8192 + soff + 0) = a00;
    *(uint4*)(sA + 0 * 8192 + soff + 2048) = a01;
    *(uint4*)(sA + 0 * 8192 + soff + 4096) = a02;
    *(uint4*)(sA + 0 * 8192 + soff + 6144) = a03;
    *(uint4*)(sB + 0 * 4096 + soff + 0) = b00;
    *(uint4*)(sB + 0 * 4096 + soff + 2048) = b01;
    }
    __syncthreads();
  }
}
DI void mma_big3(f32x4 (&acc)[4][8], const u16* __restrict__ A, const u16* __restrict__ Bt, u16* smem) {
  const int tid = threadIdx.x, lane = tid & 63, wid = tid >> 6, fr = lane & 15, fq = lane >> 4;
  const int rpk = ((fq ^ ((0 - (fr >> 2)) & 3)) << 3);
  const int lrow = lane >> 2, lc = ((lane & 3) ^ ((0 - (lane >> 4)) & 3));
  const u16* ap = A + (long)(wid * 64 + lrow) * 1024 + lc * 8;
  const u16* bp = Bt + (long)(wid * 32 + lrow) * 1024 + lc * 8;
  char* lbase = (char*)smem;
  auto issue = [&](int kt, int buf) {
    char* la = lbase + buf * 24576 + wid * 4096;
    char* lb = lbase + buf * 24576 + 16384 + wid * 2048;
#pragma unroll
    for (int i = 0; i < 4; ++i)
      __builtin_amdgcn_global_load_lds((const unsigned*)(ap + (long)(16 * i) * 1024 + kt * 32), (unsigned __attribute__((address_space(3)))*)(la + i * 1024), 16, 0, 0);
#pragma unroll
    for (int i = 0; i < 2; ++i)
      __builtin_amdgcn_global_load_lds((const unsigned*)(bp + (long)(16 * i) * 1024 + kt * 32), (unsigned __attribute__((address_space(3)))*)(lb + i * 1024), 16, 0, 0);
  };
  __syncthreads();
  issue(0, 0);
  issue(1, 1);
  int cur = 0;
#pragma unroll 1
  for (int kt = 0; kt < 32; ++kt) {
    if (kt < 31) asm volatile("s_waitcnt vmcnt(6)" ::: "memory");
    else asm volatile("s_waitcnt vmcnt(0)" ::: "memory");
    asm volatile("s_waitcnt lgkmcnt(0)" ::: "memory");
    __builtin_amdgcn_s_barrier();
    if (kt + 2 < 32) {
      int nb = cur + 2;
      if (nb >= 3) nb -= 3;
      issue(kt + 2, nb);
    }
    const u16* sA = smem + cur * 12288;
    const u16* sB = sA + 8192;
    {
      bf16x8 af[4];
      __builtin_amdgcn_s_setprio(1);
#pragma unroll
      for (int mi = 0; mi < 4; ++mi) af[mi] = *(const bf16x8*)(sA + (wid * 64 + mi * 16 + fr) * 32 + rpk);
#pragma unroll
      for (int ni = 0; ni < 8; ++ni) {
        bf16x8 bq = *(const bf16x8*)(sB + (ni * 16 + fr) * 32 + rpk);
#pragma unroll
        for (int mi = 0; mi < 4; ++mi)
          acc[mi][ni] = __builtin_amdgcn_mfma_f32_16x16x32_bf16(af[mi], bq, acc[mi][ni], 0, 0, 0);
      }
      __builtin_amdgcn_s_setprio(0);
    }
    cur = cur + 1;
    if (cur == 3) cur = 0;
  }
  __syncthreads();
}

DI void zero_big(f32x4 (&acc)[4][8]) {
#pragma unroll
  for (int mi = 0; mi < 4; ++mi)
#pragma unroll
    for (int ni = 0; ni < 8; ++ni) acc[mi][ni] = f32x4{0.f, 0.f, 0.f, 0.f};
}
DI void big_to_lds(const f32x4 (&acc)[4][8], float* T, int h) {
  const int tid = threadIdx.x, lane = tid & 63, wid = tid >> 6, fr = lane & 15, fq = lane >> 4;
  if ((wid >> 1) != h) return;
#pragma unroll
  for (int mi = 0; mi < 4; ++mi)
#pragma unroll
    for (int ni = 0; ni < 8; ++ni)
#pragma unroll
      for (int j = 0; j < 4; ++j) T[((wid & 1) * 64 + mi * 16 + fq * 4 + j) * 132 + ni * 16 + fr] = acc[mi][ni][j];
}
DI void big_to_lds_T(const f32x4 (&acc)[4][8], float* T, int h) {
  const int tid = threadIdx.x, lane = tid & 63, wid = tid >> 6, fr = lane & 15, fq = lane >> 4;
  if ((wid >> 1) != h) return;
#pragma unroll
  for (int mi = 0; mi < 4; ++mi)
#pragma unroll
    for (int ni = 0; ni < 8; ++ni) *(f32x4*)(T + (ni * 16 + fr) * 132 + (wid & 1) * 64 + mi * 16 + fq * 4) = acc[mi][ni];
}
DI int tile_at_pad(int it, int MT, int NT, int& mt, int& nt) {
  const int G = gridDim.x >> 3, xcd = blockIdx.x & 7, lb = blockIdx.x >> 3;
  const int NT8 = NT >> 3, nst = ((MT + 7) >> 3) * NT8;
  const int f = it * G + lb;
  const int st = xcd + 8 * (f >> 6);
  if (st >= nst) return 0;
  const int w = f & 63;
  mt = (st / NT8) * 8 + (w >> 3);
  nt = (st % NT8) * 8 + (w & 7);
  return mt < MT ? 1 : 2;
}

DI void mma_glds128(f32x4 (&acc)[4][4], const u16* __restrict__ A, long lda, const u16* __restrict__ Bt, long ldb, int K, u16* smem) {
  const int tid = threadIdx.x, lane = tid & 63, wid = tid >> 6, wm = wid >> 1, wn = wid & 1, fr = lane & 15, fq = lane >> 4;
  u16* sA = smem;
  u16* sB = smem + 2 * 128 * 72;
  const int nk = K >> 6;
  typedef unsigned __attribute__((address_space(3))) lds_u32;
  auto issue = [&](int kt, int buf) {
#pragma unroll
    for (int i = 0; i < 4; ++i) {
      const int row = wid * 32 + i * 8 + (lane >> 3);
      const int lc = (lane & 7) ^ ((row >> 1) & 7);
      __builtin_amdgcn_global_load_lds((const unsigned*)(A + (long)row * lda + kt * 64 + lc * 8),
                                       (lds_u32*)(sA + buf * (128 * 64) + (wid * 32 + i * 8) * 64), 16, 0, 0);
      __builtin_amdgcn_global_load_lds((const unsigned*)(Bt + (long)row * ldb + kt * 64 + lc * 8),
                                       (lds_u32*)(sB + buf * (128 * 64) + (wid * 32 + i * 8) * 64), 16, 0, 0);
    }
  };
  __syncthreads();
  issue(0, 0);
  asm volatile("s_waitcnt vmcnt(0)" ::: "memory");
  __syncthreads();
  for (int kt = 0; kt < nk; ++kt) {
    const int cur = kt & 1;
    if (kt + 1 < nk) issue(kt + 1, cur ^ 1);
    __builtin_amdgcn_s_setprio(1);
#pragma unroll
    for (int ks = 0; ks < 2; ++ks) {
      bf16x8 af[4];
#pragma unroll
      for (int mi = 0; mi < 4; ++mi)
        af[mi] = *(const bf16x8*)(sA + cur * (128 * 64) + (wm * 64 + mi * 16 + fr) * 64 + (((ks * 4 + fq) ^ (fr >> 1)) << 3));
#pragma unroll
      for (int ni = 0; ni < 4; ++ni) {
        bf16x8 bq = *(const bf16x8*)(sB + cur * (128 * 64) + (wn * 64 + ni * 16 + fr) * 64 + (((ks * 4 + fq) ^ (fr >> 1)) << 3));
#pragma unroll
        for (int mi = 0; mi < 4; ++mi)
          acc[mi][ni] = __builtin_amdgcn_mfma_f32_16x16x32_bf16(af[mi], bq, acc[mi][ni], 0, 0, 0);
      }
    }
    __builtin_amdgcn_s_setprio(0);
    asm volatile("s_waitcnt vmcnt(0)" ::: "memory");
    __syncthreads();
  }
}

template <int NI>
DI void zero_acc(f32x4 (&acc)[4][NI]) {
#pragma unroll
  for (int mi = 0; mi < 4; ++mi)
#pragma unroll
    for (int ni = 0; ni < NI; ++ni) acc[mi][ni] = f32x4{0.f, 0.f, 0.f, 0.f};
}

DI void acc_to_lds(const f32x4 (&acc)[4][4], float* T) {
  const int tid = threadIdx.x, lane = tid & 63, wid = tid >> 6, wm = wid >> 1, wn = wid & 1, fr = lane & 15, fq = lane >> 4;
#pragma unroll
  for (int mi = 0; mi < 4; ++mi)
#pragma unroll
    for (int ni = 0; ni < 4; ++ni)
#pragma unroll
      for (int j = 0; j < 4; ++j) T[(wm * 64 + mi * 16 + fq * 4 + j) * 132 + wn * 64 + ni * 16 + fr] = acc[mi][ni][j];
}
DI void acc_to_lds_T(const f32x4 (&acc)[4][4], float* T) {
  const int tid = threadIdx.x, lane = tid & 63, wid = tid >> 6, wm = wid >> 1, wn = wid & 1, fr = lane & 15, fq = lane >> 4;
#pragma unroll
  for (int mi = 0; mi < 4; ++mi)
#pragma unroll
    for (int ni = 0; ni < 4; ++ni) *(f32x4*)(T + (wn * 64 + ni * 16 + fr) * 132 + wm * 64 + mi * 16 + fq * 4) = acc[mi][ni];
}
DI uint4 pack8(float4 a, float4 b) {
  uint4 o;
  o.x = pack2(a.x, a.y); o.y = pack2(a.z, a.w); o.z = pack2(b.x, b.y); o.w = pack2(b.z, b.w);
  return o;
}
DI void tile_store_bf16(const float* T, u16* dst, long ld) {
  const int tid = threadIdx.x;
#pragma unroll 1
  for (int i = 0; i < 8; ++i) {
    int idx = tid + i * 256;
    int r = idx >> 4, c0 = (idx & 15) * 8;
    float4 a = *(const float4*)(T + r * 132 + c0), b = *(const float4*)(T + r * 132 + c0 + 4);
    *(uint4*)(dst + (long)r * ld + c0) = pack8(a, b);
  }
}

template <int MODE>
DI void build_resident(u16* smem, const u16* __restrict__ A, long lda, const float* tab) {
  const int tid = threadIdx.x;
#pragma unroll 1
  for (int i = 0; i < 8; ++i) {
    int idx = tid + i * 256;
    int r = idx >> 4, c0 = (idx & 15) * 8;
    uint4 v = *(const uint4*)(A + (long)r * lda + c0);
    float s[8];
#pragma unroll
    for (int e = 0; e < 8; ++e) s[e] = MODE == 1 ? tab[r] : tab[c0 + e];
    uint4 o;
    o.x = pack2(lo2f(v.x) * s[0], hi2f(v.x) * s[1]);
    o.y = pack2(lo2f(v.y) * s[2], hi2f(v.y) * s[3]);
    o.z = pack2(lo2f(v.z) * s[4], hi2f(v.z) * s[5]);
    o.w = pack2(lo2f(v.w) * s[6], hi2f(v.w) * s[7]);
    *(uint4*)(smem + r * 144 + c0) = o;
  }
}

DI bool tile_at(int it, int MT, int NT, int& mt, int& nt) {
  const int G = gridDim.x >> 3, xcd = blockIdx.x & 7, lb = blockIdx.x >> 3;
  const int NT8 = NT >> 3, nst = (MT >> 3) * NT8;
  const int f = it * G + lb;
  const int st = xcd + 8 * (f >> 6);
  if (st >= nst) return false;
  const int w = f & 63;
  mt = (st / NT8) * 8 + (w >> 3);
  nt = (st % NT8) * 8 + (w & 7);
  return true;
}

DI void tr_items(const float* __restrict__ src, u16* __restrict__ dst, int K, int N, long nmat, long gtid,
                 long gstride) {
  const long per = (long)N * (K / 8);
  const long total = nmat * per;
  for (long i = gtid; i < total; i += gstride) {
    long mat = i / per;
    long r = i - mat * per;
    int k8 = (int)(r / N);
    int n = (int)(r - (long)k8 * N);
    const float* s = src + mat * (long)K * N + (long)k8 * 8 * N + n;
    uint4 o;
    o.x = pack2(s[0], s[(long)N]);
    o.y = pack2(s[2L * N], s[3L * N]);
    o.z = pack2(s[4L * N], s[5L * N]);
    o.w = pack2(s[6L * N], s[7L * N]);
    *(uint4*)(dst + mat * (long)K * N + (long)n * K + k8 * 8) = o;
  }
}
DI void cvt_items(const float* __restrict__ src, u16* __restrict__ dst, long n8, long gtid, long gstride) {
  for (long i = gtid; i < n8; i += gstride) {
    float4 a = *(const float4*)(src + i * 8);
    float4 b = *(const float4*)(src + i * 8 + 4);
    uint4 o;
    o.x = pack2(a.x, a.y);
    o.y = pack2(a.z, a.w);
    o.z = pack2(b.x, b.y);
    o.w = pack2(b.z, b.w);
    *(uint4*)(dst + i * 8) = o;
  }
}

DI void phase_prep(const Params& p, u16* smem) {
  const long gtid = (long)blockIdx.x * blockDim.x + threadIdx.x;
  const long gstride = (long)gridDim.x * blockDim.x;
  unsigned char* ws = p.ws;
  {
    float* mod = (float*)(ws + OFF_MOD);
    float* red = (float*)smem;
    const int tid = threadIdx.x;
    for (int it = blockIdx.x; it < 192; it += gridDim.x) {
      const int col = it * 32 + (tid & 31), ks = tid >> 5;
      float a0 = 0.f, a1 = 0.f, a2 = 0.f, a3 = 0.f, a4 = 0.f;
      for (int k = ks * 128; k < ks * 128 + 128; ++k) {
        float w = p.mod_w[(long)k * 6144 + col];
        a0 += siluf_(p.c[k]) * w;
        a1 += siluf_(p.c[1024 + k]) * w;
        a2 += siluf_(p.c[2048 + k]) * w;
        a3 += siluf_(p.c[3072 + k]) * w;
        a4 += siluf_(p.c_ctx[k]) * w;
      }
      __syncthreads();
      red[(ks * 5 + 0) * 32 + (tid & 31)] = a0;
      red[(ks * 5 + 1) * 32 + (tid & 31)] = a1;
      red[(ks * 5 + 2) * 32 + (tid & 31)] = a2;
      red[(ks * 5 + 3) * 32 + (tid & 31)] = a3;
      red[(ks * 5 + 4) * 32 + (tid & 31)] = a4;
      __syncthreads();
      if (tid < 160) {
        int r = tid >> 5, cc = tid & 31;
        float sum = p.mod_b[it * 32 + cc];
        for (int q = 0; q < 8; ++q) sum += red[(q * 5 + r) * 32 + cc];
        mod[r * 6144 + it * 32 + cc] = sum;
      }
    }
  }
  tr_items(p.w_in, (u16*)(ws + OFF_WTIN), 1024, INC, 1, gtid, gstride);
  tr_items(p.w_ret_out, (u16*)(ws + OFF_WTRO), 1024, 1024, 1, gtid, gstride);
  tr_items(p.w_lru_out, (u16*)(ws + OFF_WTLO), 1024, 1024, 1, gtid, gstride);
  tr_items(p.w_out, (u16*)(ws + OFF_WTO), 1024, 1024, 1, gtid, gstride);
  tr_items(p.peer_wq, (u16*)(ws + OFF_WTQ), 1024, 1024, 1, gtid, gstride);
  for (int d = 0; d < 2; ++d) {
    tr_items(p.lru_wa + (long)d * 8 * 16384, (u16*)(ws + OFF_WAT) + (long)(d * 2 + 0) * 8 * 16384, 128, 128, 8, gtid, gstride);
    tr_items(p.lru_wx + (long)d * 8 * 16384, (u16*)(ws + OFF_WAT) + (long)(d * 2 + 1) * 8 * 16384, 128, 128, 8, gtid, gstride);
  }
  cvt_items(p.peer_keys, (u16*)(ws + OFF_KEYS), 8L * 2 * 128 * 64 / 8, gtid, gstride);
  {
    const int lane = threadIdx.x & 63;
    const long gw = gtid >> 6, nw = gstride >> 6;
    for (long rr = gw; rr < 2L * 16384; rr += nw) {
      const int tb = (int)(rr >> 14);
      const long row = rr & 16383;
      const float* src = (tb ? p.peer_v : p.peer_u) + row * 1024 + lane * 16;
      float4 v0 = *(const float4*)(src), v1 = *(const float4*)(src + 4), v2 = *(const float4*)(src + 8), v3 = *(const float4*)(src + 12);
      float m = fmaxf(fmaxf(fmaxf(fabsf(v0.x), fabsf(v0.y)), fmaxf(fabsf(v0.z), fabsf(v0.w))),
                      fmaxf(fmaxf(fabsf(v1.x), fabsf(v1.y)), fmaxf(fabsf(v1.z), fabsf(v1.w))));
      m = fmaxf(m, fmaxf(fmaxf(fmaxf(fabsf(v2.x), fabsf(v2.y)), fmaxf(fabsf(v2.z), fabsf(v2.w))),
                         fmaxf(fmaxf(fabsf(v3.x), fabsf(v3.y)), fmaxf(fabsf(v3.z), fabsf(v3.w)))));
#pragma unroll
      for (int o = 32; o > 0; o >>= 1) m = fmaxf(m, __shfl_xor(m, o));
      m = fmaxf(m, 1e-30f);
      const float inv = 127.f / m;
      const int qoff = tb ? 128 : 0;
#define Q8(x) ((unsigned)((int)rintf((x) * inv) + qoff) & 0xffu)
      uint4 o;
      o.x = Q8(v0.x) | (Q8(v0.y) << 8) | (Q8(v0.z) << 16) | (Q8(v0.w) << 24);
      o.y = Q8(v1.x) | (Q8(v1.y) << 8) | (Q8(v1.z) << 16) | (Q8(v1.w) << 24);
      o.z = Q8(v2.x) | (Q8(v2.y) << 8) | (Q8(v2.z) << 16) | (Q8(v2.w) << 24);
      o.w = Q8(v3.x) | (Q8(v3.y) << 8) | (Q8(v3.z) << 16) | (Q8(v3.w) << 24);
#undef Q8
      *(uint4*)(ws + (tb ? OFF_VTAB : OFF_UT) + row * 1024 + lane * 16) = o;
      if (lane == 0) ((float*)(ws + (tb ? OFF_VSC : OFF_USC)))[row] = m * (1.f / 127.f);
    }
  }
}

DI void norm_row(const float* __restrict__ src, const float* __restrict__ g, const float* __restrict__ shift,
                 const float* __restrict__ scale, u16* __restrict__ dst, int lane) {
  float4 v[4];
  float ss = 0.f;
#pragma unroll
  for (int i = 0; i < 4; ++i) {
    v[i] = *(const float4*)(src + (i * 64 + lane) * 4);
    ss += v[i].x * v[i].x + v[i].y * v[i].y + v[i].z * v[i].z + v[i].w * v[i].w;
  }
  ss = wave_sum(ss);
  float rstd = rsqrtf(ss * (1.f / 1024.f) + EPSV);
#pragma unroll
  for (int i = 0; i < 4; ++i) {
    int c = (i * 64 + lane) * 4;
    float4 gg = *(const float4*)(g + c);
    float4 sh = *(const float4*)(shift + c);
    float4 sc = *(const float4*)(scale + c);
    float y0 = v[i].x * rstd * gg.x * (1.f + sc.x) + sh.x;
    float y1 = v[i].y * rstd * gg.y * (1.f + sc.y) + sh.y;
    float y2 = v[i].z * rstd * gg.z * (1.f + sc.z) + sh.z;
    float y3 = v[i].w * rstd * gg.w * (1.f + sc.w) + sh.w;
    uint2 o;
    o.x = pack2(y0, y1);
    o.y = pack2(y2, y3);
    *(uint2*)(dst + c) = o;
  }
}

DI void phase_norm1(const Params& p) {
  const int lane = threadIdx.x & 63;
  const long gw = ((long)blockIdx.x * blockDim.x + threadIdx.x) >> 6;
  const long nw = ((long)gridDim.x * blockDim.x) >> 6;
  const float* mod = (const float*)(p.ws + OFF_MOD);
  u16* hx = (u16*)(p.ws + OFF_HX);
  for (long r = gw; r < NROW; r += nw) {
    const float* src;
    int mr;
    if (r < NTOK) { src = p.x + r * 1024; mr = (int)(r / LS); }
    else { src = p.ctx + (r - NTOK) * 1024; mr = 4; }
    norm_row(src, p.norm1_g, mod + mr * 6144, mod + mr * 6144 + 1024, hx + r * 1024, lane);
  }
}
DI void phase_norm2(const Params& p) {
  const int lane = threadIdx.x & 63;
  const long gw = ((long)blockIdx.x * blockDim.x + threadIdx.x) >> 6;
  const long nw = ((long)gridDim.x * blockDim.x) >> 6;
  const float* mod = (const float*)(p.ws + OFF_MOD);
  u16* hx2 = (u16*)(p.ws + OFF_O);
  for (long r = gw; r < NTOK; r += nw) {
    int mr = (int)(r / LS);
    norm_row(p.out + r * 1024, p.norm2_g, mod + mr * 6144 + 3072, mod + mr * 6144 + 4096, hx2 + r * 1024, lane);
  }
}

DI void phase_gemm_a(const Params& p, u16* smem) {
  const int tid = threadIdx.x, lane = tid & 63, wid = tid >> 6, wm = wid >> 1, wn = wid & 1, fr = lane & 15, fq = lane >> 4;
  const u16* hx = (const u16*)(p.ws + OFF_HX);
  const u16* wt = (const u16*)(p.ws + OFF_WTIN);
  u16* Q = (u16*)(p.ws + OFF_Q);
  u16* Kb = (u16*)(p.ws + OFF_K);
  u16* KT = (u16*)(p.ws + OFF_KT);
  u16* VT = (u16*)(p.ws + OFF_VT);
  u16* P4 = (u16*)(p.ws + OFF_P4);
  int mt, nt;
  for (int it = 0; tile_at(it, NCHUNK, 24, mt, nt); ++it) {
    const int wrow0 = nt < 16 ? nt * 128 : 3072 + (nt - 16) * 128;
    const bool latent = mt < 256;
    if (!latent && nt < 4) continue;
    f32x4 acc[4][4];
    zero_acc(acc);
    mma_glds128(acc, hx + (long)mt * 128 * 1024, 1024, wt + (long)wrow0 * 1024, 1024, 1024, smem);
    const int b = latent ? mt / 64 : (mt - 256) / 2;
    const int tseq0 = latent ? (mt % 64) * 128 : ((mt - 256) % 2) * 128;
    const long row0 = (long)mt * 128;
    const int Lseq = latent ? LS : LCX;
    float* T = (float*)smem;
    if (nt < 8) {
      if (latent) {
#pragma unroll
        for (int mi = 0; mi < 4; ++mi)
#pragma unroll
          for (int j = 0; j < 4; ++j) {
            int tok = tseq0 + wm * 64 + mi * 16 + fq * 4 + j;
            float pos = (float)(wn == 0 ? (tok >> 6) : (tok & 63));
#pragma unroll
            for (int n2 = 0; n2 < 2; ++n2) {
              float f = (float)(n2 * 16 + fr);
              float inv = exp2f(-f * (13.287712379549449f / 32.f));
              float ang = pos * inv;
              float cs = __cosf(ang), sn = __sinf(ang);
              float u1 = acc[mi][n2][j], u2 = acc[mi][n2 + 2][j];
              acc[mi][n2][j] = u1 * cs - u2 * sn;
              acc[mi][n2 + 2][j] = u2 * cs + u1 * sn;
            }
          }
      }
      if (nt < 4) {
        acc_to_lds(acc, T);
        __syncthreads();
        tile_store_bf16(T, Q + row0 * 512 + nt * 128, 512);
      } else {
        const int h = nt - 4;
#pragma unroll
        for (int mi = 0; mi < 4; ++mi)
#pragma unroll
          for (int ni = 0; ni < 4; ++ni) acc[mi][ni] *= 0.08838834764831845f;
        acc_to_lds(acc, T);
        __syncthreads();
        tile_store_bf16(T, Kb + row0 * 512 + h * 128, 512);
        __syncthreads();
        acc_to_lds_T(acc, T);
        __syncthreads();
        u16* ktb = latent ? KT : KT + (size_t)4 * 512 * LS;
        tile_store_bf16(T, ktb + ((long)(b * 512 + h * 128)) * Lseq + tseq0, Lseq);
      }
    } else if (nt < 16) {
      acc_to_lds_T(acc, T);
      __syncthreads();
      u16* vtb = latent ? VT : VT + (size_t)4 * 1024 * LS;
      tile_store_bf16(T, vtb + ((long)(b * 1024 + (nt - 8) * 128)) * Lseq + tseq0, Lseq);
    } else {
      acc_to_lds(acc, T);
      __syncthreads();
      tile_store_bf16(T, P4 + row0 * 1024 + (nt - 16) * 128, 1024);
    }
  }
}

DI float log_gamma_of(const Params& p, int dir, int h) {
  float x = p.ret_decay[dir * 4 + h];
  return -softplusf_(-x);
}

DI void kv_item(const Params& p, int item, u16* smem, float* tabs) {
  const int tid = threadIdx.x;
  const int dvh = item & 1, cc = (item >> 1) % 66, bh = (item >> 1) / 66, h = bh & 3, b = bh >> 2;
  const float lgf = log_gamma_of(p, 0, h), lgb = log_gamma_of(p, 1, h);
  __syncthreads();
  if (tid < 128) {
    tabs[tid] = __expf(lgf * (float)(127 - tid));
    tabs[128 + tid] = __expf(lgb * (float)tid);
  }
  __syncthreads();
  const u16* KT = (const u16*)(p.ws + OFF_KT);
  const u16* VT = (const u16*)(p.ws + OFF_VT);
  const u16 *asrc, *bsrc;
  long ld;
  if (cc < 2) {
    asrc = VT + (size_t)4 * 1024 * LS + ((long)(b * 1024 + h * 256 + dvh * 128)) * LCX + cc * 128;
    bsrc = KT + (size_t)4 * 512 * LS + ((long)(b * 512 + h * 128)) * LCX + cc * 128;
    ld = LCX;
  } else {
    asrc = VT + ((long)(b * 1024 + h * 256 + dvh * 128)) * LS + (cc - 2) * 128;
    bsrc = KT + ((long)(b * 512 + h * 128)) * LS + (cc - 2) * 128;
    ld = LS;
  }
#pragma unroll 1
  for (int dir = 0; dir < 2; ++dir) {
    __syncthreads();
    build_resident<2>(smem, asrc, ld, tabs + dir * 128);
    f32x4 acc[4][4];
    zero_acc(acc);
    mma_loop<true>(acc, nullptr, 0, bsrc, ld, 128, smem, Ident{});
    const int bhd = (b * 4 + h) * 2 + dir;
    u16* dst = cc < 2 ? (u16*)(p.ws + OFF_KVC) + ((long)(bhd * 2 + cc)) * 32768 + dvh * 128 * 128
                      : (u16*)p.out + ((long)bhd * 64 + (cc - 2)) * 32768 + dvh * 128 * 128;
    acc_to_lds(acc, (float*)smem);
    __syncthreads();
    tile_store_bf16((const float*)smem, dst, 128);
  }
}

DI void state_scan(const Params& p) {
  const long gtid = (long)blockIdx.x * blockDim.x + threadIdx.x;
  const long gstride = (long)gridDim.x * blockDim.x;
  for (long idx = gtid; idx < 32L * 4096; idx += gstride) {
    const int e8 = (int)(idx & 4095), bhd = (int)(idx >> 12);
    const int dir = bhd & 1, h = (bhd >> 1) & 3;
    const float cd = __expf(log_gamma_of(p, dir, h) * 128.f);
    float acc[8];
#pragma unroll
    for (int e = 0; e < 8; ++e) acc[e] = 0.f;
    const u16* kvc = (const u16*)(p.ws + OFF_KVC) + (long)bhd * 2 * 32768 + e8 * 8;
#pragma unroll
    for (int s = 0; s < 2; ++s) {
      int cc = dir == 0 ? s : 1 - s;
      uint4 kv = *(const uint4*)(kvc + (long)cc * 32768);
      acc[0] = cd * acc[0] + lo2f(kv.x); acc[1] = cd * acc[1] + hi2f(kv.x);
      acc[2] = cd * acc[2] + lo2f(kv.y); acc[3] = cd * acc[3] + hi2f(kv.y);
      acc[4] = cd * acc[4] + lo2f(kv.z); acc[5] = cd * acc[5] + hi2f(kv.z);
      acc[6] = cd * acc[6] + lo2f(kv.w); acc[7] = cd * acc[7] + hi2f(kv.w);
    }
    u16* base = (u16*)p.out + (long)bhd * 64 * 32768 + e8 * 8;
    const long cstep = dir == 0 ? 32768 : -32768;
    u16* cur = base + (long)(dir == 0 ? 0 : 63) * 32768;
    uint4 k0 = *(const uint4*)(cur), k1 = *(const uint4*)(cur + cstep), k2 = *(const uint4*)(cur + 2 * cstep), k3 = *(const uint4*)(cur + 3 * cstep);
#define SCAN_STEP(KV, s)                                                                       \
    {                                                                                          \
      uint4 kv = KV;                                                                           \
      if ((s) + 4 < 64) KV = *(const uint4*)(cur + 4 * cstep);                                 \
      uint4 o;                                                                                 \
      o.x = pack2(acc[0], acc[1]); o.y = pack2(acc[2], acc[3]); o.z = pack2(acc[4], acc[5]); o.w = pack2(acc[6], acc[7]); \
      *(uint4*)(cur) = o;                                                                      \
      acc[0] = cd * acc[0] + lo2f(kv.x); acc[1] = cd * acc[1] + hi2f(kv.x);                    \
      acc[2] = cd * acc[2] + lo2f(kv.y); acc[3] = cd * acc[3] + hi2f(kv.y);                    \
      acc[4] = cd * acc[4] + lo2f(kv.z); acc[5] = cd * acc[5] + hi2f(kv.z);                    \
      acc[6] = cd * acc[6] + lo2f(kv.w); acc[7] = cd * acc[7] + hi2f(kv.w);                    \
      cur += cstep;                                                                            \
    }
#pragma unroll 1
    for (int s = 0; s < 64; s += 4) {
      SCAN_STEP(k0, s)
      SCAN_STEP(k1, s + 1)
      SCAN_STEP(k2, s + 2)
      SCAN_STEP(k3, s + 3)
    }
#undef SCAN_STEP
  }
}

DI float one_minus_exp(float x) {
  float ser = -x * (1.f + x * (0.5f + x * (0.16666667f + x * (0.041666668f + x * 0.008333334f))));
  return x > -0.25f ? ser : 1.f - __expf(x);
}

DI void lru_tile(const Params& p, int cid, int blk, int nh, int mode, u16* smem) {
  const int tid = threadIdx.x, lane = tid & 63, wid = tid >> 6, wm = wid >> 1, wn = wid & 1, fr = lane & 15, fq = lane >> 4;
  const u16* P4 = (const u16*)(p.ws + OFF_P4);
  const u16* WAT = (const u16*)(p.ws + OFF_WAT);
  float* LA = (float*)(p.ws + OFF_LA);
  float* LB = (float*)(p.ws + OFF_LB);
  const float* LH = (const float*)(p.ws + OFF_LH);
  u16* Y = (u16*)(p.ws + OFF_Y);
  const long r0 = (long)cid * 128;
  long seq_lo, seq_hi;
  if (cid < 256) { seq_lo = (long)(cid / 64) * LS; seq_hi = seq_lo + LS; }
  else { seq_lo = NTOK + (long)((cid - 256) / 2) * LCX; seq_hi = seq_lo + LCX; }
  __syncthreads();
  {
    const int cv = (tid & 15) * 8;
    const int chc = blk * 128 + cv;
    float cw[4][8], cb8[8];
    {
      float4 b0 = *(const float4*)(p.conv_b + chc), b1 = *(const float4*)(p.conv_b + chc + 4);
      cb8[0] = b0.x; cb8[1] = b0.y; cb8[2] = b0.z; cb8[3] = b0.w; cb8[4] = b1.x; cb8[5] = b1.y; cb8[6] = b1.z; cb8[7] = b1.w;
#pragma unroll
      for (int tap = 0; tap < 4; ++tap) {
        float4 w0 = *(const float4*)(p.conv_w + tap * 1024 + chc), w1 = *(const float4*)(p.conv_w + tap * 1024 + chc + 4);
        cw[tap][0] = w0.x; cw[tap][1] = w0.y; cw[tap][2] = w0.z; cw[tap][3] = w0.w;
        cw[tap][4] = w1.x; cw[tap][5] = w1.y; cw[tap][6] = w1.z; cw[tap][7] = w1.w;
      }
    }
#pragma unroll 4
    for (int i = 0; i < 8; ++i) {
      const int row = (tid >> 4) + i * 16;
      uint4 v[4];
#pragma unroll
      for (int tap = 0; tap < 4; ++tap) {
        long rr = r0 + row + tap - 2;
        v[tap] = (rr >= seq_lo && rr < seq_hi) ? *(const uint4*)(P4 + rr * 1024 + chc) : make_uint4(0u, 0u, 0u, 0u);
      }
      float u[8];
#pragma unroll
      for (int e = 0; e < 8; ++e) u[e] = cb8[e];
#pragma unroll
      for (int tap = 0; tap < 4; ++tap) {
        u[0] += lo2f(v[tap].x) * cw[tap][0]; u[1] += hi2f(v[tap].x) * cw[tap][1];
        u[2] += lo2f(v[tap].y) * cw[tap][2]; u[3] += hi2f(v[tap].y) * cw[tap][3];
        u[4] += lo2f(v[tap].z) * cw[tap][4]; u[5] += hi2f(v[tap].z) * cw[tap][5];
        u[6] += lo2f(v[tap].w) * cw[tap][6]; u[7] += hi2f(v[tap].w) * cw[tap][7];
      }
      uint4 o;
      o.x = pack2(u[0], u[1]); o.y = pack2(u[2], u[3]); o.z = pack2(u[4], u[5]); o.w = pack2(u[6], u[7]);
      *(uint4*)(smem + row * 144 + cv) = o;
    }
  }
  u16* sW = smem + 128 * 144;
  float* abuf = (float*)(smem + 128 * 144);
  float* bbuf = abuf + 64 * 65;
  float* sg = bbuf + 64 * 65;
  const int ch = tid & 63, sgi = tid >> 6;
  const long chg = (long)blk * 128 + nh * 64 + ch;
#pragma unroll 1
  for (int dir = 0; dir < 2; ++dir) {
    f32x4 acc[2][4][2];
    __syncthreads();
#pragma unroll 1
    for (int i0 = 0; i0 < 8; i0 += 4) {
      uint4 v[4];
#pragma unroll
      for (int i = 0; i < 4; ++i) {
        int c = tid + (i0 + i) * 256;
        int g = c >> 10, cc = c & 1023, row = cc >> 4, kc = (cc & 15) * 8;
        v[i] = *(const uint4*)(WAT + (long)((dir * 2 + g) * 8 + blk) * 16384 + (nh * 64 + row) * 128 + kc);
      }
#pragma unroll
      for (int i = 0; i < 4; ++i) {
        int c = tid + (i0 + i) * 256;
        int g = c >> 10, cc = c & 1023, row = cc >> 4, kc = (cc & 15) * 8;
        *(uint4*)(sW + g * (64 * 144) + row * 144 + kc) = v[i];
      }
    }
    __syncthreads();
#pragma unroll
    for (int g = 0; g < 2; ++g) {
      zero_acc(acc[g]);
#pragma unroll
      for (int ks = 0; ks < 4; ++ks) {
        bf16x8 af[4];
#pragma unroll
        for (int mi = 0; mi < 4; ++mi) af[mi] = *(const bf16x8*)(smem + (wm * 64 + mi * 16 + fr) * 144 + ks * 32 + fq * 8);
#pragma unroll
        for (int ni = 0; ni < 2; ++ni) {
          bf16x8 bq = *(const bf16x8*)(sW + g * (64 * 144) + (wn * 32 + ni * 16 + fr) * 144 + ks * 32 + fq * 8);
#pragma unroll
          for (int mi = 0; mi < 4; ++mi)
            acc[g][mi][ni] = __builtin_amdgcn_mfma_f32_16x16x32_bf16(af[mi], bq, acc[g][mi][ni], 0, 0, 0);
        }
      }
    }
#pragma unroll
    for (int ni = 0; ni < 2; ++ni) {
      int cl = wn * 32 + ni * 16 + fr;
      int chn = blk * 128 + nh * 64 + cl;
      float ba = p.lru_ba[dir * 1024 + chn], bx = p.lru_bx[dir * 1024 + chn];
      float spl = softplusf_(-p.lru_lambda[dir * 1024 + chn]);
#pragma unroll
      for (int mi = 0; mi < 4; ++mi)
#pragma unroll
        for (int j = 0; j < 4; ++j) {
          int r = wm * 64 + mi * 16 + fq * 4 + j;
          float rg = sigmoidf_(acc[0][mi][ni][j] + ba);
          float ig = sigmoidf_(acc[1][mi][ni][j] + bx);
          float la = -8.f * rg * spl;
          float a = __expf(la);
          float uu = bf2f(smem[r * 144 + nh * 64 + cl]);
          float x2 = 2.f * la;
          float ser = -x2 * (1.f + x2 * (0.5f + x2 * (0.16666667f + x2 * (0.041666668f + x2 * 0.008333334f))));
          float bt = __builtin_amdgcn_sqrtf(x2 > -0.25f ? ser : 1.f - a * a) * (ig * uu);
          acc[0][mi][ni][j] = a;
          acc[1][mi][ni][j] = bt;
        }
    }
    float cP = 1.f, cQ = 0.f;
    if (mode == 1) cQ = LH[((long)dir * NCHUNK + cid) * 1024 + chg];
#pragma unroll
    for (int half = 0; half < 2; ++half) {
      const int hw = dir == 0 ? half : 1 - half;
      __syncthreads();
      if (wm == hw) {
#pragma unroll
        for (int mi = 0; mi < 4; ++mi)
#pragma unroll
          for (int ni = 0; ni < 2; ++ni)
#pragma unroll
            for (int j = 0; j < 4; ++j) {
              int lr = mi * 16 + fq * 4 + j, cl = wn * 32 + ni * 16 + fr;
              abuf[lr * 65 + cl] = acc[0][mi][ni][j];
              bbuf[lr * 65 + cl] = acc[1][mi][ni][j];
            }
      }
      __syncthreads();
      {
        float P = 1.f, Q = 0.f;
#pragma unroll
        for (int s = 0; s < 16; ++s) {
          int pos = sgi * 16 + s;
          int lr = dir == 0 ? pos : 63 - pos;
          float a = abuf[lr * 65 + ch], bb = bbuf[lr * 65 + ch];
          P *= a;
          Q = a * Q + bb;
        }
        sg[(sgi * 64 + ch) * 2] = P;
        sg[(sgi * 64 + ch) * 2 + 1] = Q;
      }
      __syncthreads();
      if (mode == 0) {
#pragma unroll
        for (int k = 0; k < 4; ++k) {
          float pk = sg[(k * 64 + ch) * 2], qk = sg[(k * 64 + ch) * 2 + 1];
          cQ = pk * cQ + qk;
          cP *= pk;
        }
      } else {
        float h = cQ;
#pragma unroll
        for (int k = 0; k < 4; ++k) {
          float pk = sg[(k * 64 + ch) * 2], qk = sg[(k * 64 + ch) * 2 + 1];
          if (k < sgi) h = pk * h + qk;
          cQ = pk * cQ + qk;
        }
#pragma unroll
        for (int s = 0; s < 16; ++s) {
          int pos = sgi * 16 + s;
          int lr = dir == 0 ? pos : 63 - pos;
          float a = abuf[lr * 65 + ch], bb = bbuf[lr * 65 + ch];
          h = a * h + bb;
          bbuf[lr * 65 + ch] = h;
        }
        __syncthreads();
#pragma unroll 1
        for (int i = 0; i < 2; ++i) {
          int idx = tid + i * 256;
          int row = idx >> 3, c8 = (idx & 7) * 8;
          const float* hp = bbuf + row * 65 + c8;
          float4 h0 = make_float4(hp[0], hp[1], hp[2], hp[3]), h1 = make_float4(hp[4], hp[5], hp[6], hp[7]);
          u16* yp = Y + (r0 + hw * 64 + row) * 1024 + blk * 128 + nh * 64 + c8;
          if (dir == 1) {
            uint4 y = *(const uint4*)yp;
            h0.x += lo2f(y.x); h0.y += hi2f(y.x); h0.z += lo2f(y.y); h0.w += hi2f(y.y);
            h1.x += lo2f(y.z); h1.y += hi2f(y.z); h1.z += lo2f(y.w); h1.w += hi2f(y.w);
          }
          *(uint4*)yp = pack8(h0, h1);
        }
      }
    }
    if (mode == 0 && sgi == 0) {
      LA[((long)dir * NCHUNK + cid) * 1024 + chg] = cP;
      LB[((long)dir * NCHUNK + cid) * 1024 + chg] = cQ;
    }
  }
}

DI void phase3(const Params& p, u16* smem, float* tabs) {
#ifndef REP_SUB
#define REP_SUB 0
#endif
  for (int rep = 0; rep <= (REP_SUB & 1); ++rep)
    for (int t = blockIdx.x; t < 2112; t += gridDim.x) kv_item(p, t, smem, tabs);
  for (int rep = 0; rep <= ((REP_SUB >> 1) & 1); ++rep)
    for (int u = blockIdx.x; u < NCHUNK * 16; u += gridDim.x) lru_tile(p, u >> 4, (u >> 1) & 7, u & 1, 0, smem);
}

DI void lru_cross(const Params& p) {
  const long gtid = (long)blockIdx.x * blockDim.x + threadIdx.x;
  if (gtid >= 8192) return;
  const int ch = (int)(gtid & 1023), b = (int)((gtid >> 10) & 3), dir = (int)(gtid >> 12);
  const float* LA = (const float*)(p.ws + OFF_LA) + (long)dir * NCHUNK * 1024;
  const float* LB = (const float*)(p.ws + OFF_LB) + (long)dir * NCHUNK * 1024;
  float* LH = (float*)(p.ws + OFF_LH) + (long)dir * NCHUNK * 1024;
  float h = 0.f;
  for (int s = 0; s < 2; ++s) {
    int cid = 256 + b * 2 + (dir == 0 ? s : 1 - s);
    h = LA[(long)cid * 1024 + ch] * h + LB[(long)cid * 1024 + ch];
  }
  for (int s = 0; s < 64; ++s) {
    int cid = b * 64 + (dir == 0 ? s : 63 - s);
    LH[(long)cid * 1024 + ch] = h;
    h = LA[(long)cid * 1024 + ch] * h + LB[(long)cid * 1024 + ch];
  }
}

DI void ret_out_item(const Params& p, int item, u16* smem, float* tabs) {
  const int tid = threadIdx.x, lane = tid & 63, wid = tid >> 6, wm = wid >> 1, wn = wid & 1, fr = lane & 15, fq = lane >> 4;
  const int half = item & 1, c = (item >> 1) & 63, h = (item >> 7) & 3, b = item >> 9;
  const float lgf = log_gamma_of(p, 0, h), lgb = log_gamma_of(p, 1, h);
  __syncthreads();
  for (int i = tid; i < 129; i += 256) {
    tabs[i] = __expf(lgf * (float)i);
    tabs[129 + i] = __expf(lgb * (float)i);
  }
  if (tid < 128) {
    tabs[258 + tid] = __expf(lgf * (float)(tid + 1));
    tabs[386 + tid] = __expf(lgb * (float)(128 - tid));
  }
  __syncthreads();
  const u16* Q = (const u16*)(p.ws + OFF_Q);
  const u16* Kb = (const u16*)(p.ws + OFF_K);
  const u16* VT = (const u16*)(p.ws + OFF_VT);
  const u16* ST = (const u16*)p.out;
  u16* O = (u16*)(p.ws + OFF_O);
  float* STATS = (float*)(p.ws + OFF_STATS);
  const long row0 = ((long)b * 64 + c) * 128;
  f32x4 ao[4][4];
  zero_acc(ao);
  mma_loop<false>(ao, Q + row0 * 512 + h * 128, 512, Kb + row0 * 512 + h * 128, 512, 128, smem, Ident{});
  const float ddbase = (float)(wm * 64 - wn * 64 + fq * 4 - fr);
#pragma unroll
  for (int mi = 0; mi < 4; ++mi)
#pragma unroll
    for (int ni = 0; ni < 4; ++ni)
#pragma unroll
      for (int j = 0; j < 4; ++j) {
        int i = wm * 64 + mi * 16 + fq * 4 + j, jj = wn * 64 + ni * 16 + fr;
        float dd = ddbase + (float)((mi - ni) * 16 + j);
        float d = __expf(dd >= 0.f ? lgf * dd : -lgb * dd);
        smem[i * 144 + jj] = f2bf(ao[mi][ni][j] * d);
      }
  zero_acc(ao);
#pragma unroll 1
  for (int seg = 0; seg < 3; ++seg) {
    const u16* Bt;
    long ldb;
    if (seg == 0) {
      Bt = VT + ((long)(b * 1024 + h * 256 + half * 128)) * LS + c * 128;
      ldb = LS;
    } else {
      const int dir = seg - 1;
      build_resident<1>(smem, Q + row0 * 512 + h * 128, 512, tabs + 258 + dir * 128);
      Bt = ST + ((((long)(b * 4 + h) * 2 + dir) * 64 + c) * 256 + half * 128) * 128;
      ldb = 128;
    }
    mma_loop<true>(ao, nullptr, 0, Bt, ldb, 128, smem, Ident{});
  }
  float* T = (float*)smem;
  acc_to_lds(ao, T);
  __syncthreads();
#pragma unroll 1
  for (int i = 0; i < 8; ++i) {
    int idx = tid + i * 256;
    int r = idx >> 4, c0 = (idx & 15) * 8;
    float4 a = *(const float4*)(T + r * 132 + c0), bq = *(const float4*)(T + r * 132 + c0 + 4);
    uint4 o = pack8(a, bq);
    *(uint4*)(O + (row0 + r) * 1024 + h * 256 + half * 128 + c0) = o;
    float v0 = lo2f(o.x), v1 = hi2f(o.x), v2 = lo2f(o.y), v3 = hi2f(o.y), v4 = lo2f(o.z), v5 = hi2f(o.z), v6 = lo2f(o.w), v7 = hi2f(o.w);
    float s1 = v0 + v1 + v2 + v3 + v4 + v5 + v6 + v7;
    float s2 = v0 * v0 + v1 * v1 + v2 * v2 + v3 * v3 + v4 * v4 + v5 * v5 + v6 * v6 + v7 * v7;
#pragma unroll
    for (int o2 = 1; o2 < 16; o2 <<= 1) {
      s1 += __shfl_xor(s1, o2);
      s2 += __shfl_xor(s2, o2);
    }
    if ((idx & 15) == 0) {
      float* st = STATS + ((row0 + r) * 4 + h) * 4 + half * 2;
      st[0] = s1;
      st[1] = s2;
    }
  }
}

DI void phase4(const Params& p) {
  lru_cross(p);
  state_scan(p);
}

DI void phase5(const Params& p, u16* smem, float* tabs) {
  for (int rep = 0; rep <= ((REP_SUB >> 2) & 1); ++rep)
    for (int t = blockIdx.x; t < 2048; t += gridDim.x) ret_out_item(p, t, smem, tabs);
  for (int rep = 0; rep <= ((REP_SUB >> 3) & 1); ++rep)
    for (int u = blockIdx.x; u < 256 * 16; u += gridDim.x) lru_tile(p, u >> 4, (u >> 1) & 7, u & 1, 1, smem);
}

DI void phase_gemm_b(const Params& p, u16* smem) {
  const int tid = threadIdx.x, lane = tid & 63, wid = tid >> 6, wm = wid >> 1, wn = wid & 1, fr = lane & 15, fq = lane >> 4;
  const u16* hx = (const u16*)(p.ws + OFF_HX);
  const u16* wt = (const u16*)(p.ws + OFF_WTIN);
  u16* O = (u16*)(p.ws + OFF_O);
  u16* Y = (u16*)(p.ws + OFF_Y);
  u16* S6 = (u16*)(p.ws + OFF_VT);
  u16* S7 = (u16*)(p.ws + OFF_P4);
  int mt2, nt;
  for (int it = 0; tile_at(it, 128, 32, mt2, nt); ++it) {
    const int seg = nt >> 3;
    const int wrow0 = (seg == 0 ? 2048 : 4096 + (seg - 1) * 1024) + (nt & 7) * 128;
    f32x4 acc[4][8];
    zero_big(acc);
    mma_big3(acc, hx + (long)mt2 * 256 * 1024, wt + (long)wrow0 * 1024, smem);
    u16* dst = seg == 0 ? O : (seg == 1 ? Y : (seg == 2 ? S6 : S7));
    const float* STATS = (const float*)(p.ws + OFF_STATS);
    float* T = (float*)smem;
#pragma unroll 1
   for (int h = 0; h < 2; ++h) {
    const long row0 = (long)(mt2 * 2 + h) * 128;
    __syncthreads();
    big_to_lds(acc, T, h);
    __syncthreads();
#pragma unroll 1
    for (int i = 0; i < 8; ++i) {
      int idx = tid + i * 256;
      int r = idx >> 4, c0 = (idx & 15) * 8;
      float v[8];
      {
        float4 a = *(const float4*)(T + r * 132 + c0), bq = *(const float4*)(T + r * 132 + c0 + 4);
        v[0] = a.x; v[1] = a.y; v[2] = a.z; v[3] = a.w; v[4] = bq.x; v[5] = bq.y; v[6] = bq.z; v[7] = bq.w;
      }
      long ad = (row0 + r) * 1024 + (nt & 7) * 128 + c0;
      float o[8];
      if (seg >= 2) {
#pragma unroll
        for (int e = 0; e < 8; ++e) o[e] = sigmoidf_(v[e]);
      } else {
        uint4 d = *(const uint4*)(dst + ad);
        float dv[8] = {lo2f(d.x), hi2f(d.x), lo2f(d.y), hi2f(d.y), lo2f(d.z), hi2f(d.z), lo2f(d.w), hi2f(d.w)};
        if (seg == 0) {
          float4 st = *(const float4*)(STATS + ((row0 + r) * 4 + ((nt & 7) >> 1)) * 4);
          float mu = (st.x + st.z) * (1.f / 256.f);
          float var = fmaxf((st.y + st.w) * (1.f / 256.f) - mu * mu, 0.f);
          float rstd = rsqrtf(var + EPSV);
#pragma unroll
          for (int e = 0; e < 8; ++e) o[e] = (dv[e] - mu) * rstd * siluf_(v[e]);
        } else {
#pragma unroll
          for (int e = 0; e < 8; ++e) o[e] = dv[e] * geluf_(v[e]);
        }
      }
      uint4 ov;
      ov.x = pack2(o[0], o[1]); ov.y = pack2(o[2], o[3]); ov.z = pack2(o[4], o[5]); ov.w = pack2(o[6], o[7]);
      *(uint4*)(dst + ad) = ov;
    }
   }
  }
}

DI void phase_gemm_c(const Params& p, u16* smem) {
  const int tid = threadIdx.x, lane = tid & 63, wid = tid >> 6, wm = wid >> 1, wn = wid & 1, fr = lane & 15, fq = lane >> 4;
  const u16* A3 = (const u16*)(p.ws + OFF_O);
  const u16* A5 = (const u16*)(p.ws + OFF_Y);
  const u16* S6 = (const u16*)(p.ws + OFF_VT);
  const u16* S7 = (const u16*)(p.ws + OFF_P4);
  const u16* wro = (const u16*)(p.ws + OFF_WTRO);
  const u16* wlo = (const u16*)(p.ws + OFF_WTLO);
  u16* YM = (u16*)(p.ws + OFF_HX);
  int mt2, nt;
  for (int it = 0; tile_at(it, 128, 8, mt2, nt); ++it) {
    f32x4 a1[4][8];
    float* T = (float*)smem;
    zero_big(a1);
    mma_big3(a1, A3 + (long)mt2 * 256 * 1024, wro + (long)nt * 128 * 1024, smem);
#pragma unroll 1
    for (int h = 0; h < 2; ++h) {
      const long row0 = (long)(mt2 * 2 + h) * 128;
      __syncthreads();
      big_to_lds(a1, T, h);
      __syncthreads();
#pragma unroll 1
      for (int i = 0; i < 8; ++i) {
        int idx = tid + i * 256;
        int r = idx >> 4, c0 = (idx & 15) * 8;
        float4 a = *(const float4*)(T + r * 132 + c0), bq = *(const float4*)(T + r * 132 + c0 + 4);
        long ad = (row0 + r) * 1024 + nt * 128 + c0;
        uint4 g = *(const uint4*)(S6 + ad);
        a.x *= lo2f(g.x); a.y *= hi2f(g.x); a.z *= lo2f(g.y); a.w *= hi2f(g.y);
        bq.x *= lo2f(g.z); bq.y *= hi2f(g.z); bq.z *= lo2f(g.w); bq.w *= hi2f(g.w);
        *(uint4*)(YM + ad) = pack8(a, bq);
      }
    }
    zero_big(a1);
    mma_big3(a1, A5 + (long)mt2 * 256 * 1024, wlo + (long)nt * 128 * 1024, smem);
#pragma unroll 1
    for (int h = 0; h < 2; ++h) {
      const long row0 = (long)(mt2 * 2 + h) * 128;
      __syncthreads();
      big_to_lds(a1, T, h);
      __syncthreads();
#pragma unroll 1
      for (int i = 0; i < 8; ++i) {
        int idx = tid + i * 256;
        int r = idx >> 4, c0 = (idx & 15) * 8;
        float4 a = *(const float4*)(T + r * 132 + c0), bq = *(const float4*)(T + r * 132 + c0 + 4);
        long ad = (row0 + r) * 1024 + nt * 128 + c0;
        uint4 g = *(const uint4*)(S7 + ad);
        uint4 y = *(const uint4*)(YM + ad);
        a.x = lo2f(y.x) + a.x * lo2f(g.x); a.y = hi2f(y.x) + a.y * hi2f(g.x); a.z = lo2f(y.y) + a.z * lo2f(g.y); a.w = hi2f(y.y) + a.w * hi2f(g.y);
        bq.x = lo2f(y.z) + bq.x * lo2f(g.z); bq.y = hi2f(y.z) + bq.y * hi2f(g.z); bq.z = lo2f(y.w) + bq.z * lo2f(g.w); bq.w = hi2f(y.w) + bq.w * hi2f(g.w);
        *(uint4*)(YM + ad) = pack8(a, bq);
      }
    }
  }
}

DI void phase_gemm_d(const Params& p, u16* smem) {
  const int tid = threadIdx.x, lane = tid & 63, wid = tid >> 6, wm = wid >> 1, wn = wid & 1, fr = lane & 15, fq = lane >> 4;
  const u16* YM = (const u16*)(p.ws + OFF_HX);
  const u16* wo = (const u16*)(p.ws + OFF_WTO);
  const float* mod = (const float*)(p.ws + OFF_MOD);
  int mt2, nt;
  for (int it = 0; tile_at(it, 128, 8, mt2, nt); ++it) {
    const int b = mt2 / 32;
    f32x4 acc[4][8];
    zero_big(acc);
    mma_big3(acc, YM + (long)mt2 * 256 * 1024, wo + (long)nt * 128 * 1024, smem);
    float* T = (float*)smem;
#pragma unroll 1
   for (int h = 0; h < 2; ++h) {
    const long row0 = (long)(mt2 * 2 + h) * 128;
    __syncthreads();
    big_to_lds(acc, T, h);
    __syncthreads();
#pragma unroll 1
    for (int i = 0; i < 8; ++i) {
      int idx = tid + i * 256;
      int r = idx >> 4, c0 = (idx & 15) * 8;
      float4 a = *(const float4*)(T + r * 132 + c0), bq = *(const float4*)(T + r * 132 + c0 + 4);
      long ad = (row0 + r) * 1024 + nt * 128 + c0;
      float4 ga = *(const float4*)(mod + b * 6144 + 2048 + nt * 128 + c0), gb = *(const float4*)(mod + b * 6144 + 2048 + nt * 128 + c0 + 4);
      float4 xa = *(const float4*)(p.x + ad), xb = *(const float4*)(p.x + ad + 4);
      a.x = xa.x + ga.x * a.x; a.y = xa.y + ga.y * a.y; a.z = xa.z + ga.z * a.z; a.w = xa.w + ga.w * a.w;
      bq.x = xb.x + gb.x * bq.x; bq.y = xb.y + gb.y * bq.y; bq.z = xb.z + gb.z * bq.z; bq.w = xb.w + gb.w * bq.w;
      *(float4*)(p.out + ad) = a;
      *(float4*)(p.out + ad + 4) = bq;
    }
   }
  }
}

DI void phase_gemm_e(const Params& p, u16* smem) {
  const int tid = threadIdx.x, lane = tid & 63, wid = tid >> 6, wm = wid >> 1, wn = wid & 1, fr = lane & 15, fq = lane >> 4;
  const u16* HX2 = (const u16*)(p.ws + OFF_O);
  const u16* wq = (const u16*)(p.ws + OFF_WTQ);
  u16* QP = (u16*)(p.ws + OFF_Q);
  int mt2, nt;
  for (int it = 0; tile_at(it, 128, 8, mt2, nt); ++it) {
    f32x4 acc[4][8];
    zero_big(acc);
    mma_big3(acc, HX2 + (long)mt2 * 256 * 1024, wq + (long)nt * 128 * 1024, smem);
#pragma unroll 1
    for (int h = 0; h < 2; ++h) {
      const long row0 = (long)(mt2 * 2 + h) * 128;
      __syncthreads();
      big_to_lds(acc, (float*)smem, h);
      __syncthreads();
      tile_store_bf16((const float*)smem, QP + row0 * 1024 + nt * 128, 1024);
    }
  }
}

DI void ins16(float (&L)[16], float v) {
#pragma unroll
  for (int j = 15; j >= 1; --j) L[j] = __builtin_amdgcn_fmed3f(L[j - 1], L[j], v);
  L[0] = fmaxf(L[0], v);
}

DI void phase_peer_topk(const Params& p, u16* smem) {
  const int tid = threadIdx.x, lane = tid & 63, wid = tid >> 6, wm = wid >> 1, wn = wid & 1, fr = lane & 15, fq = lane >> 4;
  const u16* QP = (const u16*)(p.ws + OFF_Q);
  const u16* KEYS = (const u16*)(p.ws + OFF_KEYS);
  int* PIDX = (int*)(p.ws + OFF_KT);
  float* PG = (float*)(p.ws + OFF_KT + (size_t)NTOK * 128 * 4);
  float* sc = (float*)smem;
  const float NINF = -__builtin_inff();
  int mt, h;
  for (int it = 0; tile_at(it, 256, 8, mt, h); ++it) {
    const long row0 = (long)mt * 128;
    float L1[16], L2[16];
#pragma unroll
    for (int j = 0; j < 16; ++j) { L1[j] = NINF; L2[j] = NINF; }
#pragma unroll
    for (int ph = 0; ph < 2; ++ph) {
      f32x4 acc[4][4];
      zero_acc(acc);
      mma_loop<false>(acc, QP + row0 * 1024 + h * 128 + ph * 64, 1024, KEYS + (long)((h * 2 + ph) * 128) * 64, 64, 64, smem, Ident{});
#pragma unroll
      for (int mi = 0; mi < 4; ++mi)
#pragma unroll
        for (int ni = 0; ni < 4; ++ni)
#pragma unroll
          for (int j = 0; j < 4; ++j) {
            int r = wm * 64 + mi * 16 + fq * 4 + j, cl = wn * 64 + ni * 16 + fr;
            sc[r * 129 + cl] = acc[mi][ni][j];
          }
      __syncthreads();
      {
        const int row = tid & 127, kh = tid >> 7;
        float Lt[16];
#pragma unroll
        for (int j = 0; j < 16; ++j) Lt[j] = NINF;
        for (int kk = 0; kk < 64; ++kk) {
          const int k = kh * 64 + kk;
          float v = sc[row * 129 + k];
          v = __uint_as_float((__float_as_uint(v) & ~0x7Fu) | (unsigned)k);
          ins16(Lt, v);
        }
        if (kh == 1) {
#pragma unroll
          for (int j = 0; j < 16; ++j) sc[row * 129 + 64 + j] = Lt[j];
        }
        __syncthreads();
        if (kh == 0) {
#pragma unroll
          for (int j = 0; j < 16; ++j) ins16(Lt, sc[row * 129 + 64 + j]);
#pragma unroll
          for (int j = 0; j < 16; ++j) {
            if (ph == 0) L1[j] = Lt[j];
            else L2[j] = Lt[j];
          }
        }
      }
    }
    if (tid < 128) {
      int* myrow = (int*)(sc + tid * 129);
      float C[16];
#pragma unroll
      for (int j = 0; j < 16; ++j) {
        C[j] = NINF;
        myrow[j] = (int)(__float_as_uint(L1[j]) & 0x7Fu);
        myrow[16 + j] = (int)(__float_as_uint(L2[j]) & 0x7Fu);
      }
#pragma unroll
      for (int a = 0; a < 16; ++a)
#pragma unroll
        for (int b = 0; b < 16; ++b)
          if ((a + 1) * (b + 1) <= 16) {
            float s = __uint_as_float(__float_as_uint(L1[a]) & ~0x7Fu) + __uint_as_float(__float_as_uint(L2[b]) & ~0x7Fu);
            s = __uint_as_float((__float_as_uint(s) & ~0xFFu) | (unsigned)(a * 16 + b));
            ins16(C, s);
          }
      float m = __uint_as_float(__float_as_uint(C[0]) & ~0xFFu);
      float w[16];
      float sum = 0.f;
#pragma unroll
      for (int k = 0; k < 16; ++k) {
        w[k] = __expf(__uint_as_float(__float_as_uint(C[k]) & ~0xFFu) - m);
        sum += w[k];
      }
      float rs = 1.f / sum;
      long base = (row0 + tid) * 128 + h * 16;
#pragma unroll
      for (int k = 0; k < 16; ++k) {
        unsigned ab = __float_as_uint(C[k]) & 0xFFu;
        int e = myrow[ab >> 4] * 128 + myrow[16 + (ab & 15)];
        PIDX[base + k] = e;
        PG[base + k] = w[k] * rs;
      }
    }
  }
}

DI float dotq16(uint4 q, const float* x) {
  float s = 0.f;
  s += (float)(q.x & 0xffu) * x[0] + (float)((q.x >> 8) & 0xffu) * x[1] + (float)((q.x >> 16) & 0xffu) * x[2] + (float)(q.x >> 24) * x[3];
  s += (float)(q.y & 0xffu) * x[4] + (float)((q.y >> 8) & 0xffu) * x[5] + (float)((q.y >> 16) & 0xffu) * x[6] + (float)(q.y >> 24) * x[7];
  s += (float)(q.z & 0xffu) * x[8] + (float)((q.z >> 8) & 0xffu) * x[9] + (float)((q.z >> 16) & 0xffu) * x[10] + (float)(q.z >> 24) * x[11];
  s += (float)(q.w & 0xffu) * x[12] + (float)((q.w >> 8) & 0xffu) * x[13] + (float)((q.w >> 16) & 0xffu) * x[14] + (float)(q.w >> 24) * x[15];
  return s;
}
DI void axpyq16(float* o, float c, uint4 q) {
  o[0] += c * (float)(q.x & 0xffu); o[1] += c * (float)((q.x >> 8) & 0xffu); o[2] += c * (float)((q.x >> 16) & 0xffu); o[3] += c * (float)(q.x >> 24);
  o[4] += c * (float)(q.y & 0xffu); o[5] += c * (float)((q.y >> 8) & 0xffu); o[6] += c * (float)((q.y >> 16) & 0xffu); o[7] += c * (float)(q.y >> 24);
  o[8] += c * (float)(q.z & 0xffu); o[9] += c * (float)((q.z >> 8) & 0xffu); o[10] += c * (float)((q.z >> 16) & 0xffu); o[11] += c * (float)(q.z >> 24);
  o[12] += c * (float)(q.w & 0xffu); o[13] += c * (float)((q.w >> 8) & 0xffu); o[14] += c * (float)((q.w >> 16) & 0xffu); o[15] += c * (float)(q.w >> 24);
}

template <int MODE>
DI void phase_peer_gather(const Params& p, float* outp) {
  const int lane = threadIdx.x & 63;
  const long gw = ((long)blockIdx.x * blockDim.x + threadIdx.x) >> 6;
  const long nw = ((long)gridDim.x * blockDim.x) >> 6;
  const u16* HX2 = (const u16*)(p.ws + OFF_O);
  const unsigned char* UT = p.ws + OFF_UT;
  const unsigned char* VTAB = p.ws + OFF_VTAB;
  const float* USC = (const float*)(p.ws + OFF_USC);
  const float* VSC = (const float*)(p.ws + OFF_VSC);
  const int* PIDX = (const int*)(p.ws + OFF_KT);
  const float* PG = (const float*)(p.ws + OFF_KT + (size_t)NTOK * 128 * 4);
  const float* mod = (const float*)(p.ws + OFF_MOD);
  for (long t = gw; t < NTOK; t += nw) {
    float x[16];
    float xl = 0.f;
    {
      uint4 v0 = *(const uint4*)(HX2 + t * 1024 + lane * 16);
      uint4 v1 = *(const uint4*)(HX2 + t * 1024 + lane * 16 + 8);
      x[0] = lo2f(v0.x); x[1] = hi2f(v0.x); x[2] = lo2f(v0.y); x[3] = hi2f(v0.y);
      x[4] = lo2f(v0.z); x[5] = hi2f(v0.z); x[6] = lo2f(v0.w); x[7] = hi2f(v0.w);
      x[8] = lo2f(v1.x); x[9] = hi2f(v1.x); x[10] = lo2f(v1.y); x[11] = hi2f(v1.y);
      x[12] = lo2f(v1.z); x[13] = hi2f(v1.z); x[14] = lo2f(v1.w); x[15] = hi2f(v1.w);
#pragma unroll
      for (int i = 0; i < 16; ++i) xl += x[i];
    }
    float xm = 0.f;
#pragma unroll
    for (int i = 0; i < 16; ++i) xm = fmaxf(xm, fabsf(x[i]));
#pragma unroll
    for (int o = 32; o > 0; o >>= 1) xm = fmaxf(xm, __shfl_xor(xm, o));
    xm = fmaxf(xm, 1e-30f);
    const float xinv = 127.f / xm, xsc = xm * (1.f / 127.f);
    int xq[4];
#pragma unroll
    for (int w = 0; w < 4; ++w) {
      unsigned b0 = (unsigned)((int)rintf(x[w * 4 + 0] * xinv)) & 0xffu, b1 = (unsigned)((int)rintf(x[w * 4 + 1] * xinv)) & 0xffu;
      unsigned b2 = (unsigned)((int)rintf(x[w * 4 + 2] * xinv)) & 0xffu, b3 = (unsigned)((int)rintf(x[w * 4 + 3] * xinv)) & 0xffu;
      xq[w] = (int)(b0 | (b1 << 8) | (b2 << 16) | (b3 << 24));
    }
    const int e0 = PIDX[t * 128 + lane], e1 = PIDX[t * 128 + 64 + lane];
    const float g0 = PG[t * 128 + lane], g1 = PG[t * 128 + 64 + lane];
    float d0 = 0.f, d1 = 0.f;
#pragma unroll 2
    for (int pi = 0; pi < (MODE == 2 ? 0 : 128); pi += 8) {
      uint4 ua[8];
#pragma unroll
      for (int q = 0; q < 8; ++q) {
        int e = __shfl(pi < 64 ? e0 : e1, (pi + q) & 63);
        ua[q] = *(const uint4*)(UT + (long)e * 1024 + lane * 16);
      }
      int a8[8];
#pragma unroll
      for (int q = 0; q < 8; ++q) {
        int acc = __builtin_amdgcn_sdot4((int)ua[q].x, xq[0], 0, false);
        acc = __builtin_amdgcn_sdot4((int)ua[q].y, xq[1], acc, false);
        acc = __builtin_amdgcn_sdot4((int)ua[q].z, xq[2], acc, false);
        a8[q] = __builtin_amdgcn_sdot4((int)ua[q].w, xq[3], acc, false);
      }
      {
        const bool h5 = (lane & 32) != 0, h4 = (lane & 16) != 0, h3 = (lane & 8) != 0;
        int b4[4], b2[2], b1;
#pragma unroll
        for (int i = 0; i < 4; ++i) {
          int keep = h5 ? a8[4 + i] : a8[i], send = h5 ? a8[i] : a8[4 + i];
          b4[i] = keep + __shfl_xor(send, 32);
        }
#pragma unroll
        for (int i = 0; i < 2; ++i) {
          int keep = h4 ? b4[2 + i] : b4[i], send = h4 ? b4[i] : b4[2 + i];
          b2[i] = keep + __shfl_xor(send, 16);
        }
        {
          int keep = h3 ? b2[1] : b2[0], send = h3 ? b2[0] : b2[1];
          b1 = keep + __shfl_xor(send, 8);
        }
        b1 += __shfl_xor(b1, 4);
        b1 += __shfl_xor(b1, 2);
        b1 += __shfl_xor(b1, 1);
        int got = __shfl(b1, (lane & 7) * 8);
        if ((lane >> 3) == ((pi & 63) >> 3)) {
          if (pi < 64) d0 = (float)got * xsc;
          else d1 = (float)got * xsc;
        }
      }
    }
    float* COEF = (float*)(p.ws + OFF_HX);
    float c0, c1;
    if (MODE != 2) {
      c0 = g0 * geluf_(d0 * USC[e0]) * VSC[e0];
      c1 = g1 * geluf_(d1 * USC[e1]) * VSC[e1];
      if (MODE == 1) {
        COEF[t * 128 + lane] = c0;
        COEF[t * 128 + 64 + lane] = c1;
        continue;
      }
    } else {
      c0 = COEF[t * 128 + lane];
      c1 = COEF[t * 128 + 64 + lane];
    }
    const float csum = wave_sum(c0 + c1);
    float o[16];
#pragma unroll
    for (int i = 0; i < 16; ++i) o[i] = 0.f;
#pragma unroll 1
    for (int pi = 0; pi < 128; pi += 8) {
      uint4 va[8];
      float cf[8];
#pragma unroll
      for (int q = 0; q < 8; ++q) {
        int e = __shfl(pi < 64 ? e0 : e1, (pi + q) & 63);
        cf[q] = __shfl(pi < 64 ? c0 : c1, (pi + q) & 63);
        va[q] = *(const uint4*)(VTAB + (long)e * 1024 + lane * 16);
      }
#pragma unroll
      for (int q = 0; q < 8; ++q) axpyq16(o, cf[q], va[q]);
    }
    const int b = (int)(t / LS);
    const float* g2 = mod + b * 6144 + 5120;
    const float* xr = p.out + t * 1024;
    float* xw = outp + t * 1024;
    float ss = 0.f;
#pragma unroll
    for (int q4 = 0; q4 < 4; ++q4) {
      int c = lane * 16 + q4 * 4;
      float4 xv = *(const float4*)(xr + c);
      float4 gv = *(const float4*)(g2 + c);
      float* oo = o + q4 * 4;
      oo[0] = xv.x + gv.x * (oo[0] - 128.f * csum);
      oo[1] = xv.y + gv.y * (oo[1] - 128.f * csum);
      oo[2] = xv.z + gv.z * (oo[2] - 128.f * csum);
      oo[3] = xv.w + gv.w * (oo[3] - 128.f * csum);
      ss += oo[0] * oo[0] + oo[1] * oo[1] + oo[2] * oo[2] + oo[3] * oo[3];
    }
    ss = wave_sum(ss);
    float rstd = rsqrtf(ss * (1.f / 1024.f) + EPSV);
#pragma unroll
    for (int q4 = 0; q4 < 4; ++q4) {
      int c = lane * 16 + q4 * 4;
      float4 fg = *(const float4*)(p.final_g + c);
      float* oo = o + q4 * 4;
      float4 r;
      r.x = oo[0] * rstd * fg.x;
      r.y = oo[1] * rstd * fg.y;
      r.z = oo[2] * rstd * fg.z;
      r.w = oo[3] * rstd * fg.w;
      *(float4*)(xw + c) = r;
    }
  }
}

#define XB_TMO      128
#define XB_XCNT(j)  (256  + 64 * (j))
#define XB_XSUB(j)  (1280 + 64 * (j))
#define XB_XGEN(j)  (2304 + 64 * (j))
#define XB_TOP      3328
#define XB_TOPGEN   3392
#define XCD_BAR_WORDS 3456
#define XB_SPIN_CAP (1u << 18)
#define LAS __attribute__((address_space(3)))
DI unsigned xb_ld(unsigned* p) { return __hip_atomic_load(p, __ATOMIC_RELAXED, __HIP_MEMORY_SCOPE_AGENT); }
DI unsigned xb_add(unsigned* p, unsigned v) { return __hip_atomic_fetch_add(p, v, __ATOMIC_RELAXED, __HIP_MEMORY_SCOPE_AGENT); }
DI unsigned xb_xcc_id() { return (unsigned)__builtin_amdgcn_s_getreg((3 << 11) | 20) & 0xFu; }
#define XB_SPIN(cond, bar) do { unsigned _sp = 0; while (cond) { __builtin_amdgcn_s_sleep(1); \
    if ((++_sp & 255u) == 0u) { if (xb_ld(&(bar)[XB_TMO])) break; if (_sp > XB_SPIN_CAP) { atomicAdd(&(bar)[XB_TMO], 1u); break; } } } } while (0)
struct XcdBarrier {
  unsigned* bar;
  unsigned x;
  volatile LAS unsigned* st;
};
DI XcdBarrier xcd_barrier_post(unsigned* bar, volatile LAS unsigned* st) {
  XcdBarrier b;
  b.bar = bar;
  b.x = xb_xcc_id();
  b.st = st;
  if (threadIdx.x == 0) (void)xb_add(&bar[XB_XCNT(b.x)], 1u);
  return b;
}
DI void xcd_barrier_complete(unsigned* bar, unsigned x, unsigned& nloc, unsigned& nx) {
  const unsigned G = gridDim.x * gridDim.y * gridDim.z;
  unsigned sum, cnt, mine, sp = 0u;
  for (;;) {
    sum = 0u; cnt = 0u; mine = 0u;
#pragma unroll
    for (unsigned j = 0; j < 16; ++j) {
      const unsigned c = xb_ld(&bar[XB_XCNT(j)]);
      sum += c;
      cnt += (c > 0u) ? 1u : 0u;
      mine = (j == x) ? c : mine;
    }
    if (sum == G) break;
    __builtin_amdgcn_s_sleep(1);
    if ((++sp & 255u) == 0u) {
      if (xb_ld(&bar[XB_TMO])) break;
      if (sp > XB_SPIN_CAP) { atomicAdd(&bar[XB_TMO], 1u); break; }
    }
  }
  nloc = mine > 0u ? mine : 1u;
  nx = cnt > 0u ? cnt : 1u;
}
DI void xcd_barrier(const XcdBarrier& b) {
  asm volatile("s_waitcnt vmcnt(0)" ::: "memory");
  __syncthreads();
  if (threadIdx.x == 0) {
    unsigned* bar = b.bar;
    __builtin_amdgcn_s_waitcnt(0);
    unsigned nloc = b.st[0], nx = b.st[1];
    if (nloc == 0u) { xcd_barrier_complete(bar, b.x, nloc, nx); b.st[0] = nloc; b.st[1] = nx; }
    const unsigned old = xb_add(&bar[XB_XSUB(b.x)], 1u);
    const unsigned gen = old / nloc;
    if (old + 1u == (gen + 1u) * nloc) {
      __builtin_amdgcn_fence(__ATOMIC_RELEASE, "agent");
      asm volatile("s_waitcnt vmcnt(0)" ::: "memory");
      const unsigned og = xb_add(&bar[XB_TOP], 1u);
      const unsigned tg = og / nx;
      if (og + 1u == (tg + 1u) * nx) xb_add(&bar[XB_TOPGEN], 1u);
      else XB_SPIN(xb_ld(&bar[XB_TOPGEN]) == tg, bar);
      __builtin_amdgcn_fence(__ATOMIC_ACQUIRE, "agent");
      xb_add(&bar[XB_XGEN(b.x)], 1u);
      asm volatile("s_waitcnt vmcnt(0)" ::: "memory");
    } else {
      XB_SPIN(xb_ld(&bar[XB_XGEN(b.x)]) == gen, bar);
      __builtin_amdgcn_fence(__ATOMIC_ACQUIRE, "agent");
      asm volatile("s_waitcnt vmcnt(0)" ::: "memory");
    }
  }
  __syncthreads();
}

constexpr int NPHASE = 14;

__global__ void __launch_bounds__(256, 2) mega(Params p) {
  extern __shared__ __attribute__((aligned(16))) unsigned char lds_raw[];
  u16* smem = (u16*)lds_raw;
  float* tabs = (float*)(lds_raw + LDS_MAIN);
#ifndef ONLY
#define ONLY -1
#endif
  const int lo = (int)p.ph_lo, hi = (int)p.ph_hi;
  volatile LAS unsigned* xst = (volatile LAS unsigned*)(lds_raw + LDS_MAIN + 3072);
  if (threadIdx.x == 0) { xst[0] = 0u; xst[1] = 0u; }
  __syncthreads();
  XcdBarrier xb = xcd_barrier_post((unsigned*)(p.ws + OFF_BAR), xst);
#ifndef REP_MASK
#define REP_MASK 0
#endif
#define PHS(n, call)                                        \
  if ((ONLY < 0 || ONLY == n) && lo <= n && n < hi) {       \
    if ((REP_MASK >> n) & 1) {                              \
      call;                                                 \
      cg::this_grid().sync();                               \
    }                                                       \
    call;                                                   \
    if (n + 1 < hi) {                                       \
      if (lo < 0) cg::this_grid().sync();                   \
      else xcd_barrier(xb);                                 \
    }                                                       \
  }
  PHS(0, phase_prep(p, smem))
#ifndef REP_SYNC
#define REP_SYNC 0
#endif
  for (int i = 0; i < REP_SYNC; ++i) xcd_barrier(xb);
  PHS(1, phase_norm1(p))
  PHS(2, phase_gemm_a(p, smem))
  PHS(3, phase3(p, smem, tabs))
  PHS(4, phase4(p))
  PHS(5, phase5(p, smem, tabs))
  PHS(6, phase_gemm_b(p, smem))
  PHS(7, phase_gemm_c(p, smem))
  PHS(8, phase_gemm_d(p, smem))
  PHS(9, phase_norm2(p))
  PHS(10, phase_gemm_e(p, smem))
  PHS(11, phase_peer_topk(p, smem))
#ifndef REP_GATHER
#define REP_GATHER 0
#endif
  PHS(12, phase_peer_gather<1>(p, p.out))
  PHS(13, phase_peer_gather<2>(p, p.out))
}

extern "C" void kernel_launch(void* const* d_in, const int* in_sizes, int n_in, void* d_out, int out_size, void* d_ws,
                              size_t ws_size, hipStream_t stream) {
  static int grid_blocks = 0;
  if (!grid_blocks) {
    int dev = 0, cus = 0, per_cu = 0;
    hipGetDevice(&dev);
    hipDeviceGetAttribute(&cus, hipDeviceAttributeMultiprocessorCount, dev);
    hipFuncSetAttribute((const void*)mega, hipFuncAttributeMaxDynamicSharedMemorySize, LDS_BYTES);
    hipOccupancyMaxActiveBlocksPerMultiprocessor(&per_cu, (const void*)mega, 256, LDS_BYTES);
    if (per_cu < 1) per_cu = 1;
    if (per_cu > 2) per_cu = 2;
    grid_blocks = cus * per_cu;
    fprintf(stderr, "mega: cus=%d per_cu=%d grid=%d ws_need=%zu ws_size=%zu\n", cus, per_cu, grid_blocks, (size_t)WS_END, ws_size);
  }
  if (ws_size < WS_END2 || n_in != 25) {
    fprintf(stderr, "mega: workspace too small (%zu < %zu) or n_in=%d\n", ws_size, (size_t)WS_END, n_in);
    return;
  }
  hipMemsetAsync((unsigned char*)d_ws + OFF_BAR, 0, 16384, stream);
  Params p{};
  const float** pp = (const float**)&p;
  for (int i = 0; i < 25; ++i) pp[i] = (const float*)d_in[i];
  p.out = (float*)d_out;
  p.ws = (unsigned char*)d_ws;
#if MULTI
  for (int ph = 0; ph < NPHASE; ++ph) {
    p.ph_lo = ph;
    p.ph_hi = ph + 1;
    hipLaunchKernelGGL(mega, dim3(grid_blocks), dim3(256), LDS_BYTES, stream, p);
  }
#else
  p.ph_lo = 0;
  p.ph_hi = NPHASE;
  void* args[] = {&p};
  hipError_t e = hipLaunchCooperativeKernel((const void*)mega, dim3(grid_blocks), dim3(256), args, LDS_BYTES, stream);
  if (e != hipSuccess) fprintf(stderr, "cooperative launch failed: %s (grid %d)\n", hipGetErrorString(e), grid_blocks);
#endif
}
```
